# Optimizing an MI355X kernel written in HIP

```python
import math
import jax, jax.numpy as jnp
from jax import lax
import numpy as np

D_MODEL = 2048
BATCH = 2
SEQ = 8192
DEPTH = 2

CTX_LEN = 256
GRID_W = 64
EXPAND = 2
D_MIX = EXPAND * D_MODEL
W_A = D_MIX // 2
W_B = D_MIX - W_A
NH_A = 8
DV_A = W_A // NH_A
DQK_A = DV_A // 2
P_B = 64
H_B = W_B // P_B
G_B = 4
R_B = H_B // G_B
N_B = 128
D_CONV = 3
CHUNK = 128
QK_W = 2 * NH_A * DQK_A
XBC_W = W_B + 2 * G_B * N_B
IN_SIZES = (NH_A * DQK_A, NH_A * DQK_A, W_A, W_A, W_A, 4 * NH_A, XBC_W, 2 * H_B, W_B)
N_IN = sum(IN_SIZES)
LN_EPS = 1e-5
DEEPNORM_ALPHA = (2 * DEPTH) ** 0.25
DEEPNORM_BETA = (8 * DEPTH) ** -0.25

kernel_name = 'hybrid_mlstm_ssd_deepnorm_prefix_dit'


def layer_norm(x, g=None, b=None, eps=LN_EPS):
    x32 = x.astype(jnp.float32)
    mu = jnp.mean(x32, axis=-1, keepdims=True)
    var = jnp.mean(jnp.square(x32 - mu), axis=-1, keepdims=True)
    y = (x32 - mu) * lax.rsqrt(var + eps)
    if g is not None:
        y = y * g.astype(jnp.float32) + b.astype(jnp.float32)
    return y.astype(x.dtype)


def rms_norm(x, g, eps=LN_EPS):
    x32 = x.astype(jnp.float32)
    y = x32 * lax.rsqrt(jnp.mean(jnp.square(x32), axis=-1, keepdims=True) + eps)
    return (y * g.astype(jnp.float32)).astype(x.dtype)


def dwconv(x, w, b):
    k = w.shape[0]
    y = lax.conv_general_dilated(x, w[:, None, :].astype(x.dtype), window_strides=(1,),
                                 padding=[(k // 2, k // 2)],
                                 dimension_numbers=('NWC', 'WIO', 'NWC'),
                                 feature_group_count=x.shape[-1])
    return y + b


def to_colmajor(t):
    bsz, t_len, ch = t.shape
    rows = t_len // GRID_W
    return t.reshape(bsz, rows, GRID_W, ch).transpose(0, 2, 1, 3).reshape(bsz, t_len, ch)


def from_colmajor(t):
    bsz, t_len, ch = t.shape
    rows = t_len // GRID_W
    return t.reshape(bsz, GRID_W, rows, ch).transpose(0, 2, 1, 3).reshape(bsz, t_len, ch)


def flip(t):
    return jnp.flip(t, axis=1)


def _chunk(t, nc):
    return t.reshape(t.shape[0], nc, CHUNK, *t.shape[2:]).swapaxes(0, 1)


def _unchunk(ys):
    ys = ys.swapaxes(0, 1)
    return ys.reshape(ys.shape[0], ys.shape[1] * CHUNK, *ys.shape[3:])


def mlstm_scan(q, k, v, li, lf, state, need_out):
    f32 = jnp.float32
    q, k, v, li, lf = (t.astype(f32) for t in (q, k, v, li, lf))
    nc = q.shape[1] // CHUNK
    mask = jnp.tril(jnp.ones((CHUNK, CHUNK), bool))

    def body(carry, inp):
        c_prev, n_prev, m_prev = carry
        qc, kc, vc, lic, lfc = inp
        b = jnp.cumsum(lfc, axis=1)
        g = b[:, -1]
        a = g[:, None] - b + lic
        m_new = jnp.maximum(g + m_prev, jnp.max(a, axis=1))
        w = jnp.exp(a - m_new[:, None])
        decay = jnp.exp(g + m_prev - m_new)
        c_new = decay[..., None, None] * c_prev + jnp.einsum('bsh,bshk,bshv->bhkv', w, kc, vc)
        n_new = decay[..., None] * n_prev + jnp.einsum('bsh,bshk->bhk', w, kc)
        if not need_out:
            return (c_new, n_new, m_new), None
        dmat = b[:, :, None, :] - b[:, None, :, :] + lic[:, None, :, :]
        dmat = jnp.where(mask[None, :, :, None], dmat, -jnp.inf)
        inter = b + m_prev[:, None]
        m_t = jnp.maximum(inter, jnp.max(dmat, axis=2))
        s = jnp.einsum('bthk,bshk->btsh', qc, kc) * jnp.exp(dmat - m_t[:, :, None])
        w_inter = jnp.exp(inter - m_t)
        num = (w_inter[..., None] * jnp.einsum('bthk,bhkv->bthv', qc, c_prev)
               + jnp.einsum('btsh,bshv->bthv', s, vc))
        den = w_inter * jnp.einsum('bthk,bhk->bth', qc, n_prev) + jnp.sum(s, axis=2)
        h = num / jnp.maximum(jnp.abs(den), jnp.exp(-m_t))[..., None]
        return (c_new, n_new, m_new), h

    chunks = tuple(_chunk(t, nc) for t in (q, k, v, li, lf))
    state, hs = lax.scan(body, state, chunks)
    h = _unchunk(hs) if need_out else None
    return h, state


def ssd_scan(xs, bm, cm, dt, a, state, need_out):
    f32 = jnp.float32
    xs, bm, cm, dt = (t.astype(f32) for t in (xs, bm, cm, dt))
    da = dt * a.astype(f32)
    nc = xs.shape[1] // CHUNK
    mask = jnp.tril(jnp.ones((CHUNK, CHUNK), bool))

    def body(s_prev, inp):
        xc, bc, cc, dtc, dac = inp
        acum = jnp.cumsum(dac, axis=1)
        total = acum[:, -1]
        w_state = jnp.exp(total[:, None] - acum) * dtc
        s_new = (jnp.exp(total)[..., None, None] * s_prev
                 + jnp.einsum('bsgr,bsgn,bsgrp->bgrpn', w_state, bc, xc))
        if not need_out:
            return s_new, None
        seg = acum[:, :, None] - acum[:, None]
        decay = jnp.exp(jnp.where(mask[None, :, :, None, None], seg, -jnp.inf))
        cb = jnp.einsum('btgn,bsgn->btsg', cc, bc)
        w_intra = cb[..., None] * decay * dtc[:, None]
        y = (jnp.einsum('btsgr,bsgrp->btgrp', w_intra, xc)
             + jnp.exp(acum)[..., None] * jnp.einsum('btgn,bgrpn->btgrp', cc, s_prev))
        return s_new, y

    chunks = tuple(_chunk(t, nc) for t in (xs, bm, cm, dt, da))
    state, ys = lax.scan(body, state, chunks)
    y = _unchunk(ys) if need_out else None
    return y, state


def zero_states(bsz):
    f32 = jnp.float32
    m_state = (jnp.zeros((bsz, NH_A, DQK_A, DV_A), f32), jnp.zeros((bsz, NH_A, DQK_A), f32),
               jnp.zeros((bsz, NH_A), f32))
    s_state = jnp.zeros((bsz, G_B, R_B, P_B, N_B), f32)
    return (m_state, m_state, s_state, s_state)


def mixer(u, w_in, conv_qk_w, conv_qk_b, gate_b, mh_w, conv_xbc_w, conv_xbc_b, dt_bias, a_log,
          d_skip, ssm_w, states, latent, need_out):
    bsz, t_len, _ = u.shape
    p = u @ w_in
    idx = np.cumsum(IN_SIZES)[:-1].tolist()
    q_raw, k_raw, v, o, z_a, g_raw, xbc, dt_raw, z_b = jnp.split(p, idx, axis=-1)
    st_mf, st_mb, st_sf, st_sb = states

    qk = jax.nn.silu(dwconv(jnp.concatenate([q_raw, k_raw], axis=-1), conv_qk_w, conv_qk_b))
    q = qk[..., :NH_A * DQK_A].reshape(bsz, t_len, NH_A, DQK_A) * (DQK_A ** -0.5)
    k = qk[..., NH_A * DQK_A:].reshape(bsz, t_len, NH_A, DQK_A)
    v = v.reshape(bsz, t_len, NH_A, DV_A)
    g = g_raw.reshape(bsz, t_len, 4, NH_A) + gate_b
    li_f, lf_f = g[:, :, 0], jax.nn.log_sigmoid(g[:, :, 1])
    li_b, lf_b = g[:, :, 2], jax.nn.log_sigmoid(g[:, :, 3])
    h_f, st_mf = mlstm_scan(q, k, v, li_f, lf_f, st_mf, need_out)
    h_b, st_mb = mlstm_scan(flip(q), flip(k), flip(v), flip(li_b), flip(lf_b), st_mb, need_out)

    if latent:
        xbc, dt_raw = to_colmajor(xbc), to_colmajor(dt_raw)
    xbc = jax.nn.silu(dwconv(xbc, conv_xbc_w, conv_xbc_b))
    xs = xbc[..., :W_B].reshape(bsz, t_len, G_B, R_B, P_B)
    bm = xbc[..., W_B:W_B + G_B * N_B].reshape(bsz, t_len, G_B, N_B)
    cm = xbc[..., W_B + G_B * N_B:].reshape(bsz, t_len, G_B, N_B)
    dt = jax.nn.softplus(dt_raw.reshape(bsz, t_len, 2, G_B, R_B) + dt_bias.reshape(2, G_B, R_B))
    a = -jnp.exp(a_log.reshape(2, G_B, R_B))
    y_f, st_sf = ssd_scan(xs, bm, cm, dt[:, :, 0], a[0], st_sf, need_out)
    y_b, st_sb = ssd_scan(flip(xs), flip(bm), flip(cm), flip(dt[:, :, 1]), a[1], st_sb, need_out)
    new_states = (st_mf, st_mb, st_sf, st_sb)
    if not need_out:
        return None, new_states

    h = layer_norm(h_f + flip(h_b)).reshape(bsz, t_len, W_A).astype(u.dtype) * mh_w
    y_a = jax.nn.sigmoid(o) * h * jax.nn.silu(z_a)
    y = (y_f + flip(y_b)).astype(u.dtype) + d_skip.reshape(G_B, R_B)[..., None] * xs
    y = y.reshape(bsz, t_len, W_B)
    if latent:
        y = from_colmajor(y)
    y_b_out = rms_norm(y * jax.nn.silu(z_b), ssm_w)
    return jnp.concatenate([y_a, y_b_out], axis=-1), new_states


def setup_inputs(seed: int = 0) -> dict:
    key = jax.random.key(seed)
    ks = jax.random.split(key, 24)
    f32 = jnp.float32

    def nrm(k, shape, s):
        return s * jax.random.normal(k, shape, f32)

    x = nrm(ks[0], (BATCH, SEQ, D_MODEL), 1.0)
    c = nrm(ks[1], (BATCH, D_MODEL), 1.0)
    ctx = nrm(ks[2], (BATCH, CTX_LEN, D_MODEL), 1.0)
    c_ctx = nrm(ks[3], (D_MODEL,), 1.0)
    w_ada = nrm(ks[4], (DEPTH, D_MODEL, 3 * D_MODEL), D_MODEL ** -0.5)
    b_ada = nrm(ks[5], (DEPTH, 3 * D_MODEL), 0.02)
    w_in = nrm(ks[6], (DEPTH, D_MODEL, N_IN), D_MODEL ** -0.5)
    conv_qk_w = nrm(ks[7], (DEPTH, D_CONV, QK_W), D_CONV ** -0.5)
    conv_qk_b = nrm(ks[8], (DEPTH, QK_W), 0.02)
    i_bias = nrm(ks[9], (DEPTH, 2, NH_A), 0.1)
    f_bias = jnp.linspace(3.0, 6.0, NH_A, dtype=f32) + nrm(ks[10], (DEPTH, 2, NH_A), 0.1)
    gate_b = jnp.stack([i_bias[:, 0], f_bias[:, 0], i_bias[:, 1], f_bias[:, 1]], axis=1)
    mh_norm_w = 1.0 + nrm(ks[11], (DEPTH, W_A), 0.02)
    conv_xbc_w = nrm(ks[12], (DEPTH, D_CONV, XBC_W), D_CONV ** -0.5)
    conv_xbc_b = nrm(ks[13], (DEPTH, XBC_W), 0.02)
    dt0 = jnp.exp(jax.random.uniform(ks[14], (DEPTH, 2, H_B), f32, math.log(1e-3), math.log(1e-1)))
    dt_bias = dt0 + jnp.log(-jnp.expm1(-dt0))
    a_log = jnp.log(jax.random.uniform(ks[15], (DEPTH, 2, H_B), f32, 1.0, 16.0))
    d_skip = 1.0 + nrm(ks[16], (DEPTH, H_B), 0.1)
    ssm_norm_w = 1.0 + nrm(ks[17], (DEPTH, W_B), 0.02)
    w_out = nrm(ks[18], (DEPTH, D_MIX, D_MODEL), D_MIX ** -0.5 * DEEPNORM_BETA)
    ln_g = 1.0 + nrm(ks[19], (DEPTH, D_MODEL), 0.02)
    ln_b = nrm(ks[20], (DEPTH, D_MODEL), 0.02)
    return {'x': x, 'c': c, 'ctx': ctx, 'c_ctx': c_ctx, 'w_ada': w_ada, 'b_ada': b_ada,
            'w_in': w_in, 'conv_qk_w': conv_qk_w, 'conv_qk_b': conv_qk_b, 'gate_b': gate_b,
            'mh_norm_w': mh_norm_w, 'conv_xbc_w': conv_xbc_w, 'conv_xbc_b': conv_xbc_b,
            'dt_bias': dt_bias, 'a_log': a_log, 'd_skip': d_skip, 'ssm_norm_w': ssm_norm_w,
            'w_out': w_out, 'ln_g': ln_g, 'ln_b': ln_b}


def reference(x, c, ctx, c_ctx, w_ada, b_ada, w_in, conv_qk_w, conv_qk_b, gate_b, mh_norm_w,
              conv_xbc_w, conv_xbc_b, dt_bias, a_log, d_skip, ssm_norm_w, w_out, ln_g, ln_b):
    xc = ctx
    for l in range(DEPTH):
        last = l == DEPTH - 1
        params = (w_in[l], conv_qk_w[l], conv_qk_b[l], gate_b[l], mh_norm_w[l], conv_xbc_w[l],
                  conv_xbc_b[l], dt_bias[l], a_log[l], d_skip[l], ssm_norm_w[l])
        shift, scale, gate = jnp.split(jax.nn.silu(c) @ w_ada[l] + b_ada[l], 3, axis=-1)
        shift_c, scale_c, gate_c = jnp.split(jax.nn.silu(c_ctx) @ w_ada[l] + b_ada[l], 3, axis=-1)
        uc = layer_norm(xc) * (1.0 + scale_c) + shift_c
        yc, ctx_states = mixer(uc, *params, zero_states(x.shape[0]), latent=False, need_out=not last)
        u = layer_norm(x) * (1.0 + scale[:, None]) + shift[:, None]
        y, _ = mixer(u, *params, ctx_states, latent=True, need_out=True)
        x = layer_norm(DEEPNORM_ALPHA * x + gate[:, None] * (y @ w_out[l]), ln_g[l], ln_b[l])
        if not last:
            xc = layer_norm(DEEPNORM_ALPHA * xc + gate_c * (yc @ w_out[l]), ln_g[l], ln_b[l])
    return x
```

```cpp
#include <hip/hip_runtime.h>
#include <hip/hip_cooperative_groups.h>
#include <cstdio>
namespace cg = cooperative_groups;

#define LAS __attribute__((address_space(3)))
typedef unsigned short u16;
typedef short bf16x8 __attribute__((ext_vector_type(8)));
typedef float f32x4 __attribute__((ext_vector_type(4)));
typedef unsigned u32x4 __attribute__((ext_vector_type(4)));
typedef unsigned u32x2 __attribute__((ext_vector_type(2)));
typedef float f32x3 __attribute__((ext_vector_type(3)));

constexpr int D = 2048, DEPTH = 2;
constexpr int CTXROWS = 512, MROWS = 16896;
constexpr int NIN = 13408, NPAD = 13568, PW = 13312, GDW = 96, QW = 5120, G2W = 320;
constexpr float LN_EPS = 1e-5f;
constexpr float ALPHA = 1.4142135623730951f;
constexpr int LDS_BYTES = 139264;

constexpr size_t SZ_WTIN1 = (size_t)NPAD * 2048 * 2, SZ_WTOUT1 = (size_t)2048 * 4096 * 2, SZ_WL = SZ_WTIN1 + SZ_WTOUT1;
constexpr size_t SZ_P = (size_t)MROWS * PW * 2, SZ_GD = (size_t)MROWS * GDW * 4, SZ_U = (size_t)MROWS * 2048 * 2;
constexpr size_t SZ_QKX = (size_t)MROWS * QW * 2, SZ_MOD = (size_t)DEPTH * 3 * 6144 * 4, SZ_RC = (size_t)CTXROWS * 2048 * 4;
constexpr size_t OFF_W = 0, OFF_P = OFF_W + DEPTH * SZ_WL, OFF_GD = OFF_P + SZ_P, OFF_U = OFF_GD + SZ_GD,
                 OFF_QKX = OFF_U + SZ_U, OFF_MOD = OFF_QKX + SZ_QKX, OFF_RC = OFF_MOD + SZ_MOD, OFF_BAR = OFF_RC + SZ_RC, OFF_G2 = OFF_BAR + 256, WS_END = OFF_G2 + (size_t)MROWS * G2W * 4 + 256;

struct Params {
    const float *x, *c, *ctx, *c_ctx, *w_ada, *b_ada, *w_in, *conv_qk_w, *conv_qk_b, *gate_b, *mh_w, *conv_xbc_w, *conv_xbc_b, *dt_bias, *a_log, *d_skip,
        *ssm_w, *w_out, *ln_g, *ln_b;
    float* out;
    u16 *wt_in, *wt_out, *P, *U, *QKX, *HB, *YB;
    float *GD, *MOD, *RC, *G2;
};
struct KArgs { const float* in[20]; float* out; unsigned char* ws; };
template <int IDX> __device__ __forceinline__ const void* kload() {
    unsigned long r;
    asm volatile("s_load_dwordx2 %0, %1, %2\n\ts_waitcnt lgkmcnt(0)" : "=s"(r) : "s"(__builtin_amdgcn_kernarg_segment_ptr()), "n"(IDX * 8) : "memory");
    return (const void*)(const __attribute__((address_space(1))) char*)r;
}
#define KIN(i) ((const float*)kload<(i)>())
#define KOUT() ((float*)kload<20>())
#define KWS() ((unsigned char*)kload<21>())

__device__ __forceinline__ int tid_() { int t = threadIdx.x; asm volatile("" : "+v"(t)); return t; }
__device__ __forceinline__ int bid_() { int b = blockIdx.x; asm volatile("" : "+s"(b)); return b; }
__device__ __forceinline__ int gdim_() { int g = gridDim.x; asm volatile("" : "+s"(g)); return g; }
#define TIDX tid_()
#define BIDX bid_()
#define GDIM gdim_()

typedef float f32x2_t __attribute__((ext_vector_type(2)));
typedef __bf16 bf16x2_t __attribute__((ext_vector_type(2)));
__device__ __forceinline__ u16 f2bf(float f) { return __builtin_bit_cast(u16, (__bf16)f); }
__device__ __forceinline__ float bf2f(unsigned h) { return __uint_as_float(h << 16); }
__device__ __forceinline__ float bflo(unsigned w) { return __uint_as_float(w << 16); }
__device__ __forceinline__ float bfhi(unsigned w) { return __uint_as_float(w & 0xFFFF0000u); }
__device__ __forceinline__ unsigned pk2(float lo, float hi) { const f32x2_t v = {lo, hi}; return __builtin_bit_cast(unsigned, __builtin_convertvector(v, bf16x2_t)); }
__device__ __forceinline__ unsigned cvt_pk_bf16(float lo, float hi) { unsigned r; asm volatile("v_cvt_pk_bf16_f32 %0, %1, %2" : "=v"(r) : "v"(lo), "v"(hi)); return r; }
__device__ __forceinline__ float wsum(float v) {
#pragma unroll
    for (int o = 32; o > 0; o >>= 1) v += __shfl_xor(v, o, 64);
    return v;
}
__device__ __forceinline__ float siluf(float v) { return v / (1.f + __expf(-v)); }
__device__ __forceinline__ float sigmf(float v) { return 1.f / (1.f + __expf(-v)); }
__device__ __forceinline__ float scan_add(float v, int lane) {
#pragma unroll
    for (int d = 1; d < 64; d <<= 1) { float t = __shfl_up(v, d, 64); if (lane >= d) v += t; }
    return v;
}
__device__ __forceinline__ float scan_max(float v, int lane) {
#pragma unroll
    for (int d = 1; d < 64; d <<= 1) { float t = __shfl_up(v, d, 64); if (lane >= d) v = fmaxf(v, t); }
    return v;
}
__device__ __forceinline__ int src_col(int n) {
    if (n < 8192) return n;
    if (n < 11264) return n + 32;
    if (n < 13312) return n + 96;
    if (n < 13344) return n - 5120;
    if (n < 13408) return n - 2048;
    return -1;
}

namespace pg8 {
constexpr int BM = 256, BK = 64, HALF = 128, HTB = HALF * BK * 2, STAGE_BYTES = 8 * HTB, NXCD = 8, WGM = 8;
__host__ __device__ __forceinline__ int lds_byte(int r, int c) { const int st = (r >> 4) * 2 + (c >> 5), rr = r & 15, cc = c & 31, ob = rr * 64 + cc * 2; return st * 1024 + (ob ^ (((ob >> 9) & 1) << 5)); }
__host__ __device__ __forceinline__ void stage_rc(int b, int& R, int& C) { const int st = b / 1024, sb = b % 1024, swz = sb ^ (((sb >> 9) & 1) << 5); R = (st >> 1) * 16 + swz / 64; C = (st & 1) * 32 + (swz % 64) / 2; }
__host__ __device__ __forceinline__ int perm32(int rho) { const int n = rho >> 4, i = rho & 15; return 8 * (i >> 2) + 4 * n + (i & 3); }
struct Unit { int pm, pn; };
struct Gemm { const u16* A; const u16* Bt; int M, N, K, lda; };
struct StaticOrder {
    int nM, nN, nwg, G, c;
    __device__ void init(int M, int N, int G_, int c_) { nM = M / BM; nN = N / BM; nwg = nM * nN; G = G_; c = c_; }
    __device__ bool next(int i, Unit& u) const {
        const long L = (long)i * G + c; if (L >= nwg) return false;
        int wgid = (int)L; { const int q = nwg / NXCD, r = nwg % NXCD, xcd = wgid % NXCD, off = wgid / NXCD; wgid = (xcd < r ? xcd * (q + 1) : r * (q + 1) + (xcd - r) * q) + off; }
        const int nig = WGM * nN, gid = wgid / nig, fm = gid * WGM, gsz = (nM - fm) < WGM ? (nM - fm) : WGM;
        u.pm = fm + ((wgid % nig) % gsz); u.pn = (wgid % nig) / gsz; return true;
    }
};

template <class Epi>
__device__ __forceinline__ void gemm_phase(LAS unsigned char* lds, const Gemm g, const StaticOrder& S, const Epi& E) {
    const int tid = TIDX, wid = __builtin_amdgcn_readfirstlane(tid >> 6), lane = tid & 63, wr = wid >> 2, wc = wid & 3, fr = lane & 15, fq = lane >> 4;
    const int K = g.K, nt = K / BK, lda = g.lda;
    unsigned voffA[2], voffB[2];
#pragma unroll
    for (int i = 0; i < 2; ++i) { int R, C; stage_rc(tid * 16 + i * 8192, R, C); const int Rb = Epi::PERM ? ((R & ~31) + perm32(R & 31)) : R;
        voffA[i] = (unsigned)(R * lda + C) * 2u; voffB[i] = (unsigned)(Rb * K + C) * 2u; }
    const size_t kstep = (size_t)(BK * 2);
    const size_t hA = (size_t)HALF * lda * 2, hB = (size_t)HALF * K * 2;
    const size_t tA = 2 * hA, tB = 2 * hB;
    const unsigned ldsw = (unsigned)wid * 1024u;
    const int aoff = lds_byte(wr * 64 + fr, fq * 8), boff = lds_byte(wc * 32 + fr, fq * 8);
#define PG8_SA(b, h) (((b) * 2 + (h)) * HTB)
#define PG8_SB(b, h) ((4 + (b) * 2 + (h)) * HTB)
#define PG8_STAGE(bufoff, gbase, voff) do { _Pragma("unroll") for (int _i = 0; _i < 2; ++_i) \
        __builtin_amdgcn_global_load_lds((const unsigned*)((const char*)(gbase) + (voff)[_i]), (LAS unsigned*)(lds + (bufoff) + ldsw + _i * 8192), 16, 0, 0); } while (0)
#define PG8_LDA(dst, b, h) do { _Pragma("unroll") for (int m = 0; m < 4; ++m) _Pragma("unroll") for (int k = 0; k < 2; ++k) dst[m][k] = *(const LAS bf16x8*)(lds + PG8_SA(b, h) + aoff + m * 2048 + k * 1024); } while (0)
#define PG8_LDB(dst, b, h) do { _Pragma("unroll") for (int n = 0; n < 2; ++n) _Pragma("unroll") for (int k = 0; k < 2; ++k) dst[n][k] = *(const LAS bf16x8*)(lds + PG8_SB(b, h) + boff + n * 2048 + k * 1024); } while (0)
#define PG8_MMA(ai, bj, At, Bt) do { __builtin_amdgcn_s_setprio(1); _Pragma("unroll") for (int m = 0; m < 4; ++m) _Pragma("unroll") for (int n = 0; n < 2; ++n) _Pragma("unroll") for (int k = 0; k < 2; ++k) \
        acc[ai][bj][m][n] = __builtin_amdgcn_mfma_f32_16x16x32_bf16(Bt[n][k], At[m][k], acc[ai][bj][m][n], 0, 0, 0); __builtin_amdgcn_s_setprio(0); } while (0)
#define PG8_WAIT_V(n) asm volatile("s_waitcnt vmcnt(" #n ")" ::: "memory")
#define PG8_WAIT_L(n) asm volatile("s_waitcnt lgkmcnt(" #n ")" ::: "memory")
#define PG8_BAR __builtin_amdgcn_s_barrier()
#define PG8_SCHED __builtin_amdgcn_sched_barrier(0)
    Unit cur, nxt; int ui = 0;
    if (!S.next(0, cur)) return;
    f32x4 acc[2][2][4][2];
#pragma unroll
    for (int a = 0; a < 2; ++a)
#pragma unroll
        for (int b = 0; b < 2; ++b)
#pragma unroll
            for (int m = 0; m < 4; ++m)
#pragma unroll
                for (int n = 0; n < 2; ++n) acc[a][b][m][n] = (f32x4){0.f, 0.f, 0.f, 0.f};
    bf16x8 At[4][2], B0[2][2], B1[2][2];
    const char* cA = (const char*)g.A + (size_t)cur.pm * tA; const char* cB = (const char*)g.Bt + (size_t)cur.pn * tB;
    PG8_STAGE(PG8_SB(0, 0), cB, voffB); PG8_STAGE(PG8_SA(0, 0), cA, voffA); PG8_STAGE(PG8_SB(0, 1), cB + hB, voffB); PG8_STAGE(PG8_SA(0, 1), cA + hA, voffA);
    if (wr == 1) PG8_BAR;
    PG8_WAIT_V(4); PG8_BAR;
    PG8_STAGE(PG8_SB(1, 0), cB + kstep, voffB); PG8_STAGE(PG8_SA(1, 0), cA + kstep, voffA); PG8_STAGE(PG8_SB(1, 1), cB + hB + kstep, voffB);
    PG8_WAIT_V(6); PG8_BAR;
    for (;;) {
        const bool has_next = S.next(ui + 1, nxt);
        const char* nA = has_next ? (const char*)g.A + (size_t)nxt.pm * tA : cA; const char* nB = has_next ? (const char*)g.Bt + (size_t)nxt.pn * tB : cB;
        for (int t = 0; t < nt; t += 2) {
            const bool last = (t == nt - 2);
            const char* a1 = cA + (size_t)(t + 1) * kstep;
            const char* a2 = last ? nA : cA + (size_t)(t + 2) * kstep; const char* b2 = last ? nB : cB + (size_t)(t + 2) * kstep;
            const char* a3 = a2 + kstep; const char* b3 = b2 + kstep;
            PG8_LDB(B0, 0, 0); PG8_SCHED; PG8_LDA(At, 0, 0); PG8_STAGE(PG8_SA(1, 1), a1 + hA, voffA);
            PG8_WAIT_L(8); PG8_BAR; PG8_WAIT_L(0); PG8_MMA(0, 0, At, B0); PG8_BAR; PG8_SCHED;
            PG8_LDB(B1, 0, 1); PG8_STAGE(PG8_SB(0, 0), b2, voffB);
            PG8_BAR; PG8_WAIT_L(0); PG8_MMA(0, 1, At, B1); PG8_BAR;
            PG8_LDA(At, 0, 1); PG8_STAGE(PG8_SA(0, 0), a2, voffA);
            PG8_BAR; PG8_WAIT_L(0); PG8_MMA(1, 0, At, B0); PG8_BAR; PG8_SCHED;
            PG8_STAGE(PG8_SB(0, 1), b2 + hB, voffB);
            PG8_WAIT_V(6); PG8_BAR; PG8_MMA(1, 1, At, B1); PG8_BAR;
            PG8_LDB(B0, 1, 0); PG8_SCHED; PG8_LDA(At, 1, 0); PG8_STAGE(PG8_SA(0, 1), a2 + hA, voffA);
            PG8_WAIT_L(8); PG8_BAR; PG8_WAIT_L(0); PG8_MMA(0, 0, At, B0); PG8_BAR; PG8_SCHED;
            PG8_LDB(B1, 1, 1); PG8_STAGE(PG8_SB(1, 0), b3, voffB);
            PG8_BAR; PG8_WAIT_L(0); PG8_MMA(0, 1, At, B1); PG8_BAR;
            PG8_LDA(At, 1, 1); PG8_STAGE(PG8_SA(1, 0), a3, voffA);
            PG8_BAR; PG8_WAIT_L(0); PG8_MMA(1, 0, At, B0); PG8_BAR; PG8_SCHED;
            PG8_STAGE(PG8_SB(1, 1), b3 + hB, voffB);
            PG8_WAIT_V(6); PG8_BAR; PG8_MMA(1, 1, At, B1); PG8_BAR;
        }
        E(acc, cur, wr, wc, fr, fq);
        if (!has_next) break;
#pragma unroll
        for (int a = 0; a < 2; ++a)
#pragma unroll
            for (int b = 0; b < 2; ++b)
#pragma unroll
                for (int m = 0; m < 4; ++m)
#pragma unroll
                    for (int n = 0; n < 2; ++n) acc[a][b][m][n] = (f32x4){0.f, 0.f, 0.f, 0.f};
        cur = nxt; cA = nA; cB = nB; ++ui;
    }
    PG8_WAIT_V(0);
    if (wr == 0) PG8_BAR;
    PG8_BAR;
#undef PG8_SA
#undef PG8_SB
#undef PG8_STAGE
#undef PG8_LDA
#undef PG8_LDB
#undef PG8_MMA
#undef PG8_WAIT_V
#undef PG8_WAIT_L
#undef PG8_BAR
#undef PG8_SCHED
}
}

struct EpiG1 {
    static constexpr bool PERM = true;
    u16* P; float* GD;
    __device__ __forceinline__ void operator()(const f32x4 (&acc)[2][2][4][2], const pg8::Unit& u, int wr, int wc, int fr, int fq) const {
        const int row0 = u.pm * 256 + wr * 64 + fr;
        if (u.pn < 52) {
            const int col0 = u.pn * 256 + wc * 32 + 8 * fq;
#pragma unroll
            for (int ai = 0; ai < 2; ++ai)
#pragma unroll
                for (int m = 0; m < 4; ++m) { u16* rowp = P + (size_t)(row0 + ai * 128 + m * 16) * PW + col0;
#pragma unroll
                    for (int bj = 0; bj < 2; ++bj) { const f32x4 v0 = acc[ai][bj][m][0], v1 = acc[ai][bj][m][1];
                        u32x4 w; w.x = cvt_pk_bf16(v0[0], v0[1]); w.y = cvt_pk_bf16(v0[2], v0[3]); w.z = cvt_pk_bf16(v1[0], v1[1]); w.w = cvt_pk_bf16(v1[2], v1[3]);
                        *(u32x4*)(rowp + bj * 128) = w; } }
        } else if (wc < 3) {
            const int cc0 = wc * 32 + 8 * fq;
#pragma unroll
            for (int ai = 0; ai < 2; ++ai)
#pragma unroll
                for (int m = 0; m < 4; ++m) { float* rowp = GD + (size_t)(row0 + ai * 128 + m * 16) * GDW + cc0;
                    *(f32x4*)(rowp) = acc[ai][0][m][0]; *(f32x4*)(rowp + 4) = acc[ai][0][m][1]; }
        }
    }
};
struct EpiG2 {
    static constexpr bool PERM = false;
    const float* xres_lat; const float* xres_ctx; float* dst_lat; float* dst_ctx; const float* modl; int row_off;
    __device__ __forceinline__ void operator()(const f32x4 (&acc)[2][2][4][2], const pg8::Unit& u, int wr, int wc, int fr, int fq) const {
        const int g0 = u.pm * 256 + row_off;
        const bool isctx = g0 < CTXROWS;
        const int b = isctx ? (g0 >> 8) : ((g0 - CTXROWS) >> 13);
        const float* gate = modl + (size_t)(isctx ? 2 : b) * 6144 + 4096;
        const float* xr = isctx ? xres_ctx + (size_t)g0 * D : xres_lat + (size_t)(g0 - CTXROWS) * D;
        float* ds = isctx ? dst_ctx + (size_t)g0 * D : dst_lat + (size_t)(g0 - CTXROWS) * D;
        const int col0 = u.pn * 256 + wc * 32 + 4 * fq;
        f32x4 gv[2][2];
#pragma unroll
        for (int bj = 0; bj < 2; ++bj)
#pragma unroll
            for (int n = 0; n < 2; ++n) gv[bj][n] = *(const f32x4*)(gate + col0 + bj * 128 + n * 16);
#pragma unroll
        for (int ai = 0; ai < 2; ++ai)
#pragma unroll
            for (int m = 0; m < 4; ++m) { const size_t ro = (size_t)(wr * 64 + fr + ai * 128 + m * 16) * D + col0;
#pragma unroll
                for (int bj = 0; bj < 2; ++bj)
#pragma unroll
                    for (int n = 0; n < 2; ++n) { const f32x4 xv = *(const f32x4*)(xr + ro + bj * 128 + n * 16);
                        *(f32x4*)(ds + ro + bj * 128 + n * 16) = xv * ALPHA + gv[bj][n] * acc[ai][bj][m][n]; } }
    }
};

struct TrTile { const float* src; u16* dst; int Nsrc, K, n0, k0, perm; };
__device__ __forceinline__ void tr_load(const TrTile& t, float (&v)[8], int tid) {
    const int nl = tid & 63, kb = tid >> 6; const int n = t.n0 + nl; const int sc = t.perm ? src_col(n) : n;
#pragma unroll
    for (int i = 0; i < 8; ++i) { const int kl = i * 8 + kb; v[i] = sc >= 0 ? t.src[(size_t)(t.k0 + kl) * t.Nsrc + sc] : 0.f; }
}
__device__ __forceinline__ void tr_to_lds(const float (&v)[8], float* sf, int tid) {
    const int nl = tid & 63, kb = tid >> 6;
#pragma unroll
    for (int i = 0; i < 8; ++i) sf[(i * 8 + kb) * 65 + nl] = v[i];
}
__device__ __forceinline__ void tr_store(const TrTile& t, const float* sf, int tid) {
    const int nl2 = tid >> 3, kc = (tid & 7) * 8;
    u32x4 w;
    w.x = pk2(sf[(kc + 0) * 65 + nl2], sf[(kc + 1) * 65 + nl2]); w.y = pk2(sf[(kc + 2) * 65 + nl2], sf[(kc + 3) * 65 + nl2]);
    w.z = pk2(sf[(kc + 4) * 65 + nl2], sf[(kc + 5) * 65 + nl2]); w.w = pk2(sf[(kc + 6) * 65 + nl2], sf[(kc + 7) * 65 + nl2]);
    *(u32x4*)(t.dst + (size_t)(t.n0 + nl2) * t.K + t.k0 + kc) = w;
}
__device__ __forceinline__ TrTile tr_tile(const Params& p, int t) {
    constexpr int T_IN = (NPAD / 64) * 32, T_OUT = 32 * 64;
    const int l = t / (T_IN + T_OUT), r = t % (T_IN + T_OUT);
    TrTile o;
    if (r < T_IN) { o.src = p.w_in + (size_t)l * 2048 * NIN; o.dst = p.wt_in + (size_t)l * (SZ_WL / 2); o.Nsrc = NIN; o.K = 2048; o.n0 = (r >> 5) * 64; o.k0 = (r & 31) * 64; o.perm = 1; }
    else { const int r2 = r - T_IN; o.src = p.w_out + (size_t)l * 4096 * 2048; o.dst = p.wt_out + (size_t)l * (SZ_WL / 2); o.Nsrc = 2048; o.K = 4096; o.n0 = (r2 >> 6) * 64; o.k0 = (r2 & 63) * 64; o.perm = 0; }
    return o;
}

__device__ void weight_tiles(const Params& p, float* sf, int l) {
    constexpr int T_L = (NPAD / 64) * 32 + 32 * 64;
    const int tid = TIDX, gd = GDIM;
    const int t_end = (l + 1) * T_L;
    int t = l * T_L + BIDX;
    float v[8];
    __syncthreads();
    if (t < t_end) { const TrTile c0 = tr_tile(p, t); tr_load(c0, v, tid); }
    while (t < t_end) {
        tr_to_lds(v, sf, tid);
        __syncthreads();
        const int tn = t + gd;
        if (tn < t_end) { const TrTile nxt = tr_tile(p, tn); tr_load(nxt, v, tid); }
        { const TrTile cur = tr_tile(p, t); tr_store(cur, sf, tid); }
        __syncthreads();
        t = tn;
    }
}

__device__ void phase_a(const Params& p, unsigned char* lds) {
    float* sf = (float*)lds;
    const int tid = TIDX;
    if (BIDX < 192) {
        for (int i = tid; i < 3 * 2048; i += 512) { const int r = i >> 11, k = i & 2047; const float v = r < 2 ? p.c[r * 2048 + k] : p.c_ctx[k]; sf[i] = siluf(v); }
        __syncthreads();
    }
    for (int t = BIDX; t < 192; t += GDIM) {
        const int l = t / 96, cb = t % 96; const int col = cb * 64 + (tid & 63); const int kg = tid >> 6;
        const float* w = p.w_ada + (size_t)l * 2048 * 6144 + col;
        float a0 = 0.f, a1 = 0.f, a2 = 0.f;
#pragma unroll 8
        for (int k = kg * 256; k < kg * 256 + 256; ++k) { const float wv = w[(size_t)k * 6144]; a0 += sf[k] * wv; a1 += sf[2048 + k] * wv; a2 += sf[4096 + k] * wv; }
        float* red = sf + 6144;
        red[(kg * 3 + 0) * 64 + (tid & 63)] = a0; red[(kg * 3 + 1) * 64 + (tid & 63)] = a1; red[(kg * 3 + 2) * 64 + (tid & 63)] = a2;
        __syncthreads();
        if (tid < 192) { const int r = tid >> 6, cc = tid & 63; float s = 0.f;
#pragma unroll
            for (int g = 0; g < 8; ++g) s += red[(g * 3 + r) * 64 + cc];
            const int col2 = cb * 64 + cc; p.MOD[(size_t)(l * 3 + r) * 6144 + col2] = s + p.b_ada[l * 6144 + col2]; }
        __syncthreads();
    }
    __syncthreads();
    weight_tiles(p, sf, 0);
}

__device__ __forceinline__ void row_stats(const f32x4 (&v)[8], float& mean, float& rstd) {
    float s = 0.f;
#pragma unroll
    for (int i = 0; i < 8; ++i) s += v[i][0] + v[i][1] + v[i][2] + v[i][3];
    mean = wsum(s) * (1.f / 2048.f);
    float q = 0.f;
#pragma unroll
    for (int i = 0; i < 8; ++i) { const f32x4 d = v[i] - mean; q += d[0] * d[0] + d[1] * d[1] + d[2] * d[2] + d[3] * d[3]; }
    rstd = rsqrtf(wsum(q) * (1.f / 2048.f) + LN_EPS);
}
__device__ void phase_ln(const Params& p, int l) {
    const int wid = TIDX >> 6, lane = TIDX & 63;
    const int nw = GDIM * 8;
    const bool fin = (l == DEPTH);
    for (int row = BIDX * 8 + wid; row < MROWS; row += nw) {
        const bool isctx = row < CTXROWS;
        if (fin && isctx) continue;
        const int b = isctx ? (row >> 8) : ((row - CTXROWS) >> 13);
        float* rw = isctx ? p.RC + (size_t)row * D : p.out + (size_t)(row - CTXROWS) * D;
        const float* src = (l == 0) ? (isctx ? p.ctx + (size_t)row * D : p.x + (size_t)(row - CTXROWS) * D) : rw;
        f32x4 v[8];
#pragma unroll
        for (int i = 0; i < 8; ++i) v[i] = *(const f32x4*)(src + i * 256 + lane * 4);
        float mean, rstd;
        if (l > 0) {
            row_stats(v, mean, rstd);
            const float* g = p.ln_g + (size_t)(l - 1) * D; const float* bb = p.ln_b + (size_t)(l - 1) * D;
#pragma unroll
            for (int i = 0; i < 8; ++i) { const f32x4 gv = *(const f32x4*)(g + i * 256 + lane * 4), bv = *(const f32x4*)(bb + i * 256 + lane * 4);
                v[i] = (v[i] - mean) * rstd * gv + bv; *(f32x4*)(rw + i * 256 + lane * 4) = v[i]; }
        }
        if (fin) continue;
        row_stats(v, mean, rstd);
        const float* md = p.MOD + (size_t)(l * 3 + (isctx ? 2 : b)) * 6144;
        u16* ur = p.U + (size_t)row * 2048;
#pragma unroll
        for (int i = 0; i < 8; ++i) { const f32x4 sh = *(const f32x4*)(md + i * 256 + lane * 4), sc = *(const f32x4*)(md + 2048 + i * 256 + lane * 4);
            const f32x4 o = (v[i] - mean) * rstd * (sc + 1.f) + sh;
            u32x2 w; w.x = pk2(o[0], o[1]); w.y = pk2(o[2], o[3]);
            *(u32x2*)(ur + i * 256 + lane * 4) = w; }
    }
}

template <bool ISM> __device__ __forceinline__ int scan_row(int b, int dir, int cc, int i) {
    const bool isctx = cc < 2; const int p0 = isctx ? cc * 128 : (cc - 2) * 128; const int slen = isctx ? 256 : 8192; const int rowbase = isctx ? b * 256 : CTXROWS + b * 8192;
    const int s = dir ? slen - 1 - (p0 + i) : p0 + i;
    return rowbase + ((ISM || isctx) ? s : ((s & 127) * 64 + (s >> 7)));
}

__device__ void phase_conv(const Params& p, int l) {
    const int tid = TIDX;
    {
        const int wv = tid >> 6, lane = tid & 63;
        const int nwv = GDIM * 8;
        for (int task = BIDX * 8 + wv; task < 2 * 2 * 66 * 40; task += nwv) {
            const int hd = task % 40; int r = task / 40; const int cc = r % 66; r /= 66; const int dir = r & 1, b = r >> 1;
            if (hd < 8) {
                const int h = hd; const int row0 = scan_row<true>(b, dir, cc, 2 * lane), row1 = scan_row<true>(b, dir, cc, 2 * lane + 1);
                const float gbi = p.gate_b[l * 32 + (dir * 2) * 8 + h], gbf = p.gate_b[l * 32 + (dir * 2 + 1) * 8 + h];
                const float li0 = p.GD[(size_t)row0 * GDW + (dir * 2) * 8 + h] + gbi, li1 = p.GD[(size_t)row1 * GDW + (dir * 2) * 8 + h] + gbi;
                const float x0 = p.GD[(size_t)row0 * GDW + (dir * 2 + 1) * 8 + h] + gbf, x1 = p.GD[(size_t)row1 * GDW + (dir * 2 + 1) * 8 + h] + gbf;
                const float lf0 = fminf(x0, 0.f) - log1pf(__expf(-fabsf(x0))), lf1 = fminf(x1, 0.f) - log1pf(__expf(-fabsf(x1)));
                const float a1 = lf0 + lf1;
                const float inc = scan_add(a1, lane); const float exc = inc - a1;
                const float b0 = exc + lf0, b1 = exc + a1;
                const float u0 = li0 - b0, u1 = li1 - b1;
                const float incm = scan_max(fmaxf(u0, u1), lane); float excm = __shfl_up(incm, 1, 64); if (lane == 0) excm = -3.0e38f;
                const float M0 = fmaxf(excm, u0), M1 = fmaxf(M0, u1);
                float* o0 = p.G2 + (size_t)row0 * G2W + dir * 32 + h * 3; float* o1 = p.G2 + (size_t)row1 * G2W + dir * 32 + h * 3;
                o0[0] = b0; o0[1] = u0; o0[2] = M0; o1[0] = b1; o1[1] = u1; o1[2] = M1;
            } else {
                const int hh = hd - 8; const int row0 = scan_row<false>(b, dir, cc, 2 * lane), row1 = scan_row<false>(b, dir, cc, 2 * lane + 1);
                const float dtb = p.dt_bias[(l * 2 + dir) * 32 + hh]; const float Ah = -__expf(p.a_log[(l * 2 + dir) * 32 + hh]);
                const float r0 = p.GD[(size_t)row0 * GDW + 32 + dir * 32 + hh] + dtb, r1 = p.GD[(size_t)row1 * GDW + 32 + dir * 32 + hh] + dtb;
                const float dt0 = fmaxf(r0, 0.f) + log1pf(__expf(-fabsf(r0))), dt1 = fmaxf(r1, 0.f) + log1pf(__expf(-fabsf(r1)));
                const float d0 = dt0 * Ah, d1 = dt1 * Ah;
                const float a1 = d0 + d1;
                const float inc = scan_add(a1, lane); const float exc = inc - a1;
                float* o0 = p.G2 + (size_t)row0 * G2W + 64 + (dir * 4 + (hh >> 3)) * 32 + (hh & 7) * 2; float* o1 = p.G2 + (size_t)row1 * G2W + 64 + (dir * 4 + (hh >> 3)) * 32 + (hh & 7) * 2;
                o0[0] = dt0; o0[1] = exc + d0; o1[0] = dt1; o1[1] = exc + a1;
            }
        }
    }
    const int ci = tid & 127, rs = tid >> 7;
    for (int t = BIDX; t < 528 * 5; t += GDIM) {
        const int cgp = t % 5, rg = t / 5;
        int pcol, ocol, wstride; const float *w, *bias; bool isx; float scale = 1.f;
        if (cgp < 2) { const int c = (cgp * 128 + ci) * 8; pcol = c; ocol = c; w = p.conv_qk_w + (size_t)l * 3 * 2048 + c; bias = p.conv_qk_b + (size_t)l * 2048 + c; wstride = 2048; isx = false;
            if (c < 1024) scale = 0.08838834764831845f; }
        else { const int c = ((cgp - 2) * 128 + ci) * 8; pcol = 8192 + c; ocol = 2048 + c; w = p.conv_xbc_w + (size_t)l * 3 * 3072 + c; bias = p.conv_xbc_b + (size_t)l * 3072 + c; wstride = 3072; isx = true; }
        float w0[8], w1[8], w2[8], bb[8];
#pragma unroll
        for (int e = 0; e < 8; ++e) { w0[e] = w[e]; w1[e] = w[wstride + e]; w2[e] = w[2 * wstride + e]; bb[e] = bias[e]; }
        const int r0 = rg * 32 + rs * 8;
        const bool lat = r0 >= CTXROWS;
        const int seqbase = lat ? (CTXROWS + (((r0 - CTXROWS) >> 13) << 13)) : (r0 & ~255);
        const int seqlen = lat ? 8192 : 256;
        const int sp0 = r0 - seqbase;
        const bool cm = lat && isx;
        u32x4 win[10];
#pragma unroll
        for (int i = 0; i < 10; ++i) { const int sp = sp0 - 1 + i;
            const int row = seqbase + (cm ? ((sp & 127) * 64 + (sp >> 7)) : sp);
            win[i] = (sp >= 0 && sp < seqlen) ? *(const u32x4*)(p.P + (size_t)row * PW + pcol) : (u32x4){0u, 0u, 0u, 0u}; }
#pragma unroll
        for (int i = 0; i < 8; ++i) { const int sp = sp0 + i;
            const int row = seqbase + (cm ? ((sp & 127) * 64 + (sp >> 7)) : sp);
            const u32x4 ap = win[i], a = win[i + 1], an = win[i + 2];
            u32x4 o;
#pragma unroll
            for (int e2 = 0; e2 < 4; ++e2) {
                const float y0 = w0[2 * e2] * bflo(ap[e2]) + w1[2 * e2] * bflo(a[e2]) + w2[2 * e2] * bflo(an[e2]) + bb[2 * e2];
                const float y1 = w0[2 * e2 + 1] * bfhi(ap[e2]) + w1[2 * e2 + 1] * bfhi(a[e2]) + w2[2 * e2 + 1] * bfhi(an[e2]) + bb[2 * e2 + 1];
                o[e2] = pk2(siluf(y0) * scale, siluf(y1) * scale);
            }
            *(u32x4*)(p.QKX + (size_t)row * QW + ocol) = o;
        }
    }
}

constexpr int LDK = 136, LDV = 88;
constexpr int LS_K = 0, LS_V = 34816, LS_VW = LS_V + 128 * LDV * 2, LS_CT = LS_VW + 128 * LDV * 2, LS_F = LS_CT + 80 * LDK * 2;

#define LDS_BAR() do { asm volatile("s_waitcnt lgkmcnt(0)" ::: "memory"); __builtin_amdgcn_s_barrier(); asm volatile("" ::: "memory"); } while (0)
#define TR_RD8(r0, r1, r2, r3, r4, r5, r6, r7, base, o0, o1, o2, o3, o4, o5, o6, o7) \
    asm volatile("ds_read_b64_tr_b16 %0, %8 offset:%9\n\tds_read_b64_tr_b16 %1, %8 offset:%10\n\tds_read_b64_tr_b16 %2, %8 offset:%11\n\tds_read_b64_tr_b16 %3, %8 offset:%12\n\t" \
                 "ds_read_b64_tr_b16 %4, %8 offset:%13\n\tds_read_b64_tr_b16 %5, %8 offset:%14\n\tds_read_b64_tr_b16 %6, %8 offset:%15\n\tds_read_b64_tr_b16 %7, %8 offset:%16\n\ts_waitcnt lgkmcnt(0)" \
                 : "=&v"(r0), "=&v"(r1), "=&v"(r2), "=&v"(r3), "=&v"(r4), "=&v"(r5), "=&v"(r6), "=&v"(r7) \
                 : "v"(base), "n"(o0), "n"(o1), "n"(o2), "n"(o3), "n"(o4), "n"(o5), "n"(o6), "n"(o7) : "memory")
#define TR_RD2(r0, r1, base, o0, o1) \
    asm volatile("ds_read_b64_tr_b16 %0, %2 offset:%3\n\tds_read_b64_tr_b16 %1, %2 offset:%4\n\ts_waitcnt lgkmcnt(0)" : "=&v"(r0), "=&v"(r1) : "v"(base), "n"(o0), "n"(o1) : "memory")
#define TR_ST10(K0_, K1_, A0_, A1_, A2_, A3_, A4_, A5_, A6_, A7_, BK_, BV_, OK0_, OK1_, OV0_, OV1_, OV2_, OV3_, OV4_, OV5_, OV6_, OV7_) \
    asm volatile("ds_read_b64_tr_b16 %[rk0], %[bk] offset:%[ok0]\n\tds_read_b64_tr_b16 %[rk1], %[bk] offset:%[ok1]\n\t" \
                 "ds_read_b64_tr_b16 %[ra0], %[bv] offset:%[ov0]\n\tds_read_b64_tr_b16 %[ra1], %[bv] offset:%[ov1]\n\tds_read_b64_tr_b16 %[ra2], %[bv] offset:%[ov2]\n\tds_read_b64_tr_b16 %[ra3], %[bv] offset:%[ov3]\n\t" \
                 "ds_read_b64_tr_b16 %[ra4], %[bv] offset:%[ov4]\n\tds_read_b64_tr_b16 %[ra5], %[bv] offset:%[ov5]\n\tds_read_b64_tr_b16 %[ra6], %[bv] offset:%[ov6]\n\tds_read_b64_tr_b16 %[ra7], %[bv] offset:%[ov7]\n\ts_waitcnt lgkmcnt(0)" \
                 : [rk0] "=&v"(K0_), [rk1] "=&v"(K1_), [ra0] "=&v"(A0_), [ra1] "=&v"(A1_), [ra2] "=&v"(A2_), [ra3] "=&v"(A3_), [ra4] "=&v"(A4_), [ra5] "=&v"(A5_), [ra6] "=&v"(A6_), [ra7] "=&v"(A7_) \
                 : [bk] "v"(BK_), [bv] "v"(BV_), [ok0] "n"(OK0_), [ok1] "n"(OK1_), [ov0] "n"(OV0_), [ov1] "n"(OV1_), [ov2] "n"(OV2_), [ov3] "n"(OV3_), [ov4] "n"(OV4_), [ov5] "n"(OV5_), [ov6] "n"(OV6_), [ov7] "n"(OV7_) : "memory")
#define TR_ST12(K0_, K1_, A0_, A1_, A2_, A3_, A4_, A5_, A6_, A7_, A8_, A9_, BK_, BV_, OK0_, OK1_, OV0_, OV1_, OV2_, OV3_, OV4_, OV5_, OV6_, OV7_, OV8_, OV9_) \
    asm volatile("ds_read_b64_tr_b16 %[rk0], %[bk] offset:%[ok0]\n\tds_read_b64_tr_b16 %[rk1], %[bk] offset:%[ok1]\n\t" \
                 "ds_read_b64_tr_b16 %[ra0], %[bv] offset:%[ov0]\n\tds_read_b64_tr_b16 %[ra1], %[bv] offset:%[ov1]\n\tds_read_b64_tr_b16 %[ra2], %[bv] offset:%[ov2]\n\tds_read_b64_tr_b16 %[ra3], %[bv] offset:%[ov3]\n\t" \
                 "ds_read_b64_tr_b16 %[ra4], %[bv] offset:%[ov4]\n\tds_read_b64_tr_b16 %[ra5], %[bv] offset:%[ov5]\n\tds_read_b64_tr_b16 %[ra6], %[bv] offset:%[ov6]\n\tds_read_b64_tr_b16 %[ra7], %[bv] offset:%[ov7]\n\t" \
                 "ds_read_b64_tr_b16 %[ra8], %[bv] offset:%[ov8]\n\tds_read_b64_tr_b16 %[ra9], %[bv] offset:%[ov9]\n\ts_waitcnt lgkmcnt(0)" \
                 : [rk0] "=&v"(K0_), [rk1] "=&v"(K1_), [ra0] "=&v"(A0_), [ra1] "=&v"(A1_), [ra2] "=&v"(A2_), [ra3] "=&v"(A3_), [ra4] "=&v"(A4_), [ra5] "=&v"(A5_), [ra6] "=&v"(A6_), [ra7] "=&v"(A7_), [ra8] "=&v"(A8_), [ra9] "=&v"(A9_) \
                 : [bk] "v"(BK_), [bv] "v"(BV_), [ok0] "n"(OK0_), [ok1] "n"(OK1_), [ov0] "n"(OV0_), [ov1] "n"(OV1_), [ov2] "n"(OV2_), [ov3] "n"(OV3_), [ov4] "n"(OV4_), [ov5] "n"(OV5_), [ov6] "n"(OV6_), [ov7] "n"(OV7_), [ov8] "n"(OV8_), [ov9] "n"(OV9_) : "memory")
__device__ __forceinline__ bf16x8 mkfrag(u32x2 lo, u32x2 hi) { const u32x4 w = {lo.x, lo.y, hi.x, hi.y}; return __builtin_bit_cast(bf16x8, w); }

template <bool ISM>
__device__ void scan_item(const Params& p, int l, int item, unsigned char* lds) {
    constexpr int NT = ISM ? 5 : 4;
    constexpr float L2E = 1.4426950408889634f;
    const int tid = TIDX, wid = __builtin_amdgcn_readfirstlane(tid >> 6), lane = tid & 63, fr = lane & 15, fq = lane >> 4;
    const int trq = fr >> 2, trp = fr & 3;
    const int sl = ISM ? (item & 3) : 0, dir = ISM ? ((item >> 2) & 1) : (item & 1), h = ISM ? ((item >> 3) & 7) : ((item >> 1) & 31), b = item >> 6;
    const int qcol = ISM ? h * 128 : 2048 + 2560 + (h >> 3) * 128;
    const int kcol = ISM ? 1024 + h * 128 : 2048 + 2048 + (h >> 3) * 128;
    const int vcol = ISM ? 2048 + h * 256 + sl * 64 : 2048 + h * 64;
    const int ocol = ISM ? h * 256 + sl * 64 : h * 64;
    u16* const obase = dir ? (ISM ? p.HB : p.YB) : (ISM ? p.P : p.P + 8192);
    const unsigned ostride = dir ? 2048u : (unsigned)PW;
    u16* Ks = (u16*)(lds + LS_K); u16* Vs = (u16*)(lds + LS_V); u16* Vw = (u16*)(lds + LS_VW); u16* CT = (u16*)(lds + LS_CT);
    float* F = (float*)(lds + LS_F);
    float *f_c = F, *f_r = F + 128, *f_wi = F + 256, *f_ws = F + 384, *f_em = F + 512;
    const unsigned ldsb = (unsigned)(size_t)(LAS unsigned char*)lds;
    const unsigned trK = ldsb + LS_K + (unsigned)(((fq * 8 + trq) * LDK + 16 * wid + 4 * trp) * 2);
    const unsigned trVw = ldsb + LS_VW + (unsigned)(((fq * 8 + trq) * LDV + 4 * trp) * 2);
    const unsigned trV = ldsb + LS_V + (unsigned)(((fq * 4 + trq) * LDV + 4 * trp) * 2);
    const float Dh = ISM ? 0.f : p.d_skip[l * 32 + h];
    const u16* __restrict__ gQKX = p.QKX; const u16* __restrict__ gP = p.P; const float* __restrict__ gG2 = p.G2;
    const int gcol = ISM ? dir * 32 + h * 3 : 64 + (dir * 4 + (h >> 3)) * 32 + (h & 7) * 2;
    __syncthreads();
    for (int i = tid; i < 128 * 24; i += 512) { const int r = i / 24, cc = 64 + i % 24; Vs[r * LDV + cc] = (ISM && cc == 64) ? (u16)0x3F80 : (u16)0; Vw[r * LDV + cc] = 0; }
    for (int i = tid; i < 80 * LDK; i += 512) CT[i] = 0;
    f32x4 st[NT];
#pragma unroll
    for (int m = 0; m < NT; ++m) st[m] = (f32x4){0.f, 0.f, 0.f, 0.f};
    float m_prev = 0.f;
    unsigned qo, ko[4], vo[2], go, ge, oo[4];
    bf16x8 qf[4]; u32x4 kr[4]; u32x4 vr[2]; f32x3 gv = {0.f, 0.f, 0.f}; float e0 = 0.f, e1 = 0.f;
#define SCAN_PTRS(cc) do { \
        qo = (unsigned)scan_row<ISM>(b, dir, (cc), 16 * wid + fr) * (unsigned)QW + (unsigned)(qcol + fq * 8); \
        _Pragma("unroll") for (int r_ = 0; r_ < 4; ++r_) { const int idx_ = r_ * 512 + tid; ko[r_] = (unsigned)scan_row<ISM>(b, dir, (cc), idx_ >> 4) * (unsigned)QW + (unsigned)(kcol + (idx_ & 15) * 8); } \
        _Pragma("unroll") for (int r_ = 0; r_ < 2; ++r_) { const int idx_ = r_ * 512 + tid; vo[r_] = (unsigned)scan_row<ISM>(b, dir, (cc), idx_ >> 3) * (unsigned)(ISM ? PW : QW) + (unsigned)(vcol + (idx_ & 7) * 8); } \
        go = (unsigned)scan_row<ISM>(b, dir, (cc), tid & 127) * (unsigned)G2W + (unsigned)gcol; ge = (unsigned)scan_row<ISM>(b, dir, (cc), 127) * (unsigned)G2W + (unsigned)gcol; \
        _Pragma("unroll") for (int j_ = 0; j_ < 4; ++j_) oo[j_] = (unsigned)scan_row<ISM>(b, dir, (cc), 16 * wid + fq * 4 + j_) * ostride + (unsigned)(ocol + fr); \
    } while (0)
#define SCAN_ADV(dr) do { const unsigned dq_ = (unsigned)((dr) * QW), dp_ = (unsigned)((dr) * PW), dg_ = (unsigned)((dr) * G2W), do_ = (unsigned)(dr) * ostride; \
        qo += dq_; _Pragma("unroll") for (int r_ = 0; r_ < 4; ++r_) ko[r_] += dq_; vo[0] += ISM ? dp_ : dq_; vo[1] += ISM ? dp_ : dq_; go += dg_; ge += dg_; \
        _Pragma("unroll") for (int j_ = 0; j_ < 4; ++j_) oo[j_] += do_; } while (0)
#define SCAN_LOAD() do { \
        _Pragma("unroll") for (int k_ = 0; k_ < 4; ++k_) qf[k_] = *(const bf16x8*)(gQKX + (size_t)qo + k_ * 32); \
        _Pragma("unroll") for (int r_ = 0; r_ < 4; ++r_) kr[r_] = *(const u32x4*)(gQKX + (size_t)ko[r_]); \
        _Pragma("unroll") for (int r_ = 0; r_ < 2; ++r_) vr[r_] = ISM ? *(const u32x4*)(gP + (size_t)vo[r_]) : *(const u32x4*)(gQKX + (size_t)vo[r_]); \
        if (tid < 128) gv = *(const f32x3*)(gG2 + (size_t)go); \
        if (ISM) { e0 = gG2[(size_t)ge]; e1 = gG2[(size_t)ge + 2]; } else { e0 = gG2[(size_t)ge + 1]; } \
    } while (0)
    SCAN_PTRS(0); SCAN_LOAD();
    const int dr_ctx = dir ? -128 : 128, dr_lat = ISM ? dr_ctx : (dir ? -1 : 1);
    __syncthreads();
#pragma unroll 1
    for (int c = 0; c < 66; ++c) {
#pragma unroll
        for (int rep = 0; rep < 4; ++rep) { const int idx = rep * 512 + tid; *(u32x4*)(Ks + (idx >> 4) * LDK + (idx & 15) * 8) = kr[rep]; }
#pragma unroll
        for (int rep = 0; rep < 2; ++rep) { const int idx = rep * 512 + tid; *(u32x4*)(Vs + (idx >> 3) * LDV + (idx & 7) * 8) = vr[rep]; }
        float decay;
        if (ISM) {
            const float Ml = fmaxf(m_prev, e1);
            if (tid < 128) { const float M = fmaxf(m_prev, gv[2]);
                f_c[tid] = gv[1] * L2E; f_r[tid] = M * L2E; f_wi[tid] = __expf(m_prev - M); f_ws[tid] = __expf(gv[1] - Ml); f_em[tid] = __expf(-(gv[0] + M)); }
            decay = __expf(m_prev - Ml); m_prev = e0 + Ml;
        } else {
            if (tid < 128) { f_c[tid] = (__logf(gv[0]) - gv[1]) * L2E; f_r[tid] = -gv[1] * L2E; f_wi[tid] = __expf(gv[1]); f_ws[tid] = __expf(e0 - gv[1]) * gv[0]; }
            decay = __expf(e0);
        }
        bf16x8 qc[4]; unsigned od[4];
#pragma unroll
        for (int k = 0; k < 4; ++k) qc[k] = qf[k];
#pragma unroll
        for (int j = 0; j < 4; ++j) od[j] = oo[j];
        const u32x4 vc0 = vr[0], vc1 = vr[1];
        LDS_BAR();
        if (c + 1 < 66) { if (c + 1 == 2) SCAN_PTRS(2); else SCAN_ADV(c == 0 ? dr_ctx : dr_lat); SCAN_LOAD(); }
        f32x4 sacc[8];
#pragma unroll
        for (int a = 0; a < 8; ++a) sacc[a] = (f32x4){0.f, 0.f, 0.f, 0.f};
#pragma unroll
        for (int a = 0; a < 8; a += 2) {
            if (a + 1 <= wid) {
                bf16x8 kf[2][4];
#pragma unroll
                for (int h2 = 0; h2 < 2; ++h2)
#pragma unroll
                    for (int ksd = 0; ksd < 4; ++ksd) kf[h2][ksd] = *(const bf16x8*)(Ks + (16 * (a + h2) + fr) * LDK + ksd * 32 + fq * 8);
#pragma unroll
                for (int ksd = 0; ksd < 4; ++ksd) { sacc[a] = __builtin_amdgcn_mfma_f32_16x16x32_bf16(kf[0][ksd], qc[ksd], sacc[a], 0, 0, 0);
                    sacc[a + 1] = __builtin_amdgcn_mfma_f32_16x16x32_bf16(kf[1][ksd], qc[ksd], sacc[a + 1], 0, 0, 0); }
            } else if (a <= wid) {
                bf16x8 kf[4];
#pragma unroll
                for (int ksd = 0; ksd < 4; ++ksd) kf[ksd] = *(const bf16x8*)(Ks + (16 * a + fr) * LDK + ksd * 32 + fq * 8);
#pragma unroll
                for (int ksd = 0; ksd < 4; ++ksd) sacc[a] = __builtin_amdgcn_mfma_f32_16x16x32_bf16(kf[ksd], qc[ksd], sacc[a], 0, 0, 0);
            }
        }
        bf16x8 sf[4]; float dsum = 0.f;
        { const float rt = f_r[16 * wid + fr];
          f32x4 cva[8];
#pragma unroll
          for (int a = 0; a < 8; ++a) cva[a] = *(const f32x4*)(f_c + 16 * a + fq * 4);
#pragma unroll
          for (int ks = 0; ks < 4; ++ks) { u32x4 w;
#pragma unroll
              for (int hf = 0; hf < 2; ++hf) { const int a = 2 * ks + hf; float v[4];
                  if (a < wid) { const f32x4 cv = cva[a];
#pragma unroll
                      for (int j = 0; j < 4; ++j) { v[j] = sacc[a][j] * __builtin_amdgcn_exp2f(cv[j] - rt); dsum += v[j]; }
                  } else if (a == wid) { const f32x4 cv = cva[a];
#pragma unroll
                      for (int j = 0; j < 4; ++j) { const float e = sacc[a][j] * __builtin_amdgcn_exp2f(cv[j] - rt); v[j] = (fq * 4 + j <= fr) ? e : 0.f; dsum += v[j]; }
                  } else { v[0] = 0.f; v[1] = 0.f; v[2] = 0.f; v[3] = 0.f; }
                  w[hf * 2] = pk2(v[0], v[1]); w[hf * 2 + 1] = pk2(v[2], v[3]); }
              sf[ks] = __builtin_bit_cast(bf16x8, w); } }
        dsum += __shfl_xor(dsum, 16, 64); dsum += __shfl_xor(dsum, 32, 64);
        {
#pragma unroll
          for (int rep = 0; rep < 2; ++rep) { const int idx = rep * 512 + tid; const int i = idx >> 3; const float wv = f_ws[i]; const u32x4 vc = rep ? vc1 : vc0; u32x4 o;
#pragma unroll
              for (int e = 0; e < 4; ++e) o[e] = pk2(bflo(vc[e]) * wv, bfhi(vc[e]) * wv);
              *(u32x4*)(Vw + i * LDV + (idx & 7) * 8) = o; }
          if (ISM && tid < 128) Vw[tid * LDV + 64] = f2bf(f_ws[tid]); }
        { f32x4 ia[NT], ib[4];
#pragma unroll
          for (int n = 0; n < NT; ++n) ia[n] = (f32x4){0.f, 0.f, 0.f, 0.f};
#pragma unroll
          for (int n = 0; n < 4; ++n) ib[n] = (f32x4){0.f, 0.f, 0.f, 0.f};
#pragma unroll
          for (int ksd = 0; ksd < 4; ++ksd) { bf16x8 bfr[NT];
#pragma unroll
              for (int n = 0; n < NT; ++n) bfr[n] = *(const bf16x8*)(CT + (n * 16 + fr) * LDK + ksd * 32 + fq * 8);
#pragma unroll
              for (int n = 0; n < NT; ++n) ia[n] = __builtin_amdgcn_mfma_f32_16x16x32_bf16(qc[ksd], bfr[n], ia[n], 0, 0, 0); }
#define SCAN_IB(ks) if (2 * (ks) <= wid) { u32x2 r0, r1, r2, r3, r4, r5, r6, r7; \
              TR_RD8(r0, r1, r2, r3, r4, r5, r6, r7, trV, (ks) * 32 * LDV * 2, (ks) * 32 * LDV * 2 + 16 * LDV * 2, (ks) * 32 * LDV * 2 + 32, (ks) * 32 * LDV * 2 + 16 * LDV * 2 + 32, \
                     (ks) * 32 * LDV * 2 + 64, (ks) * 32 * LDV * 2 + 16 * LDV * 2 + 64, (ks) * 32 * LDV * 2 + 96, (ks) * 32 * LDV * 2 + 16 * LDV * 2 + 96); \
              ib[0] = __builtin_amdgcn_mfma_f32_16x16x32_bf16(sf[ks], mkfrag(r0, r1), ib[0], 0, 0, 0); ib[1] = __builtin_amdgcn_mfma_f32_16x16x32_bf16(sf[ks], mkfrag(r2, r3), ib[1], 0, 0, 0); \
              ib[2] = __builtin_amdgcn_mfma_f32_16x16x32_bf16(sf[ks], mkfrag(r4, r5), ib[2], 0, 0, 0); ib[3] = __builtin_amdgcn_mfma_f32_16x16x32_bf16(sf[ks], mkfrag(r6, r7), ib[3], 0, 0, 0); }
          SCAN_IB(0) SCAN_IB(1) SCAN_IB(2) SCAN_IB(3)
#undef SCAN_IB
#pragma unroll
          for (int j = 0; j < 4; ++j) { const int tl = fq * 4 + j, t = 16 * wid + tl; const float wi = f_wi[t];
              float inv = 1.f;
              if (ISM) { const float qn = __shfl(ia[NT - 1][j], lane & 48, 64); const float dn = __shfl(dsum, tl, 64); inv = __builtin_amdgcn_rcpf(fmaxf(fabsf(wi * qn + dn), f_em[t])); }
              u16* dst = obase + (size_t)od[j];
              float v[4];
#pragma unroll
              for (int n = 0; n < 4; ++n) { v[n] = (wi * ia[n][j] + ib[n][j]) * inv; if (!ISM && dir == 0) v[n] += Dh * bf2f(Vs[t * LDV + n * 16 + fr]); }
              const unsigned p01 = pk2(v[0], v[1]), p23 = pk2(v[2], v[3]);
              dst[0] = (u16)(p01 & 0xFFFFu); dst[16] = (u16)(p01 >> 16); dst[32] = (u16)(p23 & 0xFFFFu); dst[48] = (u16)(p23 >> 16); } }
        LDS_BAR();
        {
#pragma unroll
          for (int m = 0; m < NT; ++m) st[m] *= decay;
#define SCAN_ST(ks) { u32x2 k0, k1, a0, a1, a2, a3, a4, a5, a6, a7, a8, a9; \
              if (ISM) TR_ST12(k0, k1, a0, a1, a2, a3, a4, a5, a6, a7, a8, a9, trK, trVw, (ks) * 32 * LDK * 2, (ks) * 32 * LDK * 2 + 4 * LDK * 2, \
                     (ks) * 32 * LDV * 2, (ks) * 32 * LDV * 2 + 4 * LDV * 2, (ks) * 32 * LDV * 2 + 32, (ks) * 32 * LDV * 2 + 4 * LDV * 2 + 32, \
                     (ks) * 32 * LDV * 2 + 64, (ks) * 32 * LDV * 2 + 4 * LDV * 2 + 64, (ks) * 32 * LDV * 2 + 96, (ks) * 32 * LDV * 2 + 4 * LDV * 2 + 96, \
                     (ks) * 32 * LDV * 2 + 128, (ks) * 32 * LDV * 2 + 4 * LDV * 2 + 128); \
              else TR_ST10(k0, k1, a0, a1, a2, a3, a4, a5, a6, a7, trK, trVw, (ks) * 32 * LDK * 2, (ks) * 32 * LDK * 2 + 4 * LDK * 2, \
                     (ks) * 32 * LDV * 2, (ks) * 32 * LDV * 2 + 4 * LDV * 2, (ks) * 32 * LDV * 2 + 32, (ks) * 32 * LDV * 2 + 4 * LDV * 2 + 32, \
                     (ks) * 32 * LDV * 2 + 64, (ks) * 32 * LDV * 2 + 4 * LDV * 2 + 64, (ks) * 32 * LDV * 2 + 96, (ks) * 32 * LDV * 2 + 4 * LDV * 2 + 96); \
              const bf16x8 kfr = mkfrag(k0, k1); \
              st[0] = __builtin_amdgcn_mfma_f32_16x16x32_bf16(mkfrag(a0, a1), kfr, st[0], 0, 0, 0); st[1] = __builtin_amdgcn_mfma_f32_16x16x32_bf16(mkfrag(a2, a3), kfr, st[1], 0, 0, 0); \
              st[2] = __builtin_amdgcn_mfma_f32_16x16x32_bf16(mkfrag(a4, a5), kfr, st[2], 0, 0, 0); st[3] = __builtin_amdgcn_mfma_f32_16x16x32_bf16(mkfrag(a6, a7), kfr, st[3], 0, 0, 0); \
              if (ISM) st[NT - 1] = __builtin_amdgcn_mfma_f32_16x16x32_bf16(mkfrag(a8, a9), kfr, st[NT - 1], 0, 0, 0); }
          SCAN_ST(0) SCAN_ST(1) SCAN_ST(2) SCAN_ST(3)
#undef SCAN_ST
#pragma unroll
          for (int m = 0; m < NT; ++m) { const unsigned p01 = pk2(st[m][0], st[m][1]), p23 = pk2(st[m][2], st[m][3]);
              u16* cp = CT + (m * 16 + fq * 4) * LDK + 16 * wid + fr;
              cp[0] = (u16)(p01 & 0xFFFFu); cp[LDK] = (u16)(p01 >> 16); cp[2 * LDK] = (u16)(p23 & 0xFFFFu); cp[3 * LDK] = (u16)(p23 >> 16); } }
        LDS_BAR();
    }
#undef SCAN_LOAD
#undef SCAN_ADV
#undef SCAN_PTRS
}

__device__ void phase_scan(const Params& p, int l, unsigned char* lds) {
    for (int blk = BIDX; blk < 256; blk += GDIM) {
        const int xcd = blk & 7, j = blk >> 3;
        if (j < 16) scan_item<true>(p, l, (xcd + 8 * (j >> 2)) * 4 + (j & 3), lds);
        else { const int G = xcd + 8 * ((j - 16) >> 3), r = (j - 16) & 7; const int dir = G & 1, g = (G >> 1) & 3, b = G >> 3;
            scan_item<false>(p, l, dir + 2 * (g * 8 + r) + 64 * b, lds); }
    }
}

__device__ void phase_post(const Params& p, int l) {
    const int wid = TIDX >> 6, lane = TIDX & 63;
    const int nw = GDIM * 8;
    const int c0 = lane * 32;
    for (int row = BIDX * 8 + wid; row < MROWS; row += nw) {
        u16* pr = p.P + (size_t)row * PW;
        u32x4 yv[4], zb[4], yb[4], ha[4], hb[4], ov[4], za[4];
#pragma unroll
        for (int q = 0; q < 4; ++q) {
            yv[q] = *(const u32x4*)(pr + 8192 + c0 + q * 8); zb[q] = *(const u32x4*)(pr + 11264 + c0 + q * 8); yb[q] = *(const u32x4*)(p.YB + (size_t)row * 2048 + c0 + q * 8);
            ha[q] = *(const u32x4*)(pr + c0 + q * 8); hb[q] = *(const u32x4*)(p.HB + (size_t)row * 2048 + c0 + q * 8);
            ov[q] = *(const u32x4*)(pr + 4096 + c0 + q * 8); za[q] = *(const u32x4*)(pr + 6144 + c0 + q * 8); }
        {
            float tv[32]; float ss = 0.f;
#pragma unroll
            for (int q = 0; q < 4; ++q)
#pragma unroll
                for (int e = 0; e < 4; ++e) { const float t0 = (bflo(yv[q][e]) + bflo(yb[q][e])) * siluf(bflo(zb[q][e])), t1 = (bfhi(yv[q][e]) + bfhi(yb[q][e])) * siluf(bfhi(zb[q][e]));
                    tv[q * 8 + 2 * e] = t0; tv[q * 8 + 2 * e + 1] = t1; ss += t0 * t0 + t1 * t1; }
            const float rstd = rsqrtf(wsum(ss) * (1.f / 2048.f) + LN_EPS);
            const float* sw = p.ssm_w + (size_t)l * 2048 + c0;
#pragma unroll
            for (int q = 0; q < 4; ++q) { const f32x4 wa = *(const f32x4*)(sw + q * 8), wb = *(const f32x4*)(sw + q * 8 + 4);
                u32x4 o; o.x = pk2(tv[q * 8] * rstd * wa[0], tv[q * 8 + 1] * rstd * wa[1]); o.y = pk2(tv[q * 8 + 2] * rstd * wa[2], tv[q * 8 + 3] * rstd * wa[3]);
                o.z = pk2(tv[q * 8 + 4] * rstd * wb[0], tv[q * 8 + 5] * rstd * wb[1]); o.w = pk2(tv[q * 8 + 6] * rstd * wb[2], tv[q * 8 + 7] * rstd * wb[3]);
                *(u32x4*)(pr + 11264 + c0 + q * 8) = o; }
        }
        {
            float hv[32]; float s = 0.f;
#pragma unroll
            for (int q = 0; q < 4; ++q)
#pragma unroll
                for (int e = 0; e < 4; ++e) { const float h0 = bflo(ha[q][e]) + bflo(hb[q][e]), h1 = bfhi(ha[q][e]) + bfhi(hb[q][e]); hv[q * 8 + 2 * e] = h0; hv[q * 8 + 2 * e + 1] = h1; s += h0 + h1; }
            s += __shfl_xor(s, 1, 64); s += __shfl_xor(s, 2, 64); s += __shfl_xor(s, 4, 64);
            const float mean = s * (1.f / 256.f);
            float q2 = 0.f;
#pragma unroll
            for (int e = 0; e < 32; ++e) { const float d = hv[e] - mean; q2 += d * d; }
            q2 += __shfl_xor(q2, 1, 64); q2 += __shfl_xor(q2, 2, 64); q2 += __shfl_xor(q2, 4, 64);
            const float rstd = rsqrtf(q2 * (1.f / 256.f) + LN_EPS);
            const float* mw = p.mh_w + (size_t)l * 2048 + c0;
#pragma unroll
            for (int q = 0; q < 4; ++q) {
                const f32x4 wa = *(const f32x4*)(mw + q * 8), wb = *(const f32x4*)(mw + q * 8 + 4);
                float r[8];
#pragma unroll
                for (int e = 0; e < 4; ++e) {
                    const float m0 = (e < 2 ? wa[2 * e] : wb[2 * e - 4]), m1 = (e < 2 ? wa[2 * e + 1] : wb[2 * e - 3]);
                    r[2 * e] = sigmf(bflo(ov[q][e])) * ((hv[q * 8 + 2 * e] - mean) * rstd * m0) * siluf(bflo(za[q][e]));
                    r[2 * e + 1] = sigmf(bfhi(ov[q][e])) * ((hv[q * 8 + 2 * e + 1] - mean) * rstd * m1) * siluf(bfhi(za[q][e])); }
                u32x4 o; o.x = pk2(r[0], r[1]); o.y = pk2(r[2], r[3]); o.z = pk2(r[4], r[5]); o.w = pk2(r[6], r[7]);
                *(u32x4*)(pr + 9216 + c0 + q * 8) = o; }
        }
    }
}

__device__ __forceinline__ void grid_barrier(unsigned* ctr, unsigned target) {
    __syncthreads();
    if (threadIdx.x == 0) {
        __threadfence();
        asm volatile("s_waitcnt vmcnt(0)" ::: "memory");
        __hip_atomic_fetch_add(ctr, 1u, __ATOMIC_RELAXED, __HIP_MEMORY_SCOPE_AGENT);
        while (__hip_atomic_load(ctr, __ATOMIC_RELAXED, __HIP_MEMORY_SCOPE_AGENT) < target) __builtin_amdgcn_s_sleep(2);
        __threadfence();
        asm volatile("s_waitcnt vmcnt(0)" ::: "memory");
    }
    __syncthreads();
}
__device__ __forceinline__ void acquire_workgroup() {
    if (threadIdx.x == 0) { __threadfence(); asm volatile("s_waitcnt vmcnt(0)" ::: "memory"); }
    __syncthreads();
}

constexpr int N_PHASES = 2 + 6 * DEPTH;
__global__ __launch_bounds__(512, 2) void mega(KArgs ka, int ph_lo, int ph_hi) {
    extern __shared__ __attribute__((aligned(16))) unsigned char shm[];
    cg::grid_group grid = cg::this_grid();
#pragma unroll 1
    for (int ph = ph_lo; ph < ph_hi; ++ph) {
        if (ph == 0) {
            Params q{}; unsigned char* ws = KWS();
            q.c = KIN(1); q.c_ctx = KIN(3); q.w_ada = KIN(4); q.b_ada = KIN(5); q.w_in = KIN(6); q.w_out = KIN(17);
            q.MOD = (float*)(ws + OFF_MOD); q.wt_in = (u16*)(ws + OFF_W); q.wt_out = (u16*)(ws + OFF_W + SZ_WTIN1);
            phase_a(q, shm);
        } else {
            const int l = (ph == N_PHASES - 1) ? DEPTH : (ph - 1) / 6, k = (ph == N_PHASES - 1) ? 0 : (ph - 1) % 6;
            if (k == 0) {
                Params q{}; unsigned char* ws = KWS();
                q.x = KIN(0); q.ctx = KIN(2); q.ln_g = KIN(18); q.ln_b = KIN(19); q.out = KOUT();
                q.RC = (float*)(ws + OFF_RC); q.MOD = (float*)(ws + OFF_MOD); q.U = (u16*)(ws + OFF_U);
                phase_ln(q, l);
                if (l >= 1 && l < DEPTH) {
                    q.w_in = KIN(6); q.w_out = KIN(17); q.wt_in = (u16*)(ws + OFF_W); q.wt_out = (u16*)(ws + OFF_W + SZ_WTIN1);
                    weight_tiles(q, (float*)shm, l);
                }
            } else if (k == 1) {
                unsigned char* ws = KWS();
                pg8::Gemm g{(const u16*)(ws + OFF_U), (const u16*)(ws + OFF_W + (size_t)l * SZ_WL), MROWS, NPAD, 2048, 2048};
                pg8::StaticOrder S; S.init(MROWS, NPAD, GDIM, BIDX);
                EpiG1 E{(u16*)(ws + OFF_P), (float*)(ws + OFF_GD)};
                pg8::gemm_phase<EpiG1>((LAS unsigned char*)shm, g, S, E);
            } else if (k == 2) {
                Params q{}; unsigned char* ws = KWS();
                q.conv_qk_w = KIN(7); q.conv_qk_b = KIN(8); q.conv_xbc_w = KIN(11); q.conv_xbc_b = KIN(12); q.gate_b = KIN(9); q.dt_bias = KIN(13); q.a_log = KIN(14);
                q.P = (u16*)(ws + OFF_P); q.QKX = (u16*)(ws + OFF_QKX); q.GD = (float*)(ws + OFF_GD); q.G2 = (float*)(ws + OFF_G2);
                phase_conv(q, l);
            } else if (k == 3) {
                Params q{}; unsigned char* ws = KWS();
                q.gate_b = KIN(9); q.dt_bias = KIN(13); q.a_log = KIN(14); q.d_skip = KIN(15);
                q.P = (u16*)(ws + OFF_P); q.QKX = (u16*)(ws + OFF_QKX); q.G2 = (float*)(ws + OFF_G2);
                q.HB = (u16*)(ws + OFF_U); q.YB = (u16*)(ws + OFF_W + (size_t)((l + 1) & 1) * SZ_WL);
                phase_scan(q, l, shm);
            } else if (k == 4) {
                Params q{}; unsigned char* ws = KWS();
                q.mh_w = KIN(10); q.ssm_w = KIN(16); q.P = (u16*)(ws + OFF_P);
                q.HB = (u16*)(ws + OFF_U); q.YB = (u16*)(ws + OFF_W + (size_t)((l + 1) & 1) * SZ_WL);
                phase_post(q, l);
            } else {
                unsigned char* ws = KWS(); float* outp = KOUT();
                const float* xin = KIN(0); const float* cin = KIN(2);
                float* rc = (float*)(ws + OFF_RC);
                const int roff = (l == DEPTH - 1) ? CTXROWS : 0;
                pg8::Gemm g{(const u16*)(ws + OFF_P) + (size_t)roff * PW + 9216, (const u16*)(ws + OFF_W + (size_t)l * SZ_WL + SZ_WTIN1), MROWS - roff, 2048, 4096, PW};
                pg8::StaticOrder S; S.init(MROWS - roff, 2048, GDIM, BIDX);
                EpiG2 E{l == 0 ? xin : outp, l == 0 ? cin : rc, outp, rc, (const float*)(ws + OFF_MOD) + (size_t)l * 3 * 6144, roff};
                pg8::gemm_phase<EpiG2>((LAS unsigned char*)shm, g, S, E);
            }
        }
        if (ph + 1 < ph_hi) { if (ph == ph_lo) { grid.sync(); acquire_workgroup(); } else grid_barrier((unsigned*)(KWS() + OFF_BAR), (unsigned)(ph - ph_lo) * (unsigned)GDIM); }
    }
}

extern "C" void kernel_launch(void* const* d_in, const int* in_sizes, int n_in, void* d_out, int out_size, void* d_ws, size_t ws_size, hipStream_t stream) {
    static int grid = 0;
    if (grid == 0) {
        if (n_in != 20 || ws_size < WS_END) { fprintf(stderr, "kernel_launch: unexpected n_in %d or ws_size %zu (< %zu)\n", n_in, ws_size, (size_t)WS_END); grid = -1; return; }
        int dev = 0, cus = 0, per_cu = 0;
        hipGetDevice(&dev);
        hipDeviceGetAttribute(&cus, hipDeviceAttributeMultiprocessorCount, dev);
        if (hipFuncSetAttribute((const void*)mega, hipFuncAttributeMaxDynamicSharedMemorySize, LDS_BYTES) != hipSuccess) { fprintf(stderr, "kernel_launch: hipFuncSetAttribute failed\n"); grid = -1; return; }
        if (hipOccupancyMaxActiveBlocksPerMultiprocessor(&per_cu, (const void*)mega, 512, LDS_BYTES) != hipSuccess || per_cu < 1) { fprintf(stderr, "kernel_launch: occupancy query says %d\n", per_cu); per_cu = 1; }
        (void)hipGetLastError();
        grid = cus;
    }
    if (grid < 0) return;
    if (hipMemsetAsync((unsigned char*)d_ws + OFF_BAR, 0, 256, stream) != hipSuccess) { fprintf(stderr, "kernel_launch: memset failed\n"); return; }
    KArgs ka{};
    for (int i = 0; i < 20; ++i) ka.in[i] = (const float*)d_in[i];
    ka.out = (float*)d_out; ka.ws = (unsigned char*)d_ws;
    int lo = 0, hi = N_PHASES;
    void* args[] = {&ka, &lo, &hi};
    hipError_t e = hipLaunchCooperativeKernel((const void*)mega, dim3(grid), dim3(512), args, LDS_BYTES, stream);
    if (e != hipSuccess) fprintf(stderr, "kernel_launch: cooperative launch failed: %s (grid %d)\n", hipGetErrorString(e), grid);
}
```

```cpp
#include <hip/hip_runtime.h>
#include <hip/hip_cooperative_groups.h>
#include <cstdio>
namespace cg = cooperative_groups;

#define LAS __attribute__((address_space(3)))
typedef unsigned short u16;
typedef short bf16x8 __attribute__((ext_vector_type(8)));
typedef float f32x4 __attribute__((ext_vector_type(4)));
typedef unsigned u32x4 __attribute__((ext_vector_type(4)));
typedef unsigned u32x2 __attribute__((ext_vector_type(2)));
typedef float f32x3 __attribute__((ext_vector_type(3)));

constexpr int D = 2048, DEPTH = 2;
constexpr int CTXROWS = 512, MROWS = 16896;
constexpr int NIN = 13408, NPAD = 13568, PW = 13312, GDW = 96, QW = 5120, G2W = 176;
constexpr float LN_EPS = 1e-5f;
constexpr float ALPHA = 1.4142135623730951f;
constexpr int LDS_BYTES = 139264;

constexpr size_t SZ_WTIN1 = (size_t)NPAD * 2048 * 2, SZ_WTOUT1 = (size_t)2048 * 4096 * 2, SZ_WL = SZ_WTIN1 + SZ_WTOUT1;
constexpr size_t SZ_P = (size_t)MROWS * PW * 2, SZ_GD = (size_t)MROWS * GDW * 4, SZ_U = (size_t)MROWS * 2048 * 2;
constexpr size_t SZ_QKX = (size_t)MROWS * QW * 2, SZ_MOD = (size_t)DEPTH * 3 * 6144 * 4, SZ_RC = (size_t)CTXROWS * 2048 * 4;
constexpr size_t OFF_W = 0, OFF_P = OFF_W + DEPTH * SZ_WL, OFF_GD = OFF_P + SZ_P, OFF_U = OFF_GD + SZ_GD,
                 OFF_QKX = OFF_U + SZ_U, OFF_MOD = OFF_QKX + SZ_QKX, OFF_RC = OFF_MOD + SZ_MOD, OFF_BAR = OFF_RC + SZ_RC, OFF_G2 = OFF_BAR + 256, WS_END = OFF_G2 + (size_t)MROWS * 176 * 4 + 256;

struct Params {
    const float *x, *c, *ctx, *c_ctx, *w_ada, *b_ada, *w_in, *conv_qk_w, *conv_qk_b, *gate_b, *mh_w, *conv_xbc_w, *conv_xbc_b, *dt_bias, *a_log, *d_skip,
        *ssm_w, *w_out, *ln_g, *ln_b;
    float* out;
    u16 *wt_in, *wt_out, *P, *U, *QKX, *HB, *YB;
    float *GD, *MOD, *RC, *G2;
};
struct KArgs { const float* in[20]; float* out; unsigned char* ws; };
template <int IDX> __device__ __forceinline__ const void* kload() {
    unsigned long r;
    asm volatile("s_load_dwordx2 %0, %1, %2\n\ts_waitcnt lgkmcnt(0)" : "=s"(r) : "s"(__builtin_amdgcn_kernarg_segment_ptr()), "n"(IDX * 8) : "memory");
    return (const void*)(const __attribute__((address_space(1))) char*)r;
}
#define KIN(i) ((const float*)kload<(i)>())
#define KOUT() ((float*)kload<20>())
#define KWS() ((unsigned char*)kload<21>())

__device__ __forceinline__ int tid_() { int t = threadIdx.x; asm volatile("" : "+v"(t)); return t; }
__device__ __forceinline__ int bid_() { int b = blockIdx.x; asm volatile("" : "+s"(b)); return b; }
__device__ __forceinline__ int gdim_() { int g = gridDim.x; asm volatile("" : "+s"(g)); return g; }
#define TIDX tid_()
#define BIDX bid_()
#define GDIM gdim_()

typedef float f32x2_t __attribute__((ext_vector_type(2)));
typedef __bf16 bf16x2_t __attribute__((ext_vector_type(2)));
__device__ __forceinline__ u16 f2bf(float f) { return __builtin_bit_cast(u16, (__bf16)f); }
__device__ __forceinline__ float bf2f(unsigned h) { return __uint_as_float(h << 16); }
__device__ __forceinline__ float bflo(unsigned w) { return __uint_as_float(w << 16); }
__device__ __forceinline__ float bfhi(unsigned w) { return __uint_as_float(w & 0xFFFF0000u); }
__device__ __forceinline__ unsigned pk2(float lo, float hi) { const f32x2_t v = {lo, hi}; return __builtin_bit_cast(unsigned, __builtin_convertvector(v, bf16x2_t)); }
__device__ __forceinline__ unsigned cvt_pk_bf16(float lo, float hi) { unsigned r; asm volatile("v_cvt_pk_bf16_f32 %0, %1, %2" : "=v"(r) : "v"(lo), "v"(hi)); return r; }
__device__ __forceinline__ float wsum(float v) {
#pragma unroll
    for (int o = 32; o > 0; o >>= 1) v += __shfl_xor(v, o, 64);
    return v;
}
__device__ __forceinline__ float siluf(float v) { return v / (1.f + __expf(-v)); }
__device__ __forceinline__ float sigmf(float v) { return 1.f / (1.f + __expf(-v)); }
__device__ __forceinline__ float scan_add(float v, int lane) {
#pragma unroll
    for (int d = 1; d < 64; d <<= 1) { float t = __shfl_up(v, d, 64); if (lane >= d) v += t; }
    return v;
}
__device__ __forceinline__ float scan_max(float v, int lane) {
#pragma unroll
    for (int d = 1; d < 64; d <<= 1) { float t = __shfl_up(v, d, 64); if (lane >= d) v = fmaxf(v, t); }
    return v;
}
__device__ __forceinline__ int src_col(int n) {
    if (n < 8192) return n;
    if (n < 11264) return n + 32;
    if (n < 13312) return n + 96;
    if (n < 13344) return n - 5120;
    if (n < 13408) return n - 2048;
    return -1;
}

namespace pg8 {
constexpr int BM = 256, BK = 64, HALF = 128, HTB = HALF * BK * 2, STAGE_BYTES = 8 * HTB, NXCD = 8, WGM = 8;
__host__ __device__ __forceinline__ int lds_byte(int r, int c) { const int st = (r >> 4) * 2 + (c >> 5), rr = r & 15, cc = c & 31, ob = rr * 64 + cc * 2; return st * 1024 + (ob ^ (((ob >> 9) & 1) << 5)); }
__host__ __device__ __forceinline__ void stage_rc(int b, int& R, int& C) { const int st = b / 1024, sb = b % 1024, swz = sb ^ (((sb >> 9) & 1) << 5); R = (st >> 1) * 16 + swz / 64; C = (st & 1) * 32 + (swz % 64) / 2; }
__host__ __device__ __forceinline__ int perm32(int rho) { const int n = rho >> 4, i = rho & 15; return 8 * (i >> 2) + 4 * n + (i & 3); }
struct Unit { int pm, pn; };
struct Gemm { const u16* A; const u16* Bt; int M, N, K, lda; };
struct StaticOrder {
    int nM, nN, nwg, G, c;
    __device__ void init(int M, int N, int G_, int c_) { nM = M / BM; nN = N / BM; nwg = nM * nN; G = G_; c = c_; }
    __device__ bool next(int i, Unit& u) const {
        const long L = (long)i * G + c; if (L >= nwg) return false;
        int wgid = (int)L; { const int q = nwg / NXCD, r = nwg % NXCD, xcd = wgid % NXCD, off = wgid / NXCD; wgid = (xcd < r ? xcd * (q + 1) : r * (q + 1) + (xcd - r) * q) + off; }
        const int nig = WGM * nN, gid = wgid / nig, fm = gid * WGM, gsz = (nM - fm) < WGM ? (nM - fm) : WGM;
        u.pm = fm + ((wgid % nig) % gsz); u.pn = (wgid % nig) / gsz; return true;
    }
};

template <class Epi>
__device__ __forceinline__ void gemm_phase(LAS unsigned char* lds, const Gemm g, const StaticOrder& S, const Epi& E) {
    const int tid = TIDX, wid = __builtin_amdgcn_readfirstlane(tid >> 6), lane = tid & 63, wr = wid >> 2, wc = wid & 3, fr = lane & 15, fq = lane >> 4;
    const int K = g.K, nt = K / BK, lda = g.lda;
    unsigned voffA[2], voffB[2];
#pragma unroll
    for (int i = 0; i < 2; ++i) { int R, C; stage_rc(tid * 16 + i * 8192, R, C); const int Rb = Epi::PERM ? ((R & ~31) + perm32(R & 31)) : R;
        voffA[i] = (unsigned)(R * lda + C) * 2u; voffB[i] = (unsigned)(Rb * K + C) * 2u; }
    const size_t kstep = (size_t)(BK * 2);
    const size_t hA = (size_t)HALF * lda * 2, hB = (size_t)HALF * K * 2;
    const size_t tA = 2 * hA, tB = 2 * hB;
    const unsigned ldsw = (unsigned)wid * 1024u;
    const int aoff = lds_byte(wr * 64 + fr, fq * 8), boff = lds_byte(wc * 32 + fr, fq * 8);
#define PG8_SA(b, h) (((b) * 2 + (h)) * HTB)
#define PG8_SB(b, h) ((4 + (b) * 2 + (h)) * HTB)
#define PG8_STAGE(bufoff, gbase, voff) do { _Pragma("unroll") for (int _i = 0; _i < 2; ++_i) \
        __builtin_amdgcn_global_load_lds((const unsigned*)((const char*)(gbase) + (voff)[_i]), (LAS unsigned*)(lds + (bufoff) + ldsw + _i * 8192), 16, 0, 0); } while (0)
#define PG8_LDA(dst, b, h) do { _Pragma("unroll") for (int m = 0; m < 4; ++m) _Pragma("unroll") for (int k = 0; k < 2; ++k) dst[m][k] = *(const LAS bf16x8*)(lds + PG8_SA(b, h) + aoff + m * 2048 + k * 1024); } while (0)
#define PG8_LDB(dst, b, h) do { _Pragma("unroll") for (int n = 0; n < 2; ++n) _Pragma("unroll") for (int k = 0; k < 2; ++k) dst[n][k] = *(const LAS bf16x8*)(lds + PG8_SB(b, h) + boff + n * 2048 + k * 1024); } while (0)
#define PG8_MMA(ai, bj, At, Bt) do { __builtin_amdgcn_s_setprio(1); _Pragma("unroll") for (int m = 0; m < 4; ++m) _Pragma("unroll") for (int n = 0; n < 2; ++n) _Pragma("unroll") for (int k = 0; k < 2; ++k) \
        acc[ai][bj][m][n] = __builtin_amdgcn_mfma_f32_16x16x32_bf16(Bt[n][k], At[m][k], acc[ai][bj][m][n], 0, 0, 0); __builtin_amdgcn_s_setprio(0); } while (0)
#define PG8_WAIT_V(n) asm volatile("s_waitcnt vmcnt(" #n ")" ::: "memory")
#define PG8_WAIT_L(n) asm volatile("s_waitcnt lgkmcnt(" #n ")" ::: "memory")
#define PG8_BAR __builtin_amdgcn_s_barrier()
#define PG8_SCHED __builtin_amdgcn_sched_barrier(0)
    Unit cur, nxt; int ui = 0;
    if (!S.next(0, cur)) return;
    f32x4 acc[2][2][4][2];
#pragma unroll
    for (int a = 0; a < 2; ++a)
#pragma unroll
        for (int b = 0; b < 2; ++b)
#pragma unroll
            for (int m = 0; m < 4; ++m)
#pragma unroll
                for (int n = 0; n < 2; ++n) acc[a][b][m][n] = (f32x4){0.f, 0.f, 0.f, 0.f};
    bf16x8 At[4][2], B0[2][2], B1[2][2];
    const char* cA = (const char*)g.A + (size_t)cur.pm * tA; const char* cB = (const char*)g.Bt + (size_t)cur.pn * tB;
    PG8_STAGE(PG8_SB(0, 0), cB, voffB); PG8_STAGE(PG8_SA(0, 0), cA, voffA); PG8_STAGE(PG8_SB(0, 1), cB + hB, voffB); PG8_STAGE(PG8_SA(0, 1), cA + hA, voffA);
    if (wr == 1) PG8_BAR;
    PG8_WAIT_V(4); PG8_BAR;
    PG8_STAGE(PG8_SB(1, 0), cB + kstep, voffB); PG8_STAGE(PG8_SA(1, 0), cA + kstep, voffA); PG8_STAGE(PG8_SB(1, 1), cB + hB + kstep, voffB);
    PG8_WAIT_V(6); PG8_BAR;
    for (;;) {
        const bool has_next = S.next(ui + 1, nxt);
        const char* nA = has_next ? (const char*)g.A + (size_t)nxt.pm * tA : cA; const char* nB = has_next ? (const char*)g.Bt + (size_t)nxt.pn * tB : cB;
        for (int t = 0; t < nt; t += 2) {
            const bool last = (t == nt - 2);
            const char* a1 = cA + (size_t)(t + 1) * kstep;
            const char* a2 = last ? nA : cA + (size_t)(t + 2) * kstep; const char* b2 = last ? nB : cB + (size_t)(t + 2) * kstep;
            const char* a3 = a2 + kstep; const char* b3 = b2 + kstep;
            PG8_LDB(B0, 0, 0); PG8_SCHED; PG8_LDA(At, 0, 0); PG8_STAGE(PG8_SA(1, 1), a1 + hA, voffA);
            PG8_WAIT_L(8); PG8_BAR; PG8_WAIT_L(0); PG8_MMA(0, 0, At, B0); PG8_BAR; PG8_SCHED;
            PG8_LDB(B1, 0, 1); PG8_STAGE(PG8_SB(0, 0), b2, voffB);
            PG8_BAR; PG8_WAIT_L(0); PG8_MMA(0, 1, At, B1); PG8_BAR;
            PG8_LDA(At, 0, 1); PG8_STAGE(PG8_SA(0, 0), a2, voffA);
            PG8_BAR; PG8_WAIT_L(0); PG8_MMA(1, 0, At, B0); PG8_BAR; PG8_SCHED;
            PG8_STAGE(PG8_SB(0, 1), b2 + hB, voffB);
            PG8_WAIT_V(6); PG8_BAR; PG8_MMA(1, 1, At, B1); PG8_BAR;
            PG8_LDB(B0, 1, 0); PG8_SCHED; PG8_LDA(At, 1, 0); PG8_STAGE(PG8_SA(0, 1), a2 + hA, voffA);
            PG8_WAIT_L(8); PG8_BAR; PG8_WAIT_L(0); PG8_MMA(0, 0, At, B0); PG8_BAR; PG8_SCHED;
            PG8_LDB(B1, 1, 1); PG8_STAGE(PG8_SB(1, 0), b3, voffB);
            PG8_BAR; PG8_WAIT_L(0); PG8_MMA(0, 1, At, B1); PG8_BAR;
            PG8_LDA(At, 1, 1); PG8_STAGE(PG8_SA(1, 0), a3, voffA);
            PG8_BAR; PG8_WAIT_L(0); PG8_MMA(1, 0, At, B0); PG8_BAR; PG8_SCHED;
            PG8_STAGE(PG8_SB(1, 1), b3 + hB, voffB);
            PG8_WAIT_V(6); PG8_BAR; PG8_MMA(1, 1, At, B1); PG8_BAR;
        }
        E(acc, cur, wr, wc, fr, fq);
        if (!has_next) break;
#pragma unroll
        for (int a = 0; a < 2; ++a)
#pragma unroll
            for (int b = 0; b < 2; ++b)
#pragma unroll
                for (int m = 0; m < 4; ++m)
#pragma unroll
                    for (int n = 0; n < 2; ++n) acc[a][b][m][n] = (f32x4){0.f, 0.f, 0.f, 0.f};
        cur = nxt; cA = nA; cB = nB; ++ui;
    }
    PG8_WAIT_V(0);
    if (wr == 0) PG8_BAR;
    PG8_BAR;
#undef PG8_SA
#undef PG8_SB
#undef PG8_STAGE
#undef PG8_LDA
#undef PG8_LDB
#undef PG8_MMA
#undef PG8_WAIT_V
#undef PG8_WAIT_L
#undef PG8_BAR
#undef PG8_SCHED
}
}

struct EpiG1 {
    static constexpr bool PERM = true;
    u16* P; float* GD;
    __device__ __forceinline__ void operator()(const f32x4 (&acc)[2][2][4][2], const pg8::Unit& u, int wr, int wc, int fr, int fq) const {
        const int row0 = u.pm * 256 + wr * 64 + fr;
        if (u.pn < 52) {
            const int col0 = u.pn * 256 + wc * 32 + 8 * fq;
#pragma unroll
            for (int ai = 0; ai < 2; ++ai)
#pragma unroll
                for (int m = 0; m < 4; ++m) { u16* rowp = P + (size_t)(row0 + ai * 128 + m * 16) * PW + col0;
#pragma unroll
                    for (int bj = 0; bj < 2; ++bj) { const f32x4 v0 = acc[ai][bj][m][0], v1 = acc[ai][bj][m][1];
                        u32x4 w; w.x = cvt_pk_bf16(v0[0], v0[1]); w.y = cvt_pk_bf16(v0[2], v0[3]); w.z = cvt_pk_bf16(v1[0], v1[1]); w.w = cvt_pk_bf16(v1[2], v1[3]);
                        *(u32x4*)(rowp + bj * 128) = w; } }
        } else if (wc < 3) {
            const int cc0 = wc * 32 + 8 * fq;
#pragma unroll
            for (int ai = 0; ai < 2; ++ai)
#pragma unroll
                for (int m = 0; m < 4; ++m) { float* rowp = GD + (size_t)(row0 + ai * 128 + m * 16) * GDW + cc0;
                    *(f32x4*)(rowp) = acc[ai][0][m][0]; *(f32x4*)(rowp + 4) = acc[ai][0][m][1]; }
        }
    }
};
struct EpiG2 {
    static constexpr bool PERM = false;
    const float* xres_lat; const float* xres_ctx; float* dst_lat; float* dst_ctx; const float* modl; int row_off;
    __device__ __forceinline__ void operator()(const f32x4 (&acc)[2][2][4][2], const pg8::Unit& u, int wr, int wc, int fr, int fq) const {
        const int g0 = u.pm * 256 + row_off;
        const bool isctx = g0 < CTXROWS;
        const int b = isctx ? (g0 >> 8) : ((g0 - CTXROWS) >> 13);
        const float* gate = modl + (size_t)(isctx ? 2 : b) * 6144 + 4096;
        const float* xr = isctx ? xres_ctx + (size_t)g0 * D : xres_lat + (size_t)(g0 - CTXROWS) * D;
        float* ds = isctx ? dst_ctx + (size_t)g0 * D : dst_lat + (size_t)(g0 - CTXROWS) * D;
        const int col0 = u.pn * 256 + wc * 32 + 4 * fq;
        f32x4 gv[2][2];
#pragma unroll
        for (int bj = 0; bj < 2; ++bj)
#pragma unroll
            for (int n = 0; n < 2; ++n) gv[bj][n] = *(const f32x4*)(gate + col0 + bj * 128 + n * 16);
#pragma unroll
        for (int ai = 0; ai < 2; ++ai)
#pragma unroll
            for (int m = 0; m < 4; ++m) { const size_t ro = (size_t)(wr * 64 + fr + ai * 128 + m * 16) * D + col0;
#pragma unroll
                for (int bj = 0; bj < 2; ++bj)
#pragma unroll
                    for (int n = 0; n < 2; ++n) { const f32x4 xv = *(const f32x4*)(xr + ro + bj * 128 + n * 16);
                        *(f32x4*)(ds + ro + bj * 128 + n * 16) = xv * ALPHA + gv[bj][n] * acc[ai][bj][m][n]; } }
    }
};

struct TrTile { const float* src; u16* dst; int Nsrc, K, n0, k0, perm; };
__device__ __forceinline__ void tr_load(const TrTile& t, float (&v)[8], int tid) {
    const int nl = tid & 63, kb = tid >> 6; const int n = t.n0 + nl; const int sc = t.perm ? src_col(n) : n;
#pragma unroll
    for (int i = 0; i < 8; ++i) { const int kl = i * 8 + kb; v[i] = sc >= 0 ? t.src[(size_t)(t.k0 + kl) * t.Nsrc + sc] : 0.f; }
}
__device__ __forceinline__ void tr_to_lds(const float (&v)[8], float* sf, int tid) {
    const int nl = tid & 63, kb = tid >> 6;
#pragma unroll
    for (int i = 0; i < 8; ++i) sf[(i * 8 + kb) * 65 + nl] = v[i];
}
__device__ __forceinline__ void tr_store(const TrTile& t, const float* sf, int tid) {
    const int nl2 = tid >> 3, kc = (tid & 7) * 8;
    u32x4 w;
    w.x = pk2(sf[(kc + 0) * 65 + nl2], sf[(kc + 1) * 65 + nl2]); w.y = pk2(sf[(kc + 2) * 65 + nl2], sf[(kc + 3) * 65 + nl2]);
    w.z = pk2(sf[(kc + 4) * 65 + nl2], sf[(kc + 5) * 65 + nl2]); w.w = pk2(sf[(kc + 6) * 65 + nl2], sf[(kc + 7) * 65 + nl2]);
    *(u32x4*)(t.dst + (size_t)(t.n0 + nl2) * t.K + t.k0 + kc) = w;
}
__device__ __forceinline__ TrTile tr_tile(const Params& p, int t) {
    constexpr int T_IN = (NPAD / 64) * 32, T_OUT = 32 * 64;
    const int l = t / (T_IN + T_OUT), r = t % (T_IN + T_OUT);
    TrTile o;
    if (r < T_IN) { o.src = p.w_in + (size_t)l * 2048 * NIN; o.dst = p.wt_in + (size_t)l * (SZ_WL / 2); o.Nsrc = NIN; o.K = 2048; o.n0 = (r >> 5) * 64; o.k0 = (r & 31) * 64; o.perm = 1; }
    else { const int r2 = r - T_IN; o.src = p.w_out + (size_t)l * 4096 * 2048; o.dst = p.wt_out + (size_t)l * (SZ_WL / 2); o.Nsrc = 2048; o.K = 4096; o.n0 = (r2 >> 6) * 64; o.k0 = (r2 & 63) * 64; o.perm = 0; }
    return o;
}

__device__ void weight_tiles(const Params& p, float* sf, int l) {
    constexpr int T_L = (NPAD / 64) * 32 + 32 * 64;
    const int tid = TIDX, gd = GDIM;
    const int t_end = (l + 1) * T_L;
    int t = l * T_L + BIDX;
    float v[8];
    __syncthreads();
    if (t < t_end) { const TrTile c0 = tr_tile(p, t); tr_load(c0, v, tid); }
    while (t < t_end) {
        tr_to_lds(v, sf, tid);
        __syncthreads();
        const int tn = t + gd;
        if (tn < t_end) { const TrTile nxt = tr_tile(p, tn); tr_load(nxt, v, tid); }
        { const TrTile cur = tr_tile(p, t); tr_store(cur, sf, tid); }
        __syncthreads();
        t = tn;
    }
}

__device__ void phase_a(const Params& p, unsigned char* lds) {
    float* sf = (float*)lds;
    const int tid = TIDX;
    if (BIDX < 192) {
        for (int i = tid; i < 3 * 2048; i += 512) { const int r = i >> 11, k = i & 2047; const float v = r < 2 ? p.c[r * 2048 + k] : p.c_ctx[k]; sf[i] = siluf(v); }
        __syncthreads();
    }
    for (int t = BIDX; t < 192; t += GDIM) {
        const int l = t / 96, cb = t % 96; const int col = cb * 64 + (tid & 63); const int kg = tid >> 6;
        const float* w = p.w_ada + (size_t)l * 2048 * 6144 + col;
        float a0 = 0.f, a1 = 0.f, a2 = 0.f;
#pragma unroll 8
        for (int k = kg * 256; k < kg * 256 + 256; ++k) { const float wv = w[(size_t)k * 6144]; a0 += sf[k] * wv; a1 += sf[2048 + k] * wv; a2 += sf[4096 + k] * wv; }
        float* red = sf + 6144;
        red[(kg * 3 + 0) * 64 + (tid & 63)] = a0; red[(kg * 3 + 1) * 64 + (tid & 63)] = a1; red[(kg * 3 + 2) * 64 + (tid & 63)] = a2;
        __syncthreads();
        if (tid < 192) { const int r = tid >> 6, cc = tid & 63; float s = 0.f;
#pragma unroll
            for (int g = 0; g < 8; ++g) s += red[(g * 3 + r) * 64 + cc];
            const int col2 = cb * 64 + cc; p.MOD[(size_t)(l * 3 + r) * 6144 + col2] = s + p.b_ada[l * 6144 + col2]; }
        __syncthreads();
    }
    __syncthreads();
    weight_tiles(p, sf, 0);
}

__device__ __forceinline__ void row_stats(const f32x4 (&v)[8], float& mean, float& rstd) {
    float s = 0.f;
#pragma unroll
    for (int i = 0; i < 8; ++i) s += v[i][0] + v[i][1] + v[i][2] + v[i][3];
    mean = wsum(s) * (1.f / 2048.f);
    float q = 0.f;
#pragma unroll
    for (int i = 0; i < 8; ++i) { const f32x4 d = v[i] - mean; q += d[0] * d[0] + d[1] * d[1] + d[2] * d[2] + d[3] * d[3]; }
    rstd = rsqrtf(wsum(q) * (1.f / 2048.f) + LN_EPS);
}
__device__ void phase_ln(const Params& p, int l) {
    const int wid = TIDX >> 6, lane = TIDX & 63;
    const int nw = GDIM * 8;
    const bool fin = (l == DEPTH);
    for (int row = BIDX * 8 + wid; row < MROWS; row += nw) {
        const bool isctx = row < CTXROWS;
        if (fin && isctx) continue;
        const int b = isctx ? (row >> 8) : ((row - CTXROWS) >> 13);
        float* rw = isctx ? p.RC + (size_t)row * D : p.out + (size_t)(row - CTXROWS) * D;
        const float* src = (l == 0) ? (isctx ? p.ctx + (size_t)row * D : p.x + (size_t)(row - CTXROWS) * D) : rw;
        f32x4 v[8];
#pragma unroll
        for (int i = 0; i < 8; ++i) v[i] = *(const f32x4*)(src + i * 256 + lane * 4);
        float mean, rstd;
        if (l > 0) {
            row_stats(v, mean, rstd);
            const float* g = p.ln_g + (size_t)(l - 1) * D; const float* bb = p.ln_b + (size_t)(l - 1) * D;
#pragma unroll
            for (int i = 0; i < 8; ++i) { const f32x4 gv = *(const f32x4*)(g + i * 256 + lane * 4), bv = *(const f32x4*)(bb + i * 256 + lane * 4);
                v[i] = (v[i] - mean) * rstd * gv + bv; *(f32x4*)(rw + i * 256 + lane * 4) = v[i]; }
        }
        if (fin) continue;
        row_stats(v, mean, rstd);
        const float* md = p.MOD + (size_t)(l * 3 + (isctx ? 2 : b)) * 6144;
        u16* ur = p.U + (size_t)row * 2048;
#pragma unroll
        for (int i = 0; i < 8; ++i) { const f32x4 sh = *(const f32x4*)(md + i * 256 + lane * 4), sc = *(const f32x4*)(md + 2048 + i * 256 + lane * 4);
            const f32x4 o = (v[i] - mean) * rstd * (sc + 1.f) + sh;
            u32x2 w; w.x = pk2(o[0], o[1]); w.y = pk2(o[2], o[3]);
            *(u32x2*)(ur + i * 256 + lane * 4) = w; }
    }
}

template <bool ISM> __device__ __forceinline__ int scan_row(int b, int dir, int cc, int i) {
    const bool isctx = cc < 2; const int p0 = isctx ? cc * 128 : (cc - 2) * 128; const int slen = isctx ? 256 : 8192; const int rowbase = isctx ? b * 256 : CTXROWS + b * 8192;
    const int s = dir ? slen - 1 - (p0 + i) : p0 + i;
    return rowbase + ((ISM || isctx) ? s : ((s & 127) * 64 + (s >> 7)));
}

__device__ void phase_conv(const Params& p, int l) {
    const int tid = TIDX;
    {
        const int wv = tid >> 6, lane = tid & 63;
        const int nwv = GDIM * 8;
        for (int task = BIDX * 8 + wv; task < 2 * 2 * 66 * 40; task += nwv) {
            const int hd = task % 40; int r = task / 40; const int cc = r % 66; r /= 66; const int dir = r & 1, b = r >> 1;
            if (hd < 8) {
                const int h = hd; const int row0 = scan_row<true>(b, dir, cc, 2 * lane), row1 = scan_row<true>(b, dir, cc, 2 * lane + 1);
                const float gbi = p.gate_b[l * 32 + (dir * 2) * 8 + h], gbf = p.gate_b[l * 32 + (dir * 2 + 1) * 8 + h];
                const float li0 = p.GD[(size_t)row0 * GDW + (dir * 2) * 8 + h] + gbi, li1 = p.GD[(size_t)row1 * GDW + (dir * 2) * 8 + h] + gbi;
                const float x0 = p.GD[(size_t)row0 * GDW + (dir * 2 + 1) * 8 + h] + gbf, x1 = p.GD[(size_t)row1 * GDW + (dir * 2 + 1) * 8 + h] + gbf;
                const float lf0 = fminf(x0, 0.f) - log1pf(__expf(-fabsf(x0))), lf1 = fminf(x1, 0.f) - log1pf(__expf(-fabsf(x1)));
                const float a1 = lf0 + lf1;
                const float inc = scan_add(a1, lane); const float exc = inc - a1;
                const float b0 = exc + lf0, b1 = exc + a1;
                const float u0 = li0 - b0, u1 = li1 - b1;
                const float incm = scan_max(fmaxf(u0, u1), lane); float excm = __shfl_up(incm, 1, 64); if (lane == 0) excm = -3.0e38f;
                const float M0 = fmaxf(excm, u0), M1 = fmaxf(M0, u1);
                float* o0 = p.G2 + (size_t)row0 * G2W + (dir * 8 + h) * 3; float* o1 = p.G2 + (size_t)row1 * G2W + (dir * 8 + h) * 3;
                o0[0] = b0; o0[1] = u0; o0[2] = M0; o1[0] = b1; o1[1] = u1; o1[2] = M1;
            } else {
                const int hh = hd - 8; const int row0 = scan_row<false>(b, dir, cc, 2 * lane), row1 = scan_row<false>(b, dir, cc, 2 * lane + 1);
                const float dtb = p.dt_bias[(l * 2 + dir) * 32 + hh]; const float Ah = -__expf(p.a_log[(l * 2 + dir) * 32 + hh]);
                const float r0 = p.GD[(size_t)row0 * GDW + 32 + dir * 32 + hh] + dtb, r1 = p.GD[(size_t)row1 * GDW + 32 + dir * 32 + hh] + dtb;
                const float dt0 = fmaxf(r0, 0.f) + log1pf(__expf(-fabsf(r0))), dt1 = fmaxf(r1, 0.f) + log1pf(__expf(-fabsf(r1)));
                const float d0 = dt0 * Ah, d1 = dt1 * Ah;
                const float a1 = d0 + d1;
                const float inc = scan_add(a1, lane); const float exc = inc - a1;
                float* o0 = p.G2 + (size_t)row0 * G2W + 48 + (dir * 32 + hh) * 2; float* o1 = p.G2 + (size_t)row1 * G2W + 48 + (dir * 32 + hh) * 2;
                o0[0] = dt0; o0[1] = exc + d0; o1[0] = dt1; o1[1] = exc + a1;
            }
        }
    }
    const int ci = tid & 127, rs = tid >> 7;
    for (int t = BIDX; t < 528 * 5; t += GDIM) {
        const int cgp = t % 5, rg = t / 5;
        int pcol, ocol, wstride; const float *w, *bias; bool isx; float scale = 1.f;
        if (cgp < 2) { const int c = (cgp * 128 + ci) * 8; pcol = c; ocol = c; w = p.conv_qk_w + (size_t)l * 3 * 2048 + c; bias = p.conv_qk_b + (size_t)l * 2048 + c; wstride = 2048; isx = false;
            if (c < 1024) scale = 0.08838834764831845f; }
        else { const int c = ((cgp - 2) * 128 + ci) * 8; pcol = 8192 + c; ocol = 2048 + c; w = p.conv_xbc_w + (size_t)l * 3 * 3072 + c; bias = p.conv_xbc_b + (size_t)l * 3072 + c; wstride = 3072; isx = true; }
        float w0[8], w1[8], w2[8], bb[8];
#pragma unroll
        for (int e = 0; e < 8; ++e) { w0[e] = w[e]; w1[e] = w[wstride + e]; w2[e] = w[2 * wstride + e]; bb[e] = bias[e]; }
        const int r0 = rg * 32 + rs * 8;
        const bool lat = r0 >= CTXROWS;
        const int seqbase = lat ? (CTXROWS + (((r0 - CTXROWS) >> 13) << 13)) : (r0 & ~255);
        const int seqlen = lat ? 8192 : 256;
        const int sp0 = r0 - seqbase;
        const bool cm = lat && isx;
        u32x4 win[10];
#pragma unroll
        for (int i = 0; i < 10; ++i) { const int sp = sp0 - 1 + i;
            const int row = seqbase + (cm ? ((sp & 127) * 64 + (sp >> 7)) : sp);
            win[i] = (sp >= 0 && sp < seqlen) ? *(const u32x4*)(p.P + (size_t)row * PW + pcol) : (u32x4){0u, 0u, 0u, 0u}; }
#pragma unroll
        for (int i = 0; i < 8; ++i) { const int sp = sp0 + i;
            const int row = seqbase + (cm ? ((sp & 127) * 64 + (sp >> 7)) : sp);
            const u32x4 ap = win[i], a = win[i + 1], an = win[i + 2];
            u32x4 o;
#pragma unroll
            for (int e2 = 0; e2 < 4; ++e2) {
                const float y0 = w0[2 * e2] * bflo(ap[e2]) + w1[2 * e2] * bflo(a[e2]) + w2[2 * e2] * bflo(an[e2]) + bb[2 * e2];
                const float y1 = w0[2 * e2 + 1] * bfhi(ap[e2]) + w1[2 * e2 + 1] * bfhi(a[e2]) + w2[2 * e2 + 1] * bfhi(an[e2]) + bb[2 * e2 + 1];
                o[e2] = pk2(siluf(y0) * scale, siluf(y1) * scale);
            }
            *(u32x4*)(p.QKX + (size_t)row * QW + ocol) = o;
        }
    }
}

constexpr int LDK = 136, LDV = 88;
constexpr int LS_K = 0, LS_V = 34816, LS_VW = LS_V + 128 * LDV * 2, LS_CT = LS_VW + 128 * LDV * 2, LS_F = LS_CT + 80 * LDK * 2;

#define LDS_BAR() do { asm volatile("s_waitcnt lgkmcnt(0)" ::: "memory"); __builtin_amdgcn_s_barrier(); asm volatile("" ::: "memory"); } while (0)
#define TR_RD8(r0, r1, r2, r3, r4, r5, r6, r7, base, o0, o1, o2, o3, o4, o5, o6, o7) \
    asm volatile("ds_read_b64_tr_b16 %0, %8 offset:%9\n\tds_read_b64_tr_b16 %1, %8 offset:%10\n\tds_read_b64_tr_b16 %2, %8 offset:%11\n\tds_read_b64_tr_b16 %3, %8 offset:%12\n\t" \
                 "ds_read_b64_tr_b16 %4, %8 offset:%13\n\tds_read_b64_tr_b16 %5, %8 offset:%14\n\tds_read_b64_tr_b16 %6, %8 offset:%15\n\tds_read_b64_tr_b16 %7, %8 offset:%16\n\ts_waitcnt lgkmcnt(0)" \
                 : "=&v"(r0), "=&v"(r1), "=&v"(r2), "=&v"(r3), "=&v"(r4), "=&v"(r5), "=&v"(r6), "=&v"(r7) \
                 : "v"(base), "n"(o0), "n"(o1), "n"(o2), "n"(o3), "n"(o4), "n"(o5), "n"(o6), "n"(o7) : "memory")
#define TR_RD2(r0, r1, base, o0, o1) \
    asm volatile("ds_read_b64_tr_b16 %0, %2 offset:%3\n\tds_read_b64_tr_b16 %1, %2 offset:%4\n\ts_waitcnt lgkmcnt(0)" : "=&v"(r0), "=&v"(r1) : "v"(base), "n"(o0), "n"(o1) : "memory")
#define TR_ST10(K0_, K1_, A0_, A1_, A2_, A3_, A4_, A5_, A6_, A7_, BK_, BV_, OK0_, OK1_, OV0_, OV1_, OV2_, OV3_, OV4_, OV5_, OV6_, OV7_) \
    asm volatile("ds_read_b64_tr_b16 %[rk0], %[bk] offset:%[ok0]\n\tds_read_b64_tr_b16 %[rk1], %[bk] offset:%[ok1]\n\t" \
                 "ds_read_b64_tr_b16 %[ra0], %[bv] offset:%[ov0]\n\tds_read_b64_tr_b16 %[ra1], %[bv] offset:%[ov1]\n\tds_read_b64_tr_b16 %[ra2], %[bv] offset:%[ov2]\n\tds_read_b64_tr_b16 %[ra3], %[bv] offset:%[ov3]\n\t" \
                 "ds_read_b64_tr_b16 %[ra4], %[bv] offset:%[ov4]\n\tds_read_b64_tr_b16 %[ra5], %[bv] offset:%[ov5]\n\tds_read_b64_tr_b16 %[ra6], %[bv] offset:%[ov6]\n\tds_read_b64_tr_b16 %[ra7], %[bv] offset:%[ov7]\n\ts_waitcnt lgkmcnt(0)" \
                 : [rk0] "=&v"(K0_), [rk1] "=&v"(K1_), [ra0] "=&v"(A0_), [ra1] "=&v"(A1_), [ra2] "=&v"(A2_), [ra3] "=&v"(A3_), [ra4] "=&v"(A4_), [ra5] "=&v"(A5_), [ra6] "=&v"(A6_), [ra7] "=&v"(A7_) \
                 : [bk] "v"(BK_), [bv] "v"(BV_), [ok0] "n"(OK0_), [ok1] "n"(OK1_), [ov0] "n"(OV0_), [ov1] "n"(OV1_), [ov2] "n"(OV2_), [ov3] "n"(OV3_), [ov4] "n"(OV4_), [ov5] "n"(OV5_), [ov6] "n"(OV6_), [ov7] "n"(OV7_) : "memory")
#define TR_ST12(K0_, K1_, A0_, A1_, A2_, A3_, A4_, A5_, A6_, A7_, A8_, A9_, BK_, BV_, OK0_, OK1_, OV0_, OV1_, OV2_, OV3_, OV4_, OV5_, OV6_, OV7_, OV8_, OV9_) \
    asm volatile("ds_read_b64_tr_b16 %[rk0], %[bk] offset:%[ok0]\n\tds_read_b64_tr_b16 %[rk1], %[bk] offset:%[ok1]\n\t" \
                 "ds_read_b64_tr_b16 %[ra0], %[bv] offset:%[ov0]\n\tds_read_b64_tr_b16 %[ra1], %[bv] offset:%[ov1]\n\tds_read_b64_tr_b16 %[ra2], %[bv] offset:%[ov2]\n\tds_read_b64_tr_b16 %[ra3], %[bv] offset:%[ov3]\n\t" \
                 "ds_read_b64_tr_b16 %[ra4], %[bv] offset:%[ov4]\n\tds_read_b64_tr_b16 %[ra5], %[bv] offset:%[ov5]\n\tds_read_b64_tr_b16 %[ra6], %[bv] offset:%[ov6]\n\tds_read_b64_tr_b16 %[ra7], %[bv] offset:%[ov7]\n\t" \
                 "ds_read_b64_tr_b16 %[ra8], %[bv] offset:%[ov8]\n\tds_read_b64_tr_b16 %[ra9], %[bv] offset:%[ov9]\n\ts_waitcnt lgkmcnt(0)" \
                 : [rk0] "=&v"(K0_), [rk1] "=&v"(K1_), [ra0] "=&v"(A0_), [ra1] "=&v"(A1_), [ra2] "=&v"(A2_), [ra3] "=&v"(A3_), [ra4] "=&v"(A4_), [ra5] "=&v"(A5_), [ra6] "=&v"(A6_), [ra7] "=&v"(A7_), [ra8] "=&v"(A8_), [ra9] "=&v"(A9_) \
                 : [bk] "v"(BK_), [bv] "v"(BV_), [ok0] "n"(OK0_), [ok1] "n"(OK1_), [ov0] "n"(OV0_), [ov1] "n"(OV1_), [ov2] "n"(OV2_), [ov3] "n"(OV3_), [ov4] "n"(OV4_), [ov5] "n"(OV5_), [ov6] "n"(OV6_), [ov7] "n"(OV7_), [ov8] "n"(OV8_), [ov9] "n"(OV9_) : "memory")
__device__ __forceinline__ bf16x8 mkfrag(u32x2 lo, u32x2 hi) { const u32x4 w = {lo.x, lo.y, hi.x, hi.y}; return __builtin_bit_cast(bf16x8, w); }

template <bool ISM>
__device__ void scan_item(const Params& p, int l, int item, unsigned char* lds) {
    constexpr int NT = ISM ? 5 : 4;
    constexpr float L2E = 1.4426950408889634f;
    const int tid = TIDX, wid = __builtin_amdgcn_readfirstlane(tid >> 6), lane = tid & 63, fr = lane & 15, fq = lane >> 4;
    const int trq = fr >> 2, trp = fr & 3;
    const int sl = ISM ? (item & 3) : 0, dir = ISM ? ((item >> 2) & 1) : (item & 1), h = ISM ? ((item >> 3) & 7) : ((item >> 1) & 31), b = item >> 6;
    const int qcol = ISM ? h * 128 : 2048 + 2560 + (h >> 3) * 128;
    const int kcol = ISM ? 1024 + h * 128 : 2048 + 2048 + (h >> 3) * 128;
    const int vcol = ISM ? 2048 + h * 256 + sl * 64 : 2048 + h * 64;
    const int ocol = ISM ? h * 256 + sl * 64 : h * 64;
    u16* const obase = dir ? (ISM ? p.HB : p.YB) : (ISM ? p.P : p.P + 8192);
    const unsigned ostride = dir ? 2048u : (unsigned)PW;
    u16* Ks = (u16*)(lds + LS_K); u16* Vs = (u16*)(lds + LS_V); u16* Vw = (u16*)(lds + LS_VW); u16* CT = (u16*)(lds + LS_CT);
    float* F = (float*)(lds + LS_F);
    float *f_c = F, *f_r = F + 128, *f_wi = F + 256, *f_ws = F + 384, *f_em = F + 512;
    const unsigned ldsb = (unsigned)(size_t)(LAS unsigned char*)lds;
    const unsigned trK = ldsb + LS_K + (unsigned)(((fq * 8 + trq) * LDK + 16 * wid + 4 * trp) * 2);
    const unsigned trVw = ldsb + LS_VW + (unsigned)(((fq * 8 + trq) * LDV + 4 * trp) * 2);
    const unsigned trV = ldsb + LS_V + (unsigned)(((fq * 4 + trq) * LDV + 4 * trp) * 2);
    const float Dh = ISM ? 0.f : p.d_skip[l * 32 + h];
    const u16* __restrict__ gQKX = p.QKX; const u16* __restrict__ gP = p.P; const float* __restrict__ gG2 = p.G2;
    const int gcol = ISM ? (dir * 8 + h) * 3 : 48 + (dir * 32 + h) * 2;
    __syncthreads();
    for (int i = tid; i < 128 * 24; i += 512) { const int r = i / 24, cc = 64 + i % 24; Vs[r * LDV + cc] = (ISM && cc == 64) ? (u16)0x3F80 : (u16)0; Vw[r * LDV + cc] = 0; }
    for (int i = tid; i < 80 * LDK; i += 512) CT[i] = 0;
    f32x4 st[NT];
#pragma unroll
    for (int m = 0; m < NT; ++m) st[m] = (f32x4){0.f, 0.f, 0.f, 0.f};
    float m_prev = 0.f;
    unsigned qo, ko[4], vo[2], go, ge, oo[4];
    bf16x8 qf[4]; u32x4 kr[4]; u32x4 vr[2]; f32x3 gv = {0.f, 0.f, 0.f}; float e0 = 0.f, e1 = 0.f;
#define SCAN_PTRS(cc) do { \
        qo = (unsigned)scan_row<ISM>(b, dir, (cc), 16 * wid + fr) * (unsigned)QW + (unsigned)(qcol + fq * 8); \
        _Pragma("unroll") for (int r_ = 0; r_ < 4; ++r_) { const int idx_ = r_ * 512 + tid; ko[r_] = (unsigned)scan_row<ISM>(b, dir, (cc), idx_ >> 4) * (unsigned)QW + (unsigned)(kcol + (idx_ & 15) * 8); } \
        _Pragma("unroll") for (int r_ = 0; r_ < 2; ++r_) { const int idx_ = r_ * 512 + tid; vo[r_] = (unsigned)scan_row<ISM>(b, dir, (cc), idx_ >> 3) * (unsigned)(ISM ? PW : QW) + (unsigned)(vcol + (idx_ & 7) * 8); } \
        go = (unsigned)scan_row<ISM>(b, dir, (cc), tid & 127) * (unsigned)G2W + (unsigned)gcol; ge = (unsigned)scan_row<ISM>(b, dir, (cc), 127) * (unsigned)G2W + (unsigned)gcol; \
        _Pragma("unroll") for (int j_ = 0; j_ < 4; ++j_) oo[j_] = (unsigned)scan_row<ISM>(b, dir, (cc), 16 * wid + fq * 4 + j_) * ostride + (unsigned)(ocol + fr); \
    } while (0)
#define SCAN_ADV(dr) do { const unsigned dq_ = (unsigned)((dr) * QW), dp_ = (unsigned)((dr) * PW), dg_ = (unsigned)((dr) * G2W), do_ = (unsigned)(dr) * ostride; \
        qo += dq_; _Pragma("unroll") for (int r_ = 0; r_ < 4; ++r_) ko[r_] += dq_; vo[0] += ISM ? dp_ : dq_; vo[1] += ISM ? dp_ : dq_; go += dg_; ge += dg_; \
        _Pragma("unroll") for (int j_ = 0; j_ < 4; ++j_) oo[j_] += do_; } while (0)
#define SCAN_LOAD() do { \
        _Pragma("unroll") for (int k_ = 0; k_ < 4; ++k_) qf[k_] = *(const bf16x8*)(gQKX + (size_t)qo + k_ * 32); \
        _Pragma("unroll") for (int r_ = 0; r_ < 4; ++r_) kr[r_] = *(const u32x4*)(gQKX + (size_t)ko[r_]); \
        _Pragma("unroll") for (int r_ = 0; r_ < 2; ++r_) vr[r_] = ISM ? *(const u32x4*)(gP + (size_t)vo[r_]) : *(const u32x4*)(gQKX + (size_t)vo[r_]); \
        if (tid < 128) gv = *(const f32x3*)(gG2 + (size_t)go); \
        if (ISM) { e0 = gG2[(size_t)ge]; e1 = gG2[(size_t)ge + 2]; } else { e0 = gG2[(size_t)ge + 1]; } \
    } while (0)
    SCAN_PTRS(0); SCAN_LOAD();
    const int dr_ctx = dir ? -128 : 128, dr_lat = ISM ? dr_ctx : (dir ? -1 : 1);
    __syncthreads();
#pragma unroll 1
    for (int c = 0; c < 66; ++c) {
#pragma unroll
        for (int rep = 0; rep < 4; ++rep) { const int idx = rep * 512 + tid; *(u32x4*)(Ks + (idx >> 4) * LDK + (idx & 15) * 8) = kr[rep]; }
#pragma unroll
        for (int rep = 0; rep < 2; ++rep) { const int idx = rep * 512 + tid; *(u32x4*)(Vs + (idx >> 3) * LDV + (idx & 7) * 8) = vr[rep]; }
        float decay;
        if (ISM) {
            const float Ml = fmaxf(m_prev, e1);
            if (tid < 128) { const float M = fmaxf(m_prev, gv[2]);
                f_c[tid] = gv[1] * L2E; f_r[tid] = M * L2E; f_wi[tid] = __expf(m_prev - M); f_ws[tid] = __expf(gv[1] - Ml); f_em[tid] = __expf(-(gv[0] + M)); }
            decay = __expf(m_prev - Ml); m_prev = e0 + Ml;
        } else {
            if (tid < 128) { f_c[tid] = (__logf(gv[0]) - gv[1]) * L2E; f_r[tid] = -gv[1] * L2E; f_wi[tid] = __expf(gv[1]); f_ws[tid] = __expf(e0 - gv[1]) * gv[0]; }
            decay = __expf(e0);
        }
        bf16x8 qc[4]; unsigned od[4];
#pragma unroll
        for (int k = 0; k < 4; ++k) qc[k] = qf[k];
#pragma unroll
        for (int j = 0; j < 4; ++j) od[j] = oo[j];
        const u32x4 vc0 = vr[0], vc1 = vr[1];
        LDS_BAR();
        if (c + 1 < 66) { if (c + 1 == 2) SCAN_PTRS(2); else SCAN_ADV(c == 0 ? dr_ctx : dr_lat); SCAN_LOAD(); }
        f32x4 sacc[8];
#pragma unroll
        for (int a = 0; a < 8; ++a) sacc[a] = (f32x4){0.f, 0.f, 0.f, 0.f};
#pragma unroll
        for (int a = 0; a < 8; a += 2) {
            if (a + 1 <= wid) {
                bf16x8 kf[2][4];
#pragma unroll
                for (int h2 = 0; h2 < 2; ++h2)
#pragma unroll
                    for (int ksd = 0; ksd < 4; ++ksd) kf[h2][ksd] = *(const bf16x8*)(Ks + (16 * (a + h2) + fr) * LDK + ksd * 32 + fq * 8);
#pragma unroll
                for (int ksd = 0; ksd < 4; ++ksd) { sacc[a] = __builtin_amdgcn_mfma_f32_16x16x32_bf16(kf[0][ksd], qc[ksd], sacc[a], 0, 0, 0);
                    sacc[a + 1] = __builtin_amdgcn_mfma_f32_16x16x32_bf16(kf[1][ksd], qc[ksd], sacc[a + 1], 0, 0, 0); }
            } else if (a <= wid) {
                bf16x8 kf[4];
#pragma unroll
                for (int ksd = 0; ksd < 4; ++ksd) kf[ksd] = *(const bf16x8*)(Ks + (16 * a + fr) * LDK + ksd * 32 + fq * 8);
#pragma unroll
                for (int ksd = 0; ksd < 4; ++ksd) sacc[a] = __builtin_amdgcn_mfma_f32_16x16x32_bf16(kf[ksd], qc[ksd], sacc[a], 0, 0, 0);
            }
        }
        bf16x8 sf[4]; float dsum = 0.f;
        { const float rt = f_r[16 * wid + fr];
          f32x4 cva[8];
#pragma unroll
          for (int a = 0; a < 8; ++a) cva[a] = *(const f32x4*)(f_c + 16 * a + fq * 4);
#pragma unroll
          for (int ks = 0; ks < 4; ++ks) { u32x4 w;
#pragma unroll
              for (int hf = 0; hf < 2; ++hf) { const int a = 2 * ks + hf; float v[4];
                  if (a < wid) { const f32x4 cv = cva[a];
#pragma unroll
                      for (int j = 0; j < 4; ++j) { v[j] = sacc[a][j] * __builtin_amdgcn_exp2f(cv[j] - rt); dsum += v[j]; }
                  } else if (a == wid) { const f32x4 cv = cva[a];
#pragma unroll
                      for (int j = 0; j < 4; ++j) { const float e = sacc[a][j] * __builtin_amdgcn_exp2f(cv[j] - rt); v[j] = (fq * 4 + j <= fr) ? e : 0.f; dsum += v[j]; }
                  } else { v[0] = 0.f; v[1] = 0.f; v[2] = 0.f; v[3] = 0.f; }
                  w[hf * 2] = pk2(v[0], v[1]); w[hf * 2 + 1] = pk2(v[2], v[3]); }
              sf[ks] = __builtin_bit_cast(bf16x8, w); } }
        dsum += __shfl_xor(dsum, 16, 64); dsum += __shfl_xor(dsum, 32, 64);
        {
#pragma unroll
          for (int rep = 0; rep < 2; ++rep) { const int idx = rep * 512 + tid; const int i = idx >> 3; const float wv = f_ws[i]; const u32x4 vc = rep ? vc1 : vc0; u32x4 o;
#pragma unroll
              for (int e = 0; e < 4; ++e) o[e] = pk2(bflo(vc[e]) * wv, bfhi(vc[e]) * wv);
              *(u32x4*)(Vw + i * LDV + (idx & 7) * 8) = o; }
          if (ISM && tid < 128) Vw[tid * LDV + 64] = f2bf(f_ws[tid]); }
        { f32x4 ia[NT], ib[4];
#pragma unroll
          for (int n = 0; n < NT; ++n) ia[n] = (f32x4){0.f, 0.f, 0.f, 0.f};
#pragma unroll
          for (int n = 0; n < 4; ++n) ib[n] = (f32x4){0.f, 0.f, 0.f, 0.f};
#pragma unroll
          for (int ksd = 0; ksd < 4; ++ksd) { bf16x8 bfr[NT];
#pragma unroll
              for (int n = 0; n < NT; ++n) bfr[n] = *(const bf16x8*)(CT + (n * 16 + fr) * LDK + ksd * 32 + fq * 8);
#pragma unroll
              for (int n = 0; n < NT; ++n) ia[n] = __builtin_amdgcn_mfma_f32_16x16x32_bf16(qc[ksd], bfr[n], ia[n], 0, 0, 0); }
#define SCAN_IB(ks) if (2 * (ks) <= wid) { u32x2 r0, r1, r2, r3, r4, r5, r6, r7; \
              TR_RD8(r0, r1, r2, r3, r4, r5, r6, r7, trV, (ks) * 32 * LDV * 2, (ks) * 32 * LDV * 2 + 16 * LDV * 2, (ks) * 32 * LDV * 2 + 32, (ks) * 32 * LDV * 2 + 16 * LDV * 2 + 32, \
                     (ks) * 32 * LDV * 2 + 64, (ks) * 32 * LDV * 2 + 16 * LDV * 2 + 64, (ks) * 32 * LDV * 2 + 96, (ks) * 32 * LDV * 2 + 16 * LDV * 2 + 96); \
              ib[0] = __builtin_amdgcn_mfma_f32_16x16x32_bf16(sf[ks], mkfrag(r0, r1), ib[0], 0, 0, 0); ib[1] = __builtin_amdgcn_mfma_f32_16x16x32_bf16(sf[ks], mkfrag(r2, r3), ib[1], 0, 0, 0); \
              ib[2] = __builtin_amdgcn_mfma_f32_16x16x32_bf16(sf[ks], mkfrag(r4, r5), ib[2], 0, 0, 0); ib[3] = __builtin_amdgcn_mfma_f32_16x16x32_bf16(sf[ks], mkfrag(r6, r7), ib[3], 0, 0, 0); }
          SCAN_IB(0) SCAN_IB(1) SCAN_IB(2) SCAN_IB(3)
#undef SCAN_IB
#pragma unroll
          for (int j = 0; j < 4; ++j) { const int tl = fq * 4 + j, t = 16 * wid + tl; const float wi = f_wi[t];
              float inv = 1.f;
              if (ISM) { const float qn = __shfl(ia[NT - 1][j], lane & 48, 64); const float dn = __shfl(dsum, tl, 64); inv = __builtin_amdgcn_rcpf(fmaxf(fabsf(wi * qn + dn), f_em[t])); }
              u16* dst = obase + (size_t)od[j];
              float v[4];
#pragma unroll
              for (int n = 0; n < 4; ++n) { v[n] = (wi * ia[n][j] + ib[n][j]) * inv; if (!ISM && dir == 0) v[n] += Dh * bf2f(Vs[t * LDV + n * 16 + fr]); }
              const unsigned p01 = pk2(v[0], v[1]), p23 = pk2(v[2], v[3]);
              dst[0] = (u16)(p01 & 0xFFFFu); dst[16] = (u16)(p01 >> 16); dst[32] = (u16)(p23 & 0xFFFFu); dst[48] = (u16)(p23 >> 16); } }
        LDS_BAR();
        {
#pragma unroll
          for (int m = 0; m < NT; ++m) st[m] *= decay;
#define SCAN_ST(ks) { u32x2 k0, k1, a0, a1, a2, a3, a4, a5, a6, a7, a8, a9; \
              if (ISM) TR_ST12(k0, k1, a0, a1, a2, a3, a4, a5, a6, a7, a8, a9, trK, trVw, (ks) * 32 * LDK * 2, (ks) * 32 * LDK * 2 + 4 * LDK * 2, \
                     (ks) * 32 * LDV * 2, (ks) * 32 * LDV * 2 + 4 * LDV * 2, (ks) * 32 * LDV * 2 + 32, (ks) * 32 * LDV * 2 + 4 * LDV * 2 + 32, \
                     (ks) * 32 * LDV * 2 + 64, (ks) * 32 * LDV * 2 + 4 * LDV * 2 + 64, (ks) * 32 * LDV * 2 + 96, (ks) * 32 * LDV * 2 + 4 * LDV * 2 + 96, \
                     (ks) * 32 * LDV * 2 + 128, (ks) * 32 * LDV * 2 + 4 * LDV * 2 + 128); \
              else TR_ST10(k0, k1, a0, a1, a2, a3, a4, a5, a6, a7, trK, trVw, (ks) * 32 * LDK * 2, (ks) * 32 * LDK * 2 + 4 * LDK * 2, \
                     (ks) * 32 * LDV * 2, (ks) * 32 * LDV * 2 + 4 * LDV * 2, (ks) * 32 * LDV * 2 + 32, (ks) * 32 * LDV * 2 + 4 * LDV * 2 + 32, \
                     (ks) * 32 * LDV * 2 + 64, (ks) * 32 * LDV * 2 + 4 * LDV * 2 + 64, (ks) * 32 * LDV * 2 + 96, (ks) * 32 * LDV * 2 + 4 * LDV * 2 + 96); \
              const bf16x8 kfr = mkfrag(k0, k1); \
              st[0] = __builtin_amdgcn_mfma_f32_16x16x32_bf16(mkfrag(a0, a1), kfr, st[0], 0, 0, 0); st[1] = __builtin_amdgcn_mfma_f32_16x16x32_bf16(mkfrag(a2, a3), kfr, st[1], 0, 0, 0); \
              st[2] = __builtin_amdgcn_mfma_f32_16x16x32_bf16(mkfrag(a4, a5), kfr, st[2], 0, 0, 0); st[3] = __builtin_amdgcn_mfma_f32_16x16x32_bf16(mkfrag(a6, a7), kfr, st[3], 0, 0, 0); \
              if (ISM) st[NT - 1] = __builtin_amdgcn_mfma_f32_16x16x32_bf16(mkfrag(a8, a9), kfr, st[NT - 1], 0, 0, 0); }
          SCAN_ST(0) SCAN_ST(1) SCAN_ST(2) SCAN_ST(3)
#undef SCAN_ST
#pragma unroll
          for (int m = 0; m < NT; ++m) { const unsigned p01 = pk2(st[m][0], st[m][1]), p23 = pk2(st[m][2], st[m][3]);
              u16* cp = CT + (m * 16 + fq * 4) * LDK + 16 * wid + fr;
              cp[0] = (u16)(p01 & 0xFFFFu); cp[LDK] = (u16)(p01 >> 16); cp[2 * LDK] = (u16)(p23 & 0xFFFFu); cp[3 * LDK] = (u16)(p23 >> 16); } }
        LDS_BAR();
    }
#undef SCAN_LOAD
#undef SCAN_ADV
#undef SCAN_PTRS
}

__device__ void phase_scan(const Params& p, int l, unsigned char* lds) {
    for (int blk = BIDX; blk < 256; blk += GDIM) {
        const int xcd = blk & 7, j = blk >> 3;
        if (j < 16) scan_item<true>(p, l, (xcd + 8 * (j >> 2)) * 4 + (j & 3), lds);
        else { const int G = xcd + 8 * ((j - 16) >> 3), r = (j - 16) & 7; const int dir = G & 1, g = (G >> 1) & 3, b = G >> 3;
            scan_item<false>(p, l, dir + 2 * (g * 8 + r) + 64 * b, lds); }
    }
}

__device__ void phase_post(const Params& p, int l) {
    const int wid = TIDX >> 6, lane = TIDX & 63;
    const int nw = GDIM * 8;
    const int c0 = lane * 32;
    for (int row = BIDX * 8 + wid; row < MROWS; row += nw) {
        u16* pr = p.P + (size_t)row * PW;
        {
            float tv[32]; float ss = 0.f;
#pragma unroll
            for (int q = 0; q < 4; ++q) { const u32x4 yv = *(const u32x4*)(pr + 8192 + c0 + q * 8), zv = *(const u32x4*)(pr + 11264 + c0 + q * 8), yb = *(const u32x4*)(p.YB + (size_t)row * 2048 + c0 + q * 8);
#pragma unroll
                for (int e = 0; e < 4; ++e) { const float t0 = (bflo(yv[e]) + bflo(yb[e])) * siluf(bflo(zv[e])), t1 = (bfhi(yv[e]) + bfhi(yb[e])) * siluf(bfhi(zv[e]));
                    tv[q * 8 + 2 * e] = t0; tv[q * 8 + 2 * e + 1] = t1; ss += t0 * t0 + t1 * t1; } }
            const float rstd = rsqrtf(wsum(ss) * (1.f / 2048.f) + LN_EPS);
            const float* sw = p.ssm_w + (size_t)l * 2048 + c0;
#pragma unroll
            for (int q = 0; q < 4; ++q) { const f32x4 wa = *(const f32x4*)(sw + q * 8), wb = *(const f32x4*)(sw + q * 8 + 4);
                u32x4 o; o.x = pk2(tv[q * 8] * rstd * wa[0], tv[q * 8 + 1] * rstd * wa[1]); o.y = pk2(tv[q * 8 + 2] * rstd * wa[2], tv[q * 8 + 3] * rstd * wa[3]);
                o.z = pk2(tv[q * 8 + 4] * rstd * wb[0], tv[q * 8 + 5] * rstd * wb[1]); o.w = pk2(tv[q * 8 + 6] * rstd * wb[2], tv[q * 8 + 7] * rstd * wb[3]);
                *(u32x4*)(pr + 11264 + c0 + q * 8) = o; }
        }
        {
            float hv[32]; float s = 0.f;
#pragma unroll
            for (int q = 0; q < 4; ++q) { const u32x4 a = *(const u32x4*)(pr + c0 + q * 8), ab = *(const u32x4*)(p.HB + (size_t)row * 2048 + c0 + q * 8);
#pragma unroll
                for (int e = 0; e < 4; ++e) { const float h0 = bflo(a[e]) + bflo(ab[e]), h1 = bfhi(a[e]) + bfhi(ab[e]); hv[q * 8 + 2 * e] = h0; hv[q * 8 + 2 * e + 1] = h1; s += h0 + h1; } }
            s += __shfl_xor(s, 1, 64); s += __shfl_xor(s, 2, 64); s += __shfl_xor(s, 4, 64);
            const float mean = s * (1.f / 256.f);
            float q2 = 0.f;
#pragma unroll
            for (int e = 0; e < 32; ++e) { const float d = hv[e] - mean; q2 += d * d; }
            q2 += __shfl_xor(q2, 1, 64); q2 += __shfl_xor(q2, 2, 64); q2 += __shfl_xor(q2, 4, 64);
            const float rstd = rsqrtf(q2 * (1.f / 256.f) + LN_EPS);
            const float* mw = p.mh_w + (size_t)l * 2048 + c0;
#pragma unroll
            for (int q = 0; q < 4; ++q) { const u32x4 ov = *(const u32x4*)(pr + 4096 + c0 + q * 8), zv = *(const u32x4*)(pr + 6144 + c0 + q * 8);
                const f32x4 wa = *(const f32x4*)(mw + q * 8), wb = *(const f32x4*)(mw + q * 8 + 4);
                float r[8];
#pragma unroll
                for (int e = 0; e < 4; ++e) {
                    const float m0 = (e < 2 ? wa[2 * e] : wb[2 * e - 4]), m1 = (e < 2 ? wa[2 * e + 1] : wb[2 * e - 3]);
                    r[2 * e] = sigmf(bflo(ov[e])) * ((hv[q * 8 + 2 * e] - mean) * rstd * m0) * siluf(bflo(zv[e]));
                    r[2 * e + 1] = sigmf(bfhi(ov[e])) * ((hv[q * 8 + 2 * e + 1] - mean) * rstd * m1) * siluf(bfhi(zv[e])); }
                u32x4 o; o.x = pk2(r[0], r[1]); o.y = pk2(r[2], r[3]); o.z = pk2(r[4], r[5]); o.w = pk2(r[6], r[7]);
                *(u32x4*)(pr + 9216 + c0 + q * 8) = o; }
        }
    }
}

__device__ __forceinline__ void grid_barrier(unsigned* ctr, unsigned target) {
    __syncthreads();
    if (threadIdx.x == 0) {
        __builtin_amdgcn_fence(__ATOMIC_RELEASE, "agent");
        asm volatile("s_waitcnt vmcnt(0)" ::: "memory");
        __hip_atomic_fetch_add(ctr, 1u, __ATOMIC_RELAXED, __HIP_MEMORY_SCOPE_AGENT);
        while (__hip_atomic_load(ctr, __ATOMIC_RELAXED, __HIP_MEMORY_SCOPE_AGENT) < target) __builtin_amdgcn_s_sleep(2);
        __builtin_amdgcn_fence(__ATOMIC_ACQUIRE, "agent");
        asm volatile("s_waitcnt vmcnt(0)" ::: "memory");
    }
    __syncthreads();
}
__device__ __forceinline__ void acquire_workgroup() {
    if (threadIdx.x == 0) { __builtin_amdgcn_fence(__ATOMIC_ACQUIRE, "agent"); asm volatile("s_waitcnt vmcnt(0)" ::: "memory"); }
    __syncthreads();
}

constexpr int N_PHASES = 2 + 6 * DEPTH;
__global__ __launch_bounds__(512, 2) void mega(KArgs ka, int ph_lo, int ph_hi) {
    extern __shared__ __attribute__((aligned(16))) unsigned char shm[];
    cg::grid_group grid = cg::this_grid();
#pragma unroll 1
    for (int ph = ph_lo; ph < ph_hi; ++ph) {
        if (ph == 0) {
            Params q{}; unsigned char* ws = KWS();
            q.c = KIN(1); q.c_ctx = KIN(3); q.w_ada = KIN(4); q.b_ada = KIN(5); q.w_in = KIN(6); q.w_out = KIN(17);
            q.MOD = (float*)(ws + OFF_MOD); q.wt_in = (u16*)(ws + OFF_W); q.wt_out = (u16*)(ws + OFF_W + SZ_WTIN1);
            phase_a(q, shm);
        } else {
            const int l = (ph == N_PHASES - 1) ? DEPTH : (ph - 1) / 6, k = (ph == N_PHASES - 1) ? 0 : (ph - 1) % 6;
            if (k == 0) {
                Params q{}; unsigned char* ws = KWS();
                q.x = KIN(0); q.ctx = KIN(2); q.ln_g = KIN(18); q.ln_b = KIN(19); q.out = KOUT();
                q.RC = (float*)(ws + OFF_RC); q.MOD = (float*)(ws + OFF_MOD); q.U = (u16*)(ws + OFF_U);
                phase_ln(q, l);
                if (l >= 1 && l < DEPTH) {
                    q.w_in = KIN(6); q.w_out = KIN(17); q.wt_in = (u16*)(ws + OFF_W); q.wt_out = (u16*)(ws + OFF_W + SZ_WTIN1);
                    weight_tiles(q, (float*)shm, l);
                }
            } else if (k == 1) {
                unsigned char* ws = KWS();
                pg8::Gemm g{(const u16*)(ws + OFF_U), (const u16*)(ws + OFF_W + (size_t)l * SZ_WL), MROWS, NPAD, 2048, 2048};
                pg8::StaticOrder S; S.init(MROWS, NPAD, GDIM, BIDX);
                EpiG1 E{(u16*)(ws + OFF_P), (float*)(ws + OFF_GD)};
                pg8::gemm_phase<EpiG1>((LAS unsigned char*)shm, g, S, E);
            } else if (k == 2) {
                Params q{}; unsigned char* ws = KWS();
                q.conv_qk_w = KIN(7); q.conv_qk_b = KIN(8); q.conv_xbc_w = KIN(11); q.conv_xbc_b = KIN(12); q.gate_b = KIN(9); q.dt_bias = KIN(13); q.a_log = KIN(14);
                q.P = (u16*)(ws + OFF_P); q.QKX = (u16*)(ws + OFF_QKX); q.GD = (float*)(ws + OFF_GD); q.G2 = (float*)(ws + OFF_G2);
                phase_conv(q, l);
            } else if (k == 3) {
                Params q{}; unsigned char* ws = KWS();
                q.gate_b = KIN(9); q.dt_bias = KIN(13); q.a_log = KIN(14); q.d_skip = KIN(15);
                q.P = (u16*)(ws + OFF_P); q.QKX = (u16*)(ws + OFF_QKX); q.G2 = (float*)(ws + OFF_G2);
                q.HB = (u16*)(ws + OFF_U); q.YB = (u16*)(ws + OFF_W + (size_t)((l + 1) & 1) * SZ_WL);
                phase_scan(q, l, shm);
            } else if (k == 4) {
                Params q{}; unsigned char* ws = KWS();
                q.mh_w = KIN(10); q.ssm_w = KIN(16); q.P = (u16*)(ws + OFF_P);
                q.HB = (u16*)(ws + OFF_U); q.YB = (u16*)(ws + OFF_W + (size_t)((l + 1) & 1) * SZ_WL);
                phase_post(q, l);
            } else {
                unsigned char* ws = KWS(); float* outp = KOUT();
                const float* xin = KIN(0); const float* cin = KIN(2);
                float* rc = (float*)(ws + OFF_RC);
                const int roff = (l == DEPTH - 1) ? CTXROWS : 0;
                pg8::Gemm g{(const u16*)(ws + OFF_P) + (size_t)roff * PW + 9216, (const u16*)(ws + OFF_W + (size_t)l * SZ_WL + SZ_WTIN1), MROWS - roff, 2048, 4096, PW};
                pg8::StaticOrder S; S.init(MROWS - roff, 2048, GDIM, BIDX);
                EpiG2 E{l == 0 ? xin : outp, l == 0 ? cin : rc, outp, rc, (const float*)(ws + OFF_MOD) + (size_t)l * 3 * 6144, roff};
                pg8::gemm_phase<EpiG2>((LAS unsigned char*)shm, g, S, E);
            }
        }
        if (ph + 1 < ph_hi) { if (ph == ph_lo) { grid.sync(); acquire_workgroup(); } else grid_barrier((unsigned*)(KWS() + OFF_BAR), (unsigned)(ph - ph_lo) * (unsigned)GDIM); }
    }
}

extern "C" void kernel_launch(void* const* d_in, const int* in_sizes, int n_in, void* d_out, int out_size, void* d_ws, size_t ws_size, hipStream_t stream) {
    static int grid = 0;
    if (grid == 0) {
        if (n_in != 20 || ws_size < WS_END) { fprintf(stderr, "kernel_launch: unexpected n_in %d or ws_size %zu (< %zu)\n", n_in, ws_size, (size_t)WS_END); grid = -1; return; }
        int dev = 0, cus = 0, per_cu = 0;
        hipGetDevice(&dev);
        hipDeviceGetAttribute(&cus, hipDeviceAttributeMultiprocessorCount, dev);
        if (hipFuncSetAttribute((const void*)mega, hipFuncAttributeMaxDynamicSharedMemorySize, LDS_BYTES) != hipSuccess) { fprintf(stderr, "kernel_launch: hipFuncSetAttribute failed\n"); grid = -1; return; }
        if (hipOccupancyMaxActiveBlocksPerMultiprocessor(&per_cu, (const void*)mega, 512, LDS_BYTES) != hipSuccess || per_cu < 1) { fprintf(stderr, "kernel_launch: occupancy query says %d\n", per_cu); per_cu = 1; }
        (void)hipGetLastError();
        grid = cus;
    }
    if (grid < 0) return;
    if (hipMemsetAsync((unsigned char*)d_ws + OFF_BAR, 0, 256, stream) != hipSuccess) { fprintf(stderr, "kernel_launch: memset failed\n"); return; }
    KArgs ka{};
    for (int i = 0; i < 20; ++i) ka.in[i] = (const float*)d_in[i];
    ka.out = (float*)d_out; ka.ws = (unsigned char*)d_ws;
    int lo = 0, hi = N_PHASES;
    void* args[] = {&ka, &lo, &hi};
    hipError_t e = hipLaunchCooperativeKernel((const void*)mega, dim3(grid), dim3(512), args, LDS_BYTES, stream);
    if (e != hipSuccess) fprintf(stderr, "kernel_launch: cooperative launch failed: %s (grid %d)\n", hipGetErrorString(e), grid);
}
```

```cpp
#include <hip/hip_runtime.h>
#include <hip/hip_cooperative_groups.h>
#include <cstdio>
namespace cg = cooperative_groups;

#define LAS __attribute__((address_space(3)))
typedef unsigned short u16;
typedef short bf16x8 __attribute__((ext_vector_type(8)));
typedef float f32x4 __attribute__((ext_vector_type(4)));
typedef unsigned u32x4 __attribute__((ext_vector_type(4)));
typedef unsigned u32x2 __attribute__((ext_vector_type(2)));
typedef float f32x3 __attribute__((ext_vector_type(3)));

constexpr int D = 2048, DEPTH = 2;
constexpr int CTXROWS = 512, MROWS = 16896;
constexpr int NIN = 13408, NPAD = 13568, PW = 13312, GDW = 96, QW = 5120, G2W = 176;
constexpr float LN_EPS = 1e-5f;
constexpr float ALPHA = 1.4142135623730951f;
constexpr int LDS_BYTES = 139264;

constexpr size_t SZ_WTIN1 = (size_t)NPAD * 2048 * 2, SZ_WTOUT1 = (size_t)2048 * 4096 * 2, SZ_WL = SZ_WTIN1 + SZ_WTOUT1;
constexpr size_t SZ_P = (size_t)MROWS * PW * 2, SZ_GD = (size_t)MROWS * GDW * 4, SZ_U = (size_t)MROWS * 2048 * 2;
constexpr size_t SZ_QKX = (size_t)MROWS * QW * 2, SZ_MOD = (size_t)DEPTH * 3 * 6144 * 4, SZ_RC = (size_t)CTXROWS * 2048 * 4;
constexpr size_t OFF_W = 0, OFF_P = OFF_W + DEPTH * SZ_WL, OFF_GD = OFF_P + SZ_P, OFF_U = OFF_GD + SZ_GD,
                 OFF_QKX = OFF_U + SZ_U, OFF_MOD = OFF_QKX + SZ_QKX, OFF_RC = OFF_MOD + SZ_MOD, OFF_BAR = OFF_RC + SZ_RC, OFF_G2 = OFF_BAR + 256, WS_END = OFF_G2 + (size_t)MROWS * 176 * 4 + 256;

struct Params {
    const float *x, *c, *ctx, *c_ctx, *w_ada, *b_ada, *w_in, *conv_qk_w, *conv_qk_b, *gate_b, *mh_w, *conv_xbc_w, *conv_xbc_b, *dt_bias, *a_log, *d_skip,
        *ssm_w, *w_out, *ln_g, *ln_b;
    float* out;
    u16 *wt_in, *wt_out, *P, *U, *QKX, *HB, *YB;
    float *GD, *MOD, *RC, *G2;
};
struct KArgs { const float* in[20]; float* out; unsigned char* ws; };
template <int IDX> __device__ __forceinline__ const void* kload() {
    unsigned long r;
    asm volatile("s_load_dwordx2 %0, %1, %2\n\ts_waitcnt lgkmcnt(0)" : "=s"(r) : "s"(__builtin_amdgcn_kernarg_segment_ptr()), "n"(IDX * 8) : "memory");
    return (const void*)(const __attribute__((address_space(1))) char*)r;
}
#define KIN(i) ((const float*)kload<(i)>())
#define KOUT() ((float*)kload<20>())
#define KWS() ((unsigned char*)kload<21>())

__device__ __forceinline__ int tid_() { int t = threadIdx.x; asm volatile("" : "+v"(t)); return t; }
__device__ __forceinline__ int bid_() { int b = blockIdx.x; asm volatile("" : "+s"(b)); return b; }
__device__ __forceinline__ int gdim_() { int g = gridDim.x; asm volatile("" : "+s"(g)); return g; }
#define TIDX tid_()
#define BIDX bid_()
#define GDIM gdim_()

typedef float f32x2_t __attribute__((ext_vector_type(2)));
typedef __bf16 bf16x2_t __attribute__((ext_vector_type(2)));
__device__ __forceinline__ u16 f2bf(float f) { return __builtin_bit_cast(u16, (__bf16)f); }
__device__ __forceinline__ float bf2f(unsigned h) { return __uint_as_float(h << 16); }
__device__ __forceinline__ float bflo(unsigned w) { return __uint_as_float(w << 16); }
__device__ __forceinline__ float bfhi(unsigned w) { return __uint_as_float(w & 0xFFFF0000u); }
__device__ __forceinline__ unsigned pk2(float lo, float hi) { const f32x2_t v = {lo, hi}; return __builtin_bit_cast(unsigned, __builtin_convertvector(v, bf16x2_t)); }
__device__ __forceinline__ unsigned cvt_pk_bf16(float lo, float hi) { unsigned r; asm volatile("v_cvt_pk_bf16_f32 %0, %1, %2" : "=v"(r) : "v"(lo), "v"(hi)); return r; }
__device__ __forceinline__ float wsum(float v) {
#pragma unroll
    for (int o = 32; o > 0; o >>= 1) v += __shfl_xor(v, o, 64);
    return v;
}
__device__ __forceinline__ float siluf(float v) { return v / (1.f + __expf(-v)); }
__device__ __forceinline__ float sigmf(float v) { return 1.f / (1.f + __expf(-v)); }
__device__ __forceinline__ float scan_add(float v, int lane) {
#pragma unroll
    for (int d = 1; d < 64; d <<= 1) { float t = __shfl_up(v, d, 64); if (lane >= d) v += t; }
    return v;
}
__device__ __forceinline__ float scan_max(float v, int lane) {
#pragma unroll
    for (int d = 1; d < 64; d <<= 1) { float t = __shfl_up(v, d, 64); if (lane >= d) v = fmaxf(v, t); }
    return v;
}
__device__ __forceinline__ int src_col(int n) {
    if (n < 8192) return n;
    if (n < 11264) return n + 32;
    if (n < 13312) return n + 96;
    if (n < 13344) return n - 5120;
    if (n < 13408) return n - 2048;
    return -1;
}

namespace pg8 {
constexpr int BM = 256, BK = 64, HALF = 128, HTB = HALF * BK * 2, STAGE_BYTES = 8 * HTB, NXCD = 8, WGM = 8;
__host__ __device__ __forceinline__ int lds_byte(int r, int c) { const int st = (r >> 4) * 2 + (c >> 5), rr = r & 15, cc = c & 31, ob = rr * 64 + cc * 2; return st * 1024 + (ob ^ (((ob >> 9) & 1) << 5)); }
__host__ __device__ __forceinline__ void stage_rc(int b, int& R, int& C) { const int st = b / 1024, sb = b % 1024, swz = sb ^ (((sb >> 9) & 1) << 5); R = (st >> 1) * 16 + swz / 64; C = (st & 1) * 32 + (swz % 64) / 2; }
__host__ __device__ __forceinline__ int perm32(int rho) { const int n = rho >> 4, i = rho & 15; return 8 * (i >> 2) + 4 * n + (i & 3); }
struct Unit { int pm, pn; };
struct Gemm { const u16* A; const u16* Bt; int M, N, K, lda; };
struct StaticOrder {
    int nM, nN, nwg, G, c;
    __device__ void init(int M, int N, int G_, int c_) { nM = M / BM; nN = N / BM; nwg = nM * nN; G = G_; c = c_; }
    __device__ bool next(int i, Unit& u) const {
        const long L = (long)i * G + c; if (L >= nwg) return false;
        int wgid = (int)L; { const int q = nwg / NXCD, r = nwg % NXCD, xcd = wgid % NXCD, off = wgid / NXCD; wgid = (xcd < r ? xcd * (q + 1) : r * (q + 1) + (xcd - r) * q) + off; }
        const int nig = WGM * nN, gid = wgid / nig, fm = gid * WGM, gsz = (nM - fm) < WGM ? (nM - fm) : WGM;
        u.pm = fm + ((wgid % nig) % gsz); u.pn = (wgid % nig) / gsz; return true;
    }
};

template <class Epi>
__device__ __forceinline__ void gemm_phase(LAS unsigned char* lds, const Gemm g, const StaticOrder& S, const Epi& E) {
    const int tid = TIDX, wid = __builtin_amdgcn_readfirstlane(tid >> 6), lane = tid & 63, wr = wid >> 2, wc = wid & 3, fr = lane & 15, fq = lane >> 4;
    const int K = g.K, nt = K / BK, lda = g.lda;
    unsigned voffA[2], voffB[2];
#pragma unroll
    for (int i = 0; i < 2; ++i) { int R, C; stage_rc(tid * 16 + i * 8192, R, C); const int Rb = Epi::PERM ? ((R & ~31) + perm32(R & 31)) : R;
        voffA[i] = (unsigned)(R * lda + C) * 2u; voffB[i] = (unsigned)(Rb * K + C) * 2u; }
    const size_t kstep = (size_t)(BK * 2);
    const size_t hA = (size_t)HALF * lda * 2, hB = (size_t)HALF * K * 2;
    const size_t tA = 2 * hA, tB = 2 * hB;
    const unsigned ldsw = (unsigned)wid * 1024u;
    const int aoff = lds_byte(wr * 64 + fr, fq * 8), boff = lds_byte(wc * 32 + fr, fq * 8);
#define PG8_SA(b, h) (((b) * 2 + (h)) * HTB)
#define PG8_SB(b, h) ((4 + (b) * 2 + (h)) * HTB)
#define PG8_STAGE(bufoff, gbase, voff) do { _Pragma("unroll") for (int _i = 0; _i < 2; ++_i) \
        __builtin_amdgcn_global_load_lds((const unsigned*)((const char*)(gbase) + (voff)[_i]), (LAS unsigned*)(lds + (bufoff) + ldsw + _i * 8192), 16, 0, 0); } while (0)
#define PG8_LDA(dst, b, h) do { _Pragma("unroll") for (int m = 0; m < 4; ++m) _Pragma("unroll") for (int k = 0; k < 2; ++k) dst[m][k] = *(const LAS bf16x8*)(lds + PG8_SA(b, h) + aoff + m * 2048 + k * 1024); } while (0)
#define PG8_LDB(dst, b, h) do { _Pragma("unroll") for (int n = 0; n < 2; ++n) _Pragma("unroll") for (int k = 0; k < 2; ++k) dst[n][k] = *(const LAS bf16x8*)(lds + PG8_SB(b, h) + boff + n * 2048 + k * 1024); } while (0)
#define PG8_MMA(ai, bj, At, Bt) do { __builtin_amdgcn_s_setprio(1); _Pragma("unroll") for (int m = 0; m < 4; ++m) _Pragma("unroll") for (int n = 0; n < 2; ++n) _Pragma("unroll") for (int k = 0; k < 2; ++k) \
        acc[ai][bj][m][n] = __builtin_amdgcn_mfma_f32_16x16x32_bf16(Bt[n][k], At[m][k], acc[ai][bj][m][n], 0, 0, 0); __builtin_amdgcn_s_setprio(0); } while (0)
#define PG8_WAIT_V(n) asm volatile("s_waitcnt vmcnt(" #n ")" ::: "memory")
#define PG8_WAIT_L(n) asm volatile("s_waitcnt lgkmcnt(" #n ")" ::: "memory")
#define PG8_BAR __builtin_amdgcn_s_barrier()
#define PG8_SCHED __builtin_amdgcn_sched_barrier(0)
    Unit cur, nxt; int ui = 0;
    if (!S.next(0, cur)) return;
    f32x4 acc[2][2][4][2];
#pragma unroll
    for (int a = 0; a < 2; ++a)
#pragma unroll
        for (int b = 0; b < 2; ++b)
#pragma unroll
            for (int m = 0; m < 4; ++m)
#pragma unroll
                for (int n = 0; n < 2; ++n) acc[a][b][m][n] = (f32x4){0.f, 0.f, 0.f, 0.f};
    bf16x8 At[4][2], B0[2][2], B1[2][2];
    const char* cA = (const char*)g.A + (size_t)cur.pm * tA; const char* cB = (const char*)g.Bt + (size_t)cur.pn * tB;
    PG8_STAGE(PG8_SB(0, 0), cB, voffB); PG8_STAGE(PG8_SA(0, 0), cA, voffA); PG8_STAGE(PG8_SB(0, 1), cB + hB, voffB); PG8_STAGE(PG8_SA(0, 1), cA + hA, voffA);
    if (wr == 1) PG8_BAR;
    PG8_WAIT_V(4); PG8_BAR;
    PG8_STAGE(PG8_SB(1, 0), cB + kstep, voffB); PG8_STAGE(PG8_SA(1, 0), cA + kstep, voffA); PG8_STAGE(PG8_SB(1, 1), cB + hB + kstep, voffB);
    PG8_WAIT_V(6); PG8_BAR;
    for (;;) {
        const bool has_next = S.next(ui + 1, nxt);
        const char* nA = has_next ? (const char*)g.A + (size_t)nxt.pm * tA : cA; const char* nB = has_next ? (const char*)g.Bt + (size_t)nxt.pn * tB : cB;
        for (int t = 0; t < nt; t += 2) {
            const bool last = (t == nt - 2);
            const char* a1 = cA + (size_t)(t + 1) * kstep;
            const char* a2 = last ? nA : cA + (size_t)(t + 2) * kstep; const char* b2 = last ? nB : cB + (size_t)(t + 2) * kstep;
            const char* a3 = a2 + kstep; const char* b3 = b2 + kstep;
            PG8_LDB(B0, 0, 0); PG8_SCHED; PG8_LDA(At, 0, 0); PG8_STAGE(PG8_SA(1, 1), a1 + hA, voffA);
            PG8_WAIT_L(8); PG8_BAR; PG8_WAIT_L(0); PG8_MMA(0, 0, At, B0); PG8_BAR; PG8_SCHED;
            PG8_LDB(B1, 0, 1); PG8_STAGE(PG8_SB(0, 0), b2, voffB);
            PG8_BAR; PG8_WAIT_L(0); PG8_MMA(0, 1, At, B1); PG8_BAR;
            PG8_LDA(At, 0, 1); PG8_STAGE(PG8_SA(0, 0), a2, voffA);
            PG8_BAR; PG8_WAIT_L(0); PG8_MMA(1, 0, At, B0); PG8_BAR; PG8_SCHED;
            PG8_STAGE(PG8_SB(0, 1), b2 + hB, voffB);
            PG8_WAIT_V(6); PG8_BAR; PG8_MMA(1, 1, At, B1); PG8_BAR;
            PG8_LDB(B0, 1, 0); PG8_SCHED; PG8_LDA(At, 1, 0); PG8_STAGE(PG8_SA(0, 1), a2 + hA, voffA);
            PG8_WAIT_L(8); PG8_BAR; PG8_WAIT_L(0); PG8_MMA(0, 0, At, B0); PG8_BAR; PG8_SCHED;
            PG8_LDB(B1, 1, 1); PG8_STAGE(PG8_SB(1, 0), b3, voffB);
            PG8_BAR; PG8_WAIT_L(0); PG8_MMA(0, 1, At, B1); PG8_BAR;
            PG8_LDA(At, 1, 1); PG8_STAGE(PG8_SA(1, 0), a3, voffA);
            PG8_BAR; PG8_WAIT_L(0); PG8_MMA(1, 0, At, B0); PG8_BAR; PG8_SCHED;
            PG8_STAGE(PG8_SB(1, 1), b3 + hB, voffB);
            PG8_WAIT_V(6); PG8_BAR; PG8_MMA(1, 1, At, B1); PG8_BAR;
        }
        E(acc, cur, wr, wc, fr, fq);
        if (!has_next) break;
#pragma unroll
        for (int a = 0; a < 2; ++a)
#pragma unroll
            for (int b = 0; b < 2; ++b)
#pragma unroll
                for (int m = 0; m < 4; ++m)
#pragma unroll
                    for (int n = 0; n < 2; ++n) acc[a][b][m][n] = (f32x4){0.f, 0.f, 0.f, 0.f};
        cur = nxt; cA = nA; cB = nB; ++ui;
    }
    PG8_WAIT_V(0);
    if (wr == 0) PG8_BAR;
    PG8_BAR;
#undef PG8_SA
#undef PG8_SB
#undef PG8_STAGE
#undef PG8_LDA
#undef PG8_LDB
#undef PG8_MMA
#undef PG8_WAIT_V
#undef PG8_WAIT_L
#undef PG8_BAR
#undef PG8_SCHED
}
}

struct EpiG1 {
    static constexpr bool PERM = true;
    u16* P; float* GD;
    __device__ __forceinline__ void operator()(const f32x4 (&acc)[2][2][4][2], const pg8::Unit& u, int wr, int wc, int fr, int fq) const {
        const int row0 = u.pm * 256 + wr * 64 + fr;
        if (u.pn < 52) {
            const int col0 = u.pn * 256 + wc * 32 + 8 * fq;
#pragma unroll
            for (int ai = 0; ai < 2; ++ai)
#pragma unroll
                for (int m = 0; m < 4; ++m) { u16* rowp = P + (size_t)(row0 + ai * 128 + m * 16) * PW + col0;
#pragma unroll
                    for (int bj = 0; bj < 2; ++bj) { const f32x4 v0 = acc[ai][bj][m][0], v1 = acc[ai][bj][m][1];
                        u32x4 w; w.x = cvt_pk_bf16(v0[0], v0[1]); w.y = cvt_pk_bf16(v0[2], v0[3]); w.z = cvt_pk_bf16(v1[0], v1[1]); w.w = cvt_pk_bf16(v1[2], v1[3]);
                        *(u32x4*)(rowp + bj * 128) = w; } }
        } else if (wc < 3) {
            const int cc0 = wc * 32 + 8 * fq;
#pragma unroll
            for (int ai = 0; ai < 2; ++ai)
#pragma unroll
                for (int m = 0; m < 4; ++m) { float* rowp = GD + (size_t)(row0 + ai * 128 + m * 16) * GDW + cc0;
                    *(f32x4*)(rowp) = acc[ai][0][m][0]; *(f32x4*)(rowp + 4) = acc[ai][0][m][1]; }
        }
    }
};
struct EpiG2 {
    static constexpr bool PERM = false;
    const float* xres_lat; const float* xres_ctx; float* dst_lat; float* dst_ctx; const float* modl; int row_off;
    __device__ __forceinline__ void operator()(const f32x4 (&acc)[2][2][4][2], const pg8::Unit& u, int wr, int wc, int fr, int fq) const {
        const int g0 = u.pm * 256 + row_off;
        const bool isctx = g0 < CTXROWS;
        const int b = isctx ? (g0 >> 8) : ((g0 - CTXROWS) >> 13);
        const float* gate = modl + (size_t)(isctx ? 2 : b) * 6144 + 4096;
        const float* xr = isctx ? xres_ctx + (size_t)g0 * D : xres_lat + (size_t)(g0 - CTXROWS) * D;
        float* ds = isctx ? dst_ctx + (size_t)g0 * D : dst_lat + (size_t)(g0 - CTXROWS) * D;
        const int col0 = u.pn * 256 + wc * 32 + 4 * fq;
        f32x4 gv[2][2];
#pragma unroll
        for (int bj = 0; bj < 2; ++bj)
#pragma unroll
            for (int n = 0; n < 2; ++n) gv[bj][n] = *(const f32x4*)(gate + col0 + bj * 128 + n * 16);
#pragma unroll
        for (int ai = 0; ai < 2; ++ai)
#pragma unroll
            for (int m = 0; m < 4; ++m) { const size_t ro = (size_t)(wr * 64 + fr + ai * 128 + m * 16) * D + col0;
#pragma unroll
                for (int bj = 0; bj < 2; ++bj)
#pragma unroll
                    for (int n = 0; n < 2; ++n) { const f32x4 xv = *(const f32x4*)(xr + ro + bj * 128 + n * 16);
                        *(f32x4*)(ds + ro + bj * 128 + n * 16) = xv * ALPHA + gv[bj][n] * acc[ai][bj][m][n]; } }
    }
};

struct TrTile { const float* src; u16* dst; int Nsrc, K, n0, k0, perm; };
__device__ __forceinline__ void tr_load(const TrTile& t, float (&v)[8], int tid) {
    const int nl = tid & 63, kb = tid >> 6; const int n = t.n0 + nl; const int sc = t.perm ? src_col(n) : n;
#pragma unroll
    for (int i = 0; i < 8; ++i) { const int kl = i * 8 + kb; v[i] = sc >= 0 ? t.src[(size_t)(t.k0 + kl) * t.Nsrc + sc] : 0.f; }
}
__device__ __forceinline__ void tr_to_lds(const float (&v)[8], float* sf, int tid) {
    const int nl = tid & 63, kb = tid >> 6;
#pragma unroll
    for (int i = 0; i < 8; ++i) sf[(i * 8 + kb) * 65 + nl] = v[i];
}
__device__ __forceinline__ void tr_store(const TrTile& t, const float* sf, int tid) {
    const int nl2 = tid >> 3, kc = (tid & 7) * 8;
    u32x4 w;
    w.x = pk2(sf[(kc + 0) * 65 + nl2], sf[(kc + 1) * 65 + nl2]); w.y = pk2(sf[(kc + 2) * 65 + nl2], sf[(kc + 3) * 65 + nl2]);
    w.z = pk2(sf[(kc + 4) * 65 + nl2], sf[(kc + 5) * 65 + nl2]); w.w = pk2(sf[(kc + 6) * 65 + nl2], sf[(kc + 7) * 65 + nl2]);
    *(u32x4*)(t.dst + (size_t)(t.n0 + nl2) * t.K + t.k0 + kc) = w;
}
__device__ __forceinline__ TrTile tr_tile(const Params& p, int t) {
    constexpr int T_IN = (NPAD / 64) * 32, T_OUT = 32 * 64;
    const int l = t / (T_IN + T_OUT), r = t % (T_IN + T_OUT);
    TrTile o;
    if (r < T_IN) { o.src = p.w_in + (size_t)l * 2048 * NIN; o.dst = p.wt_in + (size_t)l * (SZ_WL / 2); o.Nsrc = NIN; o.K = 2048; o.n0 = (r >> 5) * 64; o.k0 = (r & 31) * 64; o.perm = 1; }
    else { const int r2 = r - T_IN; o.src = p.w_out + (size_t)l * 4096 * 2048; o.dst = p.wt_out + (size_t)l * (SZ_WL / 2); o.Nsrc = 2048; o.K = 4096; o.n0 = (r2 >> 6) * 64; o.k0 = (r2 & 63) * 64; o.perm = 0; }
    return o;
}

__device__ void weight_tiles(const Params& p, float* sf, int l) {
    constexpr int T_L = (NPAD / 64) * 32 + 32 * 64;
    const int tid = TIDX, gd = GDIM;
    const int t_end = (l + 1) * T_L;
    int t = l * T_L + BIDX;
    float v[8];
    __syncthreads();
    if (t < t_end) { const TrTile c0 = tr_tile(p, t); tr_load(c0, v, tid); }
    while (t < t_end) {
        tr_to_lds(v, sf, tid);
        __syncthreads();
        const int tn = t + gd;
        if (tn < t_end) { const TrTile nxt = tr_tile(p, tn); tr_load(nxt, v, tid); }
        { const TrTile cur = tr_tile(p, t); tr_store(cur, sf, tid); }
        __syncthreads();
        t = tn;
    }
}

__device__ void phase_a(const Params& p, unsigned char* lds) {
    float* sf = (float*)lds;
    const int tid = TIDX;
    if (BIDX < 192) {
        for (int i = tid; i < 3 * 2048; i += 512) { const int r = i >> 11, k = i & 2047; const float v = r < 2 ? p.c[r * 2048 + k] : p.c_ctx[k]; sf[i] = siluf(v); }
        __syncthreads();
    }
    for (int t = BIDX; t < 192; t += GDIM) {
        const int l = t / 96, cb = t % 96; const int col = cb * 64 + (tid & 63); const int kg = tid >> 6;
        const float* w = p.w_ada + (size_t)l * 2048 * 6144 + col;
        float a0 = 0.f, a1 = 0.f, a2 = 0.f;
#pragma unroll 8
        for (int k = kg * 256; k < kg * 256 + 256; ++k) { const float wv = w[(size_t)k * 6144]; a0 += sf[k] * wv; a1 += sf[2048 + k] * wv; a2 += sf[4096 + k] * wv; }
        float* red = sf + 6144;
        red[(kg * 3 + 0) * 64 + (tid & 63)] = a0; red[(kg * 3 + 1) * 64 + (tid & 63)] = a1; red[(kg * 3 + 2) * 64 + (tid & 63)] = a2;
        __syncthreads();
        if (tid < 192) { const int r = tid >> 6, cc = tid & 63; float s = 0.f;
#pragma unroll
            for (int g = 0; g < 8; ++g) s += red[(g * 3 + r) * 64 + cc];
            const int col2 = cb * 64 + cc; p.MOD[(size_t)(l * 3 + r) * 6144 + col2] = s + p.b_ada[l * 6144 + col2]; }
        __syncthreads();
    }
    __syncthreads();
    weight_tiles(p, sf, 0);
}

__device__ __forceinline__ void row_stats(const f32x4 (&v)[8], float& mean, float& rstd) {
    float s = 0.f;
#pragma unroll
    for (int i = 0; i < 8; ++i) s += v[i][0] + v[i][1] + v[i][2] + v[i][3];
    mean = wsum(s) * (1.f / 2048.f);
    float q = 0.f;
#pragma unroll
    for (int i = 0; i < 8; ++i) { const f32x4 d = v[i] - mean; q += d[0] * d[0] + d[1] * d[1] + d[2] * d[2] + d[3] * d[3]; }
    rstd = rsqrtf(wsum(q) * (1.f / 2048.f) + LN_EPS);
}
__device__ void phase_ln(const Params& p, int l) {
    const int wid = TIDX >> 6, lane = TIDX & 63;
    const int nw = GDIM * 8;
    const bool fin = (l == DEPTH);
    for (int row = BIDX * 8 + wid; row < MROWS; row += nw) {
        const bool isctx = row < CTXROWS;
        if (fin && isctx) continue;
        const int b = isctx ? (row >> 8) : ((row - CTXROWS) >> 13);
        float* rw = isctx ? p.RC + (size_t)row * D : p.out + (size_t)(row - CTXROWS) * D;
        const float* src = (l == 0) ? (isctx ? p.ctx + (size_t)row * D : p.x + (size_t)(row - CTXROWS) * D) : rw;
        f32x4 v[8];
#pragma unroll
        for (int i = 0; i < 8; ++i) v[i] = *(const f32x4*)(src + i * 256 + lane * 4);
        float mean, rstd;
        if (l > 0) {
            row_stats(v, mean, rstd);
            const float* g = p.ln_g + (size_t)(l - 1) * D; const float* bb = p.ln_b + (size_t)(l - 1) * D;
#pragma unroll
            for (int i = 0; i < 8; ++i) { const f32x4 gv = *(const f32x4*)(g + i * 256 + lane * 4), bv = *(const f32x4*)(bb + i * 256 + lane * 4);
                v[i] = (v[i] - mean) * rstd * gv + bv; *(f32x4*)(rw + i * 256 + lane * 4) = v[i]; }
        }
        if (fin) continue;
        row_stats(v, mean, rstd);
        const float* md = p.MOD + (size_t)(l * 3 + (isctx ? 2 : b)) * 6144;
        u16* ur = p.U + (size_t)row * 2048;
#pragma unroll
        for (int i = 0; i < 8; ++i) { const f32x4 sh = *(const f32x4*)(md + i * 256 + lane * 4), sc = *(const f32x4*)(md + 2048 + i * 256 + lane * 4);
            const f32x4 o = (v[i] - mean) * rstd * (sc + 1.f) + sh;
            u32x2 w; w.x = pk2(o[0], o[1]); w.y = pk2(o[2], o[3]);
            *(u32x2*)(ur + i * 256 + lane * 4) = w; }
    }
}

template <bool ISM> __device__ __forceinline__ int scan_row(int b, int dir, int cc, int i) {
    const bool isctx = cc < 2; const int p0 = isctx ? cc * 128 : (cc - 2) * 128; const int slen = isctx ? 256 : 8192; const int rowbase = isctx ? b * 256 : CTXROWS + b * 8192;
    const int s = dir ? slen - 1 - (p0 + i) : p0 + i;
    return rowbase + ((ISM || isctx) ? s : ((s & 127) * 64 + (s >> 7)));
}

__device__ void phase_conv(const Params& p, int l) {
    const int tid = TIDX;
    {
        const int wv = tid >> 6, lane = tid & 63;
        const int nwv = GDIM * 8;
        for (int task = BIDX * 8 + wv; task < 2 * 2 * 66 * 40; task += nwv) {
            const int hd = task % 40; int r = task / 40; const int cc = r % 66; r /= 66; const int dir = r & 1, b = r >> 1;
            if (hd < 8) {
                const int h = hd; const int row0 = scan_row<true>(b, dir, cc, 2 * lane), row1 = scan_row<true>(b, dir, cc, 2 * lane + 1);
                const float gbi = p.gate_b[l * 32 + (dir * 2) * 8 + h], gbf = p.gate_b[l * 32 + (dir * 2 + 1) * 8 + h];
                const float li0 = p.GD[(size_t)row0 * GDW + (dir * 2) * 8 + h] + gbi, li1 = p.GD[(size_t)row1 * GDW + (dir * 2) * 8 + h] + gbi;
                const float x0 = p.GD[(size_t)row0 * GDW + (dir * 2 + 1) * 8 + h] + gbf, x1 = p.GD[(size_t)row1 * GDW + (dir * 2 + 1) * 8 + h] + gbf;
                const float lf0 = fminf(x0, 0.f) - log1pf(__expf(-fabsf(x0))), lf1 = fminf(x1, 0.f) - log1pf(__expf(-fabsf(x1)));
                const float a1 = lf0 + lf1;
                const float inc = scan_add(a1, lane); const float exc = inc - a1;
                const float b0 = exc + lf0, b1 = exc + a1;
                const float u0 = li0 - b0, u1 = li1 - b1;
                const float incm = scan_max(fmaxf(u0, u1), lane); float excm = __shfl_up(incm, 1, 64); if (lane == 0) excm = -3.0e38f;
                const float M0 = fmaxf(excm, u0), M1 = fmaxf(M0, u1);
                float* o0 = p.G2 + (size_t)row0 * G2W + (dir * 8 + h) * 3; float* o1 = p.G2 + (size_t)row1 * G2W + (dir * 8 + h) * 3;
                o0[0] = b0; o0[1] = u0; o0[2] = M0; o1[0] = b1; o1[1] = u1; o1[2] = M1;
            } else {
                const int hh = hd - 8; const int row0 = scan_row<false>(b, dir, cc, 2 * lane), row1 = scan_row<false>(b, dir, cc, 2 * lane + 1);
                const float dtb = p.dt_bias[(l * 2 + dir) * 32 + hh]; const float Ah = -__expf(p.a_log[(l * 2 + dir) * 32 + hh]);
                const float r0 = p.GD[(size_t)row0 * GDW + 32 + dir * 32 + hh] + dtb, r1 = p.GD[(size_t)row1 * GDW + 32 + dir * 32 + hh] + dtb;
                const float dt0 = fmaxf(r0, 0.f) + log1pf(__expf(-fabsf(r0))), dt1 = fmaxf(r1, 0.f) + log1pf(__expf(-fabsf(r1)));
                const float d0 = dt0 * Ah, d1 = dt1 * Ah;
                const float a1 = d0 + d1;
                const float inc = scan_add(a1, lane); const float exc = inc - a1;
                float* o0 = p.G2 + (size_t)row0 * G2W + 48 + (dir * 32 + hh) * 2; float* o1 = p.G2 + (size_t)row1 * G2W + 48 + (dir * 32 + hh) * 2;
                o0[0] = dt0; o0[1] = exc + d0; o1[0] = dt1; o1[1] = exc + a1;
            }
        }
    }
    const int ci = tid & 127, rs = tid >> 7;
    for (int t = BIDX; t < 528 * 5; t += GDIM) {
        const int cgp = t % 5, rg = t / 5;
        int pcol, ocol, wstride; const float *w, *bias; bool isx; float scale = 1.f;
        if (cgp < 2) { const int c = (cgp * 128 + ci) * 8; pcol = c; ocol = c; w = p.conv_qk_w + (size_t)l * 3 * 2048 + c; bias = p.conv_qk_b + (size_t)l * 2048 + c; wstride = 2048; isx = false;
            if (c < 1024) scale = 0.08838834764831845f; }
        else { const int c = ((cgp - 2) * 128 + ci) * 8; pcol = 8192 + c; ocol = 2048 + c; w = p.conv_xbc_w + (size_t)l * 3 * 3072 + c; bias = p.conv_xbc_b + (size_t)l * 3072 + c; wstride = 3072; isx = true; }
        float w0[8], w1[8], w2[8], bb[8];
#pragma unroll
        for (int e = 0; e < 8; ++e) { w0[e] = w[e]; w1[e] = w[wstride + e]; w2[e] = w[2 * wstride + e]; bb[e] = bias[e]; }
        const int r0 = rg * 32 + rs * 8;
        const bool lat = r0 >= CTXROWS;
        const int seqbase = lat ? (CTXROWS + (((r0 - CTXROWS) >> 13) << 13)) : (r0 & ~255);
        const int seqlen = lat ? 8192 : 256;
        const int sp0 = r0 - seqbase;
        const bool cm = lat && isx;
        u32x4 win[10];
#pragma unroll
        for (int i = 0; i < 10; ++i) { const int sp = sp0 - 1 + i;
            const int row = seqbase + (cm ? ((sp & 127) * 64 + (sp >> 7)) : sp);
            win[i] = (sp >= 0 && sp < seqlen) ? *(const u32x4*)(p.P + (size_t)row * PW + pcol) : (u32x4){0u, 0u, 0u, 0u}; }
#pragma unroll
        for (int i = 0; i < 8; ++i) { const int sp = sp0 + i;
            const int row = seqbase + (cm ? ((sp & 127) * 64 + (sp >> 7)) : sp);
            const u32x4 ap = win[i], a = win[i + 1], an = win[i + 2];
            u32x4 o;
#pragma unroll
            for (int e2 = 0; e2 < 4; ++e2) {
                const float y0 = w0[2 * e2] * bflo(ap[e2]) + w1[2 * e2] * bflo(a[e2]) + w2[2 * e2] * bflo(an[e2]) + bb[2 * e2];
                const float y1 = w0[2 * e2 + 1] * bfhi(ap[e2]) + w1[2 * e2 + 1] * bfhi(a[e2]) + w2[2 * e2 + 1] * bfhi(an[e2]) + bb[2 * e2 + 1];
                o[e2] = pk2(siluf(y0) * scale, siluf(y1) * scale);
            }
            *(u32x4*)(p.QKX + (size_t)row * QW + ocol) = o;
        }
    }
}

constexpr int LDK = 136, LDV = 88;
constexpr int LS_K = 0, LS_V = 34816, LS_VW = LS_V + 128 * LDV * 2, LS_CT = LS_VW + 128 * LDV * 2, LS_F = LS_CT + 80 * LDK * 2;

#define LDS_BAR() do { asm volatile("s_waitcnt lgkmcnt(0)" ::: "memory"); __builtin_amdgcn_s_barrier(); asm volatile("" ::: "memory"); } while (0)
#define TR_RD8(r0, r1, r2, r3, r4, r5, r6, r7, base, o0, o1, o2, o3, o4, o5, o6, o7) \
    asm volatile("ds_read_b64_tr_b16 %0, %8 offset:%9\n\tds_read_b64_tr_b16 %1, %8 offset:%10\n\tds_read_b64_tr_b16 %2, %8 offset:%11\n\tds_read_b64_tr_b16 %3, %8 offset:%12\n\t" \
                 "ds_read_b64_tr_b16 %4, %8 offset:%13\n\tds_read_b64_tr_b16 %5, %8 offset:%14\n\tds_read_b64_tr_b16 %6, %8 offset:%15\n\tds_read_b64_tr_b16 %7, %8 offset:%16\n\ts_waitcnt lgkmcnt(0)" \
                 : "=&v"(r0), "=&v"(r1), "=&v"(r2), "=&v"(r3), "=&v"(r4), "=&v"(r5), "=&v"(r6), "=&v"(r7) \
                 : "v"(base), "n"(o0), "n"(o1), "n"(o2), "n"(o3), "n"(o4), "n"(o5), "n"(o6), "n"(o7) : "memory")
#define TR_RD2(r0, r1, base, o0, o1) \
    asm volatile("ds_read_b64_tr_b16 %0, %2 offset:%3\n\tds_read_b64_tr_b16 %1, %2 offset:%4\n\ts_waitcnt lgkmcnt(0)" : "=&v"(r0), "=&v"(r1) : "v"(base), "n"(o0), "n"(o1) : "memory")
#define TR_ST10(K0_, K1_, A0_, A1_, A2_, A3_, A4_, A5_, A6_, A7_, BK_, BV_, OK0_, OK1_, OV0_, OV1_, OV2_, OV3_, OV4_, OV5_, OV6_, OV7_) \
    asm volatile("ds_read_b64_tr_b16 %[rk0], %[bk] offset:%[ok0]\n\tds_read_b64_tr_b16 %[rk1], %[bk] offset:%[ok1]\n\t" \
                 "ds_read_b64_tr_b16 %[ra0], %[bv] offset:%[ov0]\n\tds_read_b64_tr_b16 %[ra1], %[bv] offset:%[ov1]\n\tds_read_b64_tr_b16 %[ra2], %[bv] offset:%[ov2]\n\tds_read_b64_tr_b16 %[ra3], %[bv] offset:%[ov3]\n\t" \
                 "ds_read_b64_tr_b16 %[ra4], %[bv] offset:%[ov4]\n\tds_read_b64_tr_b16 %[ra5], %[bv] offset:%[ov5]\n\tds_read_b64_tr_b16 %[ra6], %[bv] offset:%[ov6]\n\tds_read_b64_tr_b16 %[ra7], %[bv] offset:%[ov7]\n\ts_waitcnt lgkmcnt(0)" \
                 : [rk0] "=&v"(K0_), [rk1] "=&v"(K1_), [ra0] "=&v"(A0_), [ra1] "=&v"(A1_), [ra2] "=&v"(A2_), [ra3] "=&v"(A3_), [ra4] "=&v"(A4_), [ra5] "=&v"(A5_), [ra6] "=&v"(A6_), [ra7] "=&v"(A7_) \
                 : [bk] "v"(BK_), [bv] "v"(BV_), [ok0] "n"(OK0_), [ok1] "n"(OK1_), [ov0] "n"(OV0_), [ov1] "n"(OV1_), [ov2] "n"(OV2_), [ov3] "n"(OV3_), [ov4] "n"(OV4_), [ov5] "n"(OV5_), [ov6] "n"(OV6_), [ov7] "n"(OV7_) : "memory")
#define TR_ST12(K0_, K1_, A0_, A1_, A2_, A3_, A4_, A5_, A6_, A7_, A8_, A9_, BK_, BV_, OK0_, OK1_, OV0_, OV1_, OV2_, OV3_, OV4_, OV5_, OV6_, OV7_, OV8_, OV9_) \
    asm volatile("ds_read_b64_tr_b16 %[rk0], %[bk] offset:%[ok0]\n\tds_read_b64_tr_b16 %[rk1], %[bk] offset:%[ok1]\n\t" \
                 "ds_read_b64_tr_b16 %[ra0], %[bv] offset:%[ov0]\n\tds_read_b64_tr_b16 %[ra1], %[bv] offset:%[ov1]\n\tds_read_b64_tr_b16 %[ra2], %[bv] offset:%[ov2]\n\tds_read_b64_tr_b16 %[ra3], %[bv] offset:%[ov3]\n\t" \
                 "ds_read_b64_tr_b16 %[ra4], %[bv] offset:%[ov4]\n\tds_read_b64_tr_b16 %[ra5], %[bv] offset:%[ov5]\n\tds_read_b64_tr_b16 %[ra6], %[bv] offset:%[ov6]\n\tds_read_b64_tr_b16 %[ra7], %[bv] offset:%[ov7]\n\t" \
                 "ds_read_b64_tr_b16 %[ra8], %[bv] offset:%[ov8]\n\tds_read_b64_tr_b16 %[ra9], %[bv] offset:%[ov9]\n\ts_waitcnt lgkmcnt(0)" \
                 : [rk0] "=&v"(K0_), [rk1] "=&v"(K1_), [ra0] "=&v"(A0_), [ra1] "=&v"(A1_), [ra2] "=&v"(A2_), [ra3] "=&v"(A3_), [ra4] "=&v"(A4_), [ra5] "=&v"(A5_), [ra6] "=&v"(A6_), [ra7] "=&v"(A7_), [ra8] "=&v"(A8_), [ra9] "=&v"(A9_) \
                 : [bk] "v"(BK_), [bv] "v"(BV_), [ok0] "n"(OK0_), [ok1] "n"(OK1_), [ov0] "n"(OV0_), [ov1] "n"(OV1_), [ov2] "n"(OV2_), [ov3] "n"(OV3_), [ov4] "n"(OV4_), [ov5] "n"(OV5_), [ov6] "n"(OV6_), [ov7] "n"(OV7_), [ov8] "n"(OV8_), [ov9] "n"(OV9_) : "memory")
__device__ __forceinline__ bf16x8 mkfrag(u32x2 lo, u32x2 hi) { const u32x4 w = {lo.x, lo.y, hi.x, hi.y}; return __builtin_bit_cast(bf16x8, w); }

template <bool ISM>
__device__ void scan_item(const Params& p, int l, int item, unsigned char* lds) {
    constexpr int NT = ISM ? 5 : 4;
    constexpr float L2E = 1.4426950408889634f;
    const int tid = TIDX, wid = __builtin_amdgcn_readfirstlane(tid >> 6), lane = tid & 63, fr = lane & 15, fq = lane >> 4;
    const int trq = fr >> 2, trp = fr & 3;
    const int sl = ISM ? (item & 3) : 0, dir = ISM ? ((item >> 2) & 1) : (item & 1), h = ISM ? ((item >> 3) & 7) : ((item >> 1) & 31), b = item >> 6;
    const int qcol = ISM ? h * 128 : 2048 + 2560 + (h >> 3) * 128;
    const int kcol = ISM ? 1024 + h * 128 : 2048 + 2048 + (h >> 3) * 128;
    const int vcol = ISM ? 2048 + h * 256 + sl * 64 : 2048 + h * 64;
    const int ocol = ISM ? h * 256 + sl * 64 : h * 64;
    u16* const obase = dir ? (ISM ? p.HB : p.YB) : (ISM ? p.P : p.P + 8192);
    const unsigned ostride = dir ? 2048u : (unsigned)PW;
    u16* Ks = (u16*)(lds + LS_K); u16* Vs = (u16*)(lds + LS_V); u16* Vw = (u16*)(lds + LS_VW); u16* CT = (u16*)(lds + LS_CT);
    float* F = (float*)(lds + LS_F);
    float *f_c = F, *f_r = F + 128, *f_wi = F + 256, *f_ws = F + 384, *f_em = F + 512;
    const unsigned ldsb = (unsigned)(size_t)(LAS unsigned char*)lds;
    const unsigned trK = ldsb + LS_K + (unsigned)(((fq * 8 + trq) * LDK + 16 * wid + 4 * trp) * 2);
    const unsigned trVw = ldsb + LS_VW + (unsigned)(((fq * 8 + trq) * LDV + 4 * trp) * 2);
    const unsigned trV = ldsb + LS_V + (unsigned)(((fq * 4 + trq) * LDV + 4 * trp) * 2);
    const float Dh = ISM ? 0.f : p.d_skip[l * 32 + h];
    const u16* __restrict__ gQKX = p.QKX; const u16* __restrict__ gP = p.P; const float* __restrict__ gG2 = p.G2;
    const int gcol = ISM ? (dir * 8 + h) * 3 : 48 + (dir * 32 + h) * 2;
    __syncthreads();
    for (int i = tid; i < 128 * 24; i += 512) { const int r = i / 24, cc = 64 + i % 24; Vs[r * LDV + cc] = (ISM && cc == 64) ? (u16)0x3F80 : (u16)0; Vw[r * LDV + cc] = 0; }
    for (int i = tid; i < 80 * LDK; i += 512) CT[i] = 0;
    f32x4 st[NT];
#pragma unroll
    for (int m = 0; m < NT; ++m) st[m] = (f32x4){0.f, 0.f, 0.f, 0.f};
    float m_prev = 0.f;
    unsigned qo, ko[4], vo[2], go, ge, oo[4];
    bf16x8 qf[4]; u32x4 kr[4]; u32x4 vr[2]; f32x3 gv = {0.f, 0.f, 0.f}; float e0 = 0.f, e1 = 0.f;
#define SCAN_PTRS(cc) do { \
        qo = (unsigned)scan_row<ISM>(b, dir, (cc), 16 * wid + fr) * (unsigned)QW + (unsigned)(qcol + fq * 8); \
        _Pragma("unroll") for (int r_ = 0; r_ < 4; ++r_) { const int idx_ = r_ * 512 + tid; ko[r_] = (unsigned)scan_row<ISM>(b, dir, (cc), idx_ >> 4) * (unsigned)QW + (unsigned)(kcol + (idx_ & 15) * 8); } \
        _Pragma("unroll") for (int r_ = 0; r_ < 2; ++r_) { const int idx_ = r_ * 512 + tid; vo[r_] = (unsigned)scan_row<ISM>(b, dir, (cc), idx_ >> 3) * (unsigned)(ISM ? PW : QW) + (unsigned)(vcol + (idx_ & 7) * 8); } \
        go = (unsigned)scan_row<ISM>(b, dir, (cc), tid & 127) * (unsigned)G2W + (unsigned)gcol; ge = (unsigned)scan_row<ISM>(b, dir, (cc), 127) * (unsigned)G2W + (unsigned)gcol; \
        _Pragma("unroll") for (int j_ = 0; j_ < 4; ++j_) oo[j_] = (unsigned)scan_row<ISM>(b, dir, (cc), 16 * wid + fq * 4 + j_) * ostride + (unsigned)(ocol + fr); \
    } while (0)
#define SCAN_ADV(dr) do { const unsigned dq_ = (unsigned)((dr) * QW), dp_ = (unsigned)((dr) * PW), dg_ = (unsigned)((dr) * G2W), do_ = (unsigned)(dr) * ostride; \
        qo += dq_; _Pragma("unroll") for (int r_ = 0; r_ < 4; ++r_) ko[r_] += dq_; vo[0] += ISM ? dp_ : dq_; vo[1] += ISM ? dp_ : dq_; go += dg_; ge += dg_; \
        _Pragma("unroll") for (int j_ = 0; j_ < 4; ++j_) oo[j_] += do_; } while (0)
#define SCAN_LOAD() do { \
        _Pragma("unroll") for (int k_ = 0; k_ < 4; ++k_) qf[k_] = *(const bf16x8*)(gQKX + (size_t)qo + k_ * 32); \
        _Pragma("unroll") for (int r_ = 0; r_ < 4; ++r_) kr[r_] = *(const u32x4*)(gQKX + (size_t)ko[r_]); \
        _Pragma("unroll") for (int r_ = 0; r_ < 2; ++r_) vr[r_] = ISM ? *(const u32x4*)(gP + (size_t)vo[r_]) : *(const u32x4*)(gQKX + (size_t)vo[r_]); \
        if (tid < 128) gv = *(const f32x3*)(gG2 + (size_t)go); \
        if (ISM) { e0 = gG2[(size_t)ge]; e1 = gG2[(size_t)ge + 2]; } else { e0 = gG2[(size_t)ge + 1]; } \
    } while (0)
    SCAN_PTRS(0); SCAN_LOAD();
    const int dr_ctx = dir ? -128 : 128, dr_lat = ISM ? dr_ctx : (dir ? -1 : 1);
    __syncthreads();
#pragma unroll 1
    for (int c = 0; c < 66; ++c) {
#pragma unroll
        for (int rep = 0; rep < 4; ++rep) { const int idx = rep * 512 + tid; *(u32x4*)(Ks + (idx >> 4) * LDK + (idx & 15) * 8) = kr[rep]; }
#pragma unroll
        for (int rep = 0; rep < 2; ++rep) { const int idx = rep * 512 + tid; *(u32x4*)(Vs + (idx >> 3) * LDV + (idx & 7) * 8) = vr[rep]; }
        float decay;
        if (ISM) {
            const float Ml = fmaxf(m_prev, e1);
            if (tid < 128) { const float M = fmaxf(m_prev, gv[2]);
                f_c[tid] = gv[1] * L2E; f_r[tid] = M * L2E; f_wi[tid] = __expf(m_prev - M); f_ws[tid] = __expf(gv[1] - Ml); f_em[tid] = __expf(-(gv[0] + M)); }
            decay = __expf(m_prev - Ml); m_prev = e0 + Ml;
        } else {
            if (tid < 128) { f_c[tid] = (__logf(gv[0]) - gv[1]) * L2E; f_r[tid] = -gv[1] * L2E; f_wi[tid] = __expf(gv[1]); f_ws[tid] = __expf(e0 - gv[1]) * gv[0]; }
            decay = __expf(e0);
        }
        bf16x8 qc[4]; unsigned od[4];
#pragma unroll
        for (int k = 0; k < 4; ++k) qc[k] = qf[k];
#pragma unroll
        for (int j = 0; j < 4; ++j) od[j] = oo[j];
        const u32x4 vc0 = vr[0], vc1 = vr[1];
        LDS_BAR();
        if (c + 1 < 66) { if (c + 1 == 2) SCAN_PTRS(2); else SCAN_ADV(c == 0 ? dr_ctx : dr_lat); SCAN_LOAD(); }
        f32x4 sacc[8];
#pragma unroll
        for (int a = 0; a < 8; ++a) sacc[a] = (f32x4){0.f, 0.f, 0.f, 0.f};
#pragma unroll
        for (int a = 0; a < 8; a += 2) {
            if (a + 1 <= wid) {
                bf16x8 kf[2][4];
#pragma unroll
                for (int h2 = 0; h2 < 2; ++h2)
#pragma unroll
                    for (int ksd = 0; ksd < 4; ++ksd) kf[h2][ksd] = *(const bf16x8*)(Ks + (16 * (a + h2) + fr) * LDK + ksd * 32 + fq * 8);
#pragma unroll
                for (int ksd = 0; ksd < 4; ++ksd) { sacc[a] = __builtin_amdgcn_mfma_f32_16x16x32_bf16(kf[0][ksd], qc[ksd], sacc[a], 0, 0, 0);
                    sacc[a + 1] = __builtin_amdgcn_mfma_f32_16x16x32_bf16(kf[1][ksd], qc[ksd], sacc[a + 1], 0, 0, 0); }
            } else if (a <= wid) {
                bf16x8 kf[4];
#pragma unroll
                for (int ksd = 0; ksd < 4; ++ksd) kf[ksd] = *(const bf16x8*)(Ks + (16 * a + fr) * LDK + ksd * 32 + fq * 8);
#pragma unroll
                for (int ksd = 0; ksd < 4; ++ksd) sacc[a] = __builtin_amdgcn_mfma_f32_16x16x32_bf16(kf[ksd], qc[ksd], sacc[a], 0, 0, 0);
            }
        }
        bf16x8 sf[4]; float dsum = 0.f;
        { const float rt = f_r[16 * wid + fr];
          f32x4 cva[8];
#pragma unroll
          for (int a = 0; a < 8; ++a) cva[a] = *(const f32x4*)(f_c + 16 * a + fq * 4);
#pragma unroll
          for (int ks = 0; ks < 4; ++ks) { u32x4 w;
#pragma unroll
              for (int hf = 0; hf < 2; ++hf) { const int a = 2 * ks + hf; float v[4];
                  if (a < wid) { const f32x4 cv = cva[a];
#pragma unroll
                      for (int j = 0; j < 4; ++j) { v[j] = sacc[a][j] * __builtin_amdgcn_exp2f(cv[j] - rt); dsum += v[j]; }
                  } else if (a == wid) { const f32x4 cv = cva[a];
#pragma unroll
                      for (int j = 0; j < 4; ++j) { const float e = sacc[a][j] * __builtin_amdgcn_exp2f(cv[j] - rt); v[j] = (fq * 4 + j <= fr) ? e : 0.f; dsum += v[j]; }
                  } else { v[0] = 0.f; v[1] = 0.f; v[2] = 0.f; v[3] = 0.f; }
                  w[hf * 2] = pk2(v[0], v[1]); w[hf * 2 + 1] = pk2(v[2], v[3]); }
              sf[ks] = __builtin_bit_cast(bf16x8, w); } }
        dsum += __shfl_xor(dsum, 16, 64); dsum += __shfl_xor(dsum, 32, 64);
        {
#pragma unroll
          for (int rep = 0; rep < 2; ++rep) { const int idx = rep * 512 + tid; const int i = idx >> 3; const float wv = f_ws[i]; const u32x4 vc = rep ? vc1 : vc0; u32x4 o;
#pragma unroll
              for (int e = 0; e < 4; ++e) o[e] = pk2(bflo(vc[e]) * wv, bfhi(vc[e]) * wv);
              *(u32x4*)(Vw + i * LDV + (idx & 7) * 8) = o; }
          if (ISM && tid < 128) Vw[tid * LDV + 64] = f2bf(f_ws[tid]); }
        { f32x4 ia[NT], ib[4];
#pragma unroll
          for (int n = 0; n < NT; ++n) ia[n] = (f32x4){0.f, 0.f, 0.f, 0.f};
#pragma unroll
          for (int n = 0; n < 4; ++n) ib[n] = (f32x4){0.f, 0.f, 0.f, 0.f};
#pragma unroll
          for (int ksd = 0; ksd < 4; ++ksd) { bf16x8 bfr[NT];
#pragma unroll
              for (int n = 0; n < NT; ++n) bfr[n] = *(const bf16x8*)(CT + (n * 16 + fr) * LDK + ksd * 32 + fq * 8);
#pragma unroll
              for (int n = 0; n < NT; ++n) ia[n] = __builtin_amdgcn_mfma_f32_16x16x32_bf16(qc[ksd], bfr[n], ia[n], 0, 0, 0); }
#define SCAN_IB(ks) if (2 * (ks) <= wid) { u32x2 r0, r1, r2, r3, r4, r5, r6, r7; \
              TR_RD8(r0, r1, r2, r3, r4, r5, r6, r7, trV, (ks) * 32 * LDV * 2, (ks) * 32 * LDV * 2 + 16 * LDV * 2, (ks) * 32 * LDV * 2 + 32, (ks) * 32 * LDV * 2 + 16 * LDV * 2 + 32, \
                     (ks) * 32 * LDV * 2 + 64, (ks) * 32 * LDV * 2 + 16 * LDV * 2 + 64, (ks) * 32 * LDV * 2 + 96, (ks) * 32 * LDV * 2 + 16 * LDV * 2 + 96); \
              ib[0] = __builtin_amdgcn_mfma_f32_16x16x32_bf16(sf[ks], mkfrag(r0, r1), ib[0], 0, 0, 0); ib[1] = __builtin_amdgcn_mfma_f32_16x16x32_bf16(sf[ks], mkfrag(r2, r3), ib[1], 0, 0, 0); \
              ib[2] = __builtin_amdgcn_mfma_f32_16x16x32_bf16(sf[ks], mkfrag(r4, r5), ib[2], 0, 0, 0); ib[3] = __builtin_amdgcn_mfma_f32_16x16x32_bf16(sf[ks], mkfrag(r6, r7), ib[3], 0, 0, 0); }
          SCAN_IB(0) SCAN_IB(1) SCAN_IB(2) SCAN_IB(3)
#undef SCAN_IB
#pragma unroll
          for (int j = 0; j < 4; ++j) { const int tl = fq * 4 + j, t = 16 * wid + tl; const float wi = f_wi[t];
              float inv = 1.f;
              if (ISM) { const float qn = __shfl(ia[NT - 1][j], lane & 48, 64); const float dn = __shfl(dsum, tl, 64); inv = __builtin_amdgcn_rcpf(fmaxf(fabsf(wi * qn + dn), f_em[t])); }
              u16* dst = obase + (size_t)od[j];
              float v[4];
#pragma unroll
              for (int n = 0; n < 4; ++n) { v[n] = (wi * ia[n][j] + ib[n][j]) * inv; if (!ISM && dir == 0) v[n] += Dh * bf2f(Vs[t * LDV + n * 16 + fr]); }
              const unsigned p01 = pk2(v[0], v[1]), p23 = pk2(v[2], v[3]);
              dst[0] = (u16)(p01 & 0xFFFFu); dst[16] = (u16)(p01 >> 16); dst[32] = (u16)(p23 & 0xFFFFu); dst[48] = (u16)(p23 >> 16); } }
        LDS_BAR();
        {
#pragma unroll
          for (int m = 0; m < NT; ++m) st[m] *= decay;
#define SCAN_ST(ks) { u32x2 k0, k1, a0, a1, a2, a3, a4, a5, a6, a7, a8, a9; \
              if (ISM) TR_ST12(k0, k1, a0, a1, a2, a3, a4, a5, a6, a7, a8, a9, trK, trVw, (ks) * 32 * LDK * 2, (ks) * 32 * LDK * 2 + 4 * LDK * 2, \
                     (ks) * 32 * LDV * 2, (ks) * 32 * LDV * 2 + 4 * LDV * 2, (ks) * 32 * LDV * 2 + 32, (ks) * 32 * LDV * 2 + 4 * LDV * 2 + 32, \
                     (ks) * 32 * LDV * 2 + 64, (ks) * 32 * LDV * 2 + 4 * LDV * 2 + 64, (ks) * 32 * LDV * 2 + 96, (ks) * 32 * LDV * 2 + 4 * LDV * 2 + 96, \
                     (ks) * 32 * LDV * 2 + 128, (ks) * 32 * LDV * 2 + 4 * LDV * 2 + 128); \
              else TR_ST10(k0, k1, a0, a1, a2, a3, a4, a5, a6, a7, trK, trVw, (ks) * 32 * LDK * 2, (ks) * 32 * LDK * 2 + 4 * LDK * 2, \
                     (ks) * 32 * LDV * 2, (ks) * 32 * LDV * 2 + 4 * LDV * 2, (ks) * 32 * LDV * 2 + 32, (ks) * 32 * LDV * 2 + 4 * LDV * 2 + 32, \
                     (ks) * 32 * LDV * 2 + 64, (ks) * 32 * LDV * 2 + 4 * LDV * 2 + 64, (ks) * 32 * LDV * 2 + 96, (ks) * 32 * LDV * 2 + 4 * LDV * 2 + 96); \
              const bf16x8 kfr = mkfrag(k0, k1); \
              st[0] = __builtin_amdgcn_mfma_f32_16x16x32_bf16(mkfrag(a0, a1), kfr, st[0], 0, 0, 0); st[1] = __builtin_amdgcn_mfma_f32_16x16x32_bf16(mkfrag(a2, a3), kfr, st[1], 0, 0, 0); \
              st[2] = __builtin_amdgcn_mfma_f32_16x16x32_bf16(mkfrag(a4, a5), kfr, st[2], 0, 0, 0); st[3] = __builtin_amdgcn_mfma_f32_16x16x32_bf16(mkfrag(a6, a7), kfr, st[3], 0, 0, 0); \
              if (ISM) st[NT - 1] = __builtin_amdgcn_mfma_f32_16x16x32_bf16(mkfrag(a8, a9), kfr, st[NT - 1], 0, 0, 0); }
          SCAN_ST(0) SCAN_ST(1) SCAN_ST(2) SCAN_ST(3)
#undef SCAN_ST
#pragma unroll
          for (int m = 0; m < NT; ++m) { const unsigned p01 = pk2(st[m][0], st[m][1]), p23 = pk2(st[m][2], st[m][3]);
              u16* cp = CT + (m * 16 + fq * 4) * LDK + 16 * wid + fr;
              cp[0] = (u16)(p01 & 0xFFFFu); cp[LDK] = (u16)(p01 >> 16); cp[2 * LDK] = (u16)(p23 & 0xFFFFu); cp[3 * LDK] = (u16)(p23 >> 16); } }
        LDS_BAR();
    }
#undef SCAN_LOAD
#undef SCAN_ADV
#undef SCAN_PTRS
}

__device__ void phase_scan(const Params& p, int l, unsigned char* lds) {
    for (int blk = BIDX; blk < 256; blk += GDIM) {
        const int xcd = blk & 7, j = blk >> 3;
        if (j < 16) scan_item<true>(p, l, (xcd + 8 * (j >> 2)) * 4 + (j & 3), lds);
        else { const int G = xcd + 8 * ((j - 16) >> 3), r = (j - 16) & 7; const int dir = G & 1, g = (G >> 1) & 3, b = G >> 3;
            scan_item<false>(p, l, dir + 2 * (g * 8 + r) + 64 * b, lds); }
    }
}

__device__ void phase_post(const Params& p, int l) {
    const int wid = TIDX >> 6, lane = TIDX & 63;
    const int nw = GDIM * 8;
    const int c0 = lane * 32;
    for (int row = BIDX * 8 + wid; row < MROWS; row += nw) {
        u16* pr = p.P + (size_t)row * PW;
        {
            float tv[32]; float ss = 0.f;
#pragma unroll
            for (int q = 0; q < 4; ++q) { const u32x4 yv = *(const u32x4*)(pr + 8192 + c0 + q * 8), zv = *(const u32x4*)(pr + 11264 + c0 + q * 8), yb = *(const u32x4*)(p.YB + (size_t)row * 2048 + c0 + q * 8);
#pragma unroll
                for (int e = 0; e < 4; ++e) { const float t0 = (bflo(yv[e]) + bflo(yb[e])) * siluf(bflo(zv[e])), t1 = (bfhi(yv[e]) + bfhi(yb[e])) * siluf(bfhi(zv[e]));
                    tv[q * 8 + 2 * e] = t0; tv[q * 8 + 2 * e + 1] = t1; ss += t0 * t0 + t1 * t1; } }
            const float rstd = rsqrtf(wsum(ss) * (1.f / 2048.f) + LN_EPS);
            const float* sw = p.ssm_w + (size_t)l * 2048 + c0;
#pragma unroll
            for (int q = 0; q < 4; ++q) { const f32x4 wa = *(const f32x4*)(sw + q * 8), wb = *(const f32x4*)(sw + q * 8 + 4);
                u32x4 o; o.x = pk2(tv[q * 8] * rstd * wa[0], tv[q * 8 + 1] * rstd * wa[1]); o.y = pk2(tv[q * 8 + 2] * rstd * wa[2], tv[q * 8 + 3] * rstd * wa[3]);
                o.z = pk2(tv[q * 8 + 4] * rstd * wb[0], tv[q * 8 + 5] * rstd * wb[1]); o.w = pk2(tv[q * 8 + 6] * rstd * wb[2], tv[q * 8 + 7] * rstd * wb[3]);
                *(u32x4*)(pr + 11264 + c0 + q * 8) = o; }
        }
        {
            float hv[32]; float s = 0.f;
#pragma unroll
            for (int q = 0; q < 4; ++q) { const u32x4 a = *(const u32x4*)(pr + c0 + q * 8), ab = *(const u32x4*)(p.HB + (size_t)row * 2048 + c0 + q * 8);
#pragma unroll
                for (int e = 0; e < 4; ++e) { const float h0 = bflo(a[e]) + bflo(ab[e]), h1 = bfhi(a[e]) + bfhi(ab[e]); hv[q * 8 + 2 * e] = h0; hv[q * 8 + 2 * e + 1] = h1; s += h0 + h1; } }
            s += __shfl_xor(s, 1, 64); s += __shfl_xor(s, 2, 64); s += __shfl_xor(s, 4, 64);
            const float mean = s * (1.f / 256.f);
            float q2 = 0.f;
#pragma unroll
            for (int e = 0; e < 32; ++e) { const float d = hv[e] - mean; q2 += d * d; }
            q2 += __shfl_xor(q2, 1, 64); q2 += __shfl_xor(q2, 2, 64); q2 += __shfl_xor(q2, 4, 64);
            const float rstd = rsqrtf(q2 * (1.f / 256.f) + LN_EPS);
            const float* mw = p.mh_w + (size_t)l * 2048 + c0;
#pragma unroll
            for (int q = 0; q < 4; ++q) { const u32x4 ov = *(const u32x4*)(pr + 4096 + c0 + q * 8), zv = *(const u32x4*)(pr + 6144 + c0 + q * 8);
                const f32x4 wa = *(const f32x4*)(mw + q * 8), wb = *(const f32x4*)(mw + q * 8 + 4);
                float r[8];
#pragma unroll
                for (int e = 0; e < 4; ++e) {
                    const float m0 = (e < 2 ? wa[2 * e] : wb[2 * e - 4]), m1 = (e < 2 ? wa[2 * e + 1] : wb[2 * e - 3]);
                    r[2 * e] = sigmf(bflo(ov[e])) * ((hv[q * 8 + 2 * e] - mean) * rstd * m0) * siluf(bflo(zv[e]));
                    r[2 * e + 1] = sigmf(bfhi(ov[e])) * ((hv[q * 8 + 2 * e + 1] - mean) * rstd * m1) * siluf(bfhi(zv[e])); }
                u32x4 o; o.x = pk2(r[0], r[1]); o.y = pk2(r[2], r[3]); o.z = pk2(r[4], r[5]); o.w = pk2(r[6], r[7]);
                *(u32x4*)(pr + 9216 + c0 + q * 8) = o; }
        }
    }
}

__device__ __forceinline__ void grid_barrier(unsigned* ctr, unsigned target) {
    __syncthreads();
    if (threadIdx.x == 0) {
        __builtin_amdgcn_fence(__ATOMIC_RELEASE, "agent");
        asm volatile("s_waitcnt vmcnt(0)" ::: "memory");
        __hip_atomic_fetch_add(ctr, 1u, __ATOMIC_RELAXED, __HIP_MEMORY_SCOPE_AGENT);
        while (__hip_atomic_load(ctr, __ATOMIC_RELAXED, __HIP_MEMORY_SCOPE_AGENT) < target) __builtin_amdgcn_s_sleep(2);
        __builtin_amdgcn_fence(__ATOMIC_ACQUIRE, "agent");
        asm volatile("s_waitcnt vmcnt(0)" ::: "memory");
    }
    __syncthreads();
}
__device__ __forceinline__ void acquire_workgroup() {
    if (threadIdx.x == 0) { __builtin_amdgcn_fence(__ATOMIC_ACQUIRE, "agent"); asm volatile("s_waitcnt vmcnt(0)" ::: "memory"); }
    __syncthreads();
}

constexpr int N_PHASES = 2 + 6 * DEPTH;
__global__ __launch_bounds__(512, 2) void mega(KArgs ka, int ph_lo, int ph_hi) {
    extern __shared__ __attribute__((aligned(16))) unsigned char shm[];
    cg::grid_group grid = cg::this_grid();
#pragma unroll 1
    for (int ph = ph_lo; ph < ph_hi; ++ph) {
        if (ph == 0) {
            Params q{}; unsigned char* ws = KWS();
            q.c = KIN(1); q.c_ctx = KIN(3); q.w_ada = KIN(4); q.b_ada = KIN(5); q.w_in = KIN(6); q.w_out = KIN(17);
            q.MOD = (float*)(ws + OFF_MOD); q.wt_in = (u16*)(ws + OFF_W); q.wt_out = (u16*)(ws + OFF_W + SZ_WTIN1);
            phase_a(q, shm);
        } else {
            const int l = (ph == N_PHASES - 1) ? DEPTH : (ph - 1) / 6, k = (ph == N_PHASES - 1) ? 0 : (ph - 1) % 6;
            if (k == 0) {
                Params q{}; unsigned char* ws = KWS();
                q.x = KIN(0); q.ctx = KIN(2); q.ln_g = KIN(18); q.ln_b = KIN(19); q.out = KOUT();
                q.RC = (float*)(ws + OFF_RC); q.MOD = (float*)(ws + OFF_MOD); q.U = (u16*)(ws + OFF_U);
                phase_ln(q, l);
                if (l >= 1 && l < DEPTH) {
                    q.w_in = KIN(6); q.w_out = KIN(17); q.wt_in = (u16*)(ws + OFF_W); q.wt_out = (u16*)(ws + OFF_W + SZ_WTIN1);
                    weight_tiles(q, (float*)shm, l);
                }
            } else if (k == 1) {
                unsigned char* ws = KWS();
                pg8::Gemm g{(const u16*)(ws + OFF_U), (const u16*)(ws + OFF_W + (size_t)l * SZ_WL), MROWS, NPAD, 2048, 2048};
                pg8::StaticOrder S; S.init(MROWS, NPAD, GDIM, BIDX);
                EpiG1 E{(u16*)(ws + OFF_P), (float*)(ws + OFF_GD)};
                pg8::gemm_phase<EpiG1>((LAS unsigned char*)shm, g, S, E);
            } else if (k == 2) {
                Params q{}; unsigned char* ws = KWS();
                q.conv_qk_w = KIN(7); q.conv_qk_b = KIN(8); q.conv_xbc_w = KIN(11); q.conv_xbc_b = KIN(12); q.gate_b = KIN(9); q.dt_bias = KIN(13); q.a_log = KIN(14);
                q.P = (u16*)(ws + OFF_P); q.QKX = (u16*)(ws + OFF_QKX); q.GD = (float*)(ws + OFF_GD); q.G2 = (float*)(ws + OFF_G2);
                phase_conv(q, l);
            } else if (k == 3) {
                Params q{}; unsigned char* ws = KWS();
                q.gate_b = KIN(9); q.dt_bias = KIN(13); q.a_log = KIN(14); q.d_skip = KIN(15);
                q.P = (u16*)(ws + OFF_P); q.QKX = (u16*)(ws + OFF_QKX); q.G2 = (float*)(ws + OFF_G2);
                q.HB = (u16*)(ws + OFF_U); q.YB = (u16*)(ws + OFF_W + (size_t)((l + 1) & 1) * SZ_WL);
                phase_scan(q, l, shm);
            } else if (k == 4) {
                Params q{}; unsigned char* ws = KWS();
                q.mh_w = KIN(10); q.ssm_w = KIN(16); q.P = (u16*)(ws + OFF_P);
                q.HB = (u16*)(ws + OFF_U); q.YB = (u16*)(ws + OFF_W + (size_t)((l + 1) & 1) * SZ_WL);
                phase_post(q, l);
            } else {
                unsigned char* ws = KWS(); float* outp = KOUT();
                const float* xin = KIN(0); const float* cin = KIN(2);
                float* rc = (float*)(ws + OFF_RC);
                const int roff = (l == DEPTH - 1) ? CTXROWS : 0;
                pg8::Gemm g{(const u16*)(ws + OFF_P) + (size_t)roff * PW + 9216, (const u16*)(ws + OFF_W + (size_t)l * SZ_WL + SZ_WTIN1), MROWS - roff, 2048, 4096, PW};
                pg8::StaticOrder S; S.init(MROWS - roff, 2048, GDIM, BIDX);
                EpiG2 E{l == 0 ? xin : outp, l == 0 ? cin : rc, outp, rc, (const float*)(ws + OFF_MOD) + (size_t)l * 3 * 6144, roff};
                pg8::gemm_phase<EpiG2>((LAS unsigned char*)shm, g, S, E);
            }
        }
        if (ph + 1 < ph_hi) {
            if (ph_hi > N_PHASES) { grid.sync(); acquire_workgroup(); }
            grid_barrier((unsigned*)(KWS() + OFF_BAR), (unsigned)(ph - ph_lo + 1) * (unsigned)GDIM);
        }
    }
}

extern "C" void kernel_launch(void* const* d_in, const int* in_sizes, int n_in, void* d_out, int out_size, void* d_ws, size_t ws_size, hipStream_t stream) {
    static int grid = 0;
    if (grid == 0) {
        if (n_in != 20 || ws_size < WS_END) { fprintf(stderr, "kernel_launch: unexpected n_in %d or ws_size %zu (< %zu)\n", n_in, ws_size, (size_t)WS_END); grid = -1; return; }
        int dev = 0, cus = 0, per_cu = 0;
        hipGetDevice(&dev);
        hipDeviceGetAttribute(&cus, hipDeviceAttributeMultiprocessorCount, dev);
        if (hipFuncSetAttribute((const void*)mega, hipFuncAttributeMaxDynamicSharedMemorySize, LDS_BYTES) != hipSuccess) { fprintf(stderr, "kernel_launch: hipFuncSetAttribute failed\n"); grid = -1; return; }
        if (hipOccupancyMaxActiveBlocksPerMultiprocessor(&per_cu, (const void*)mega, 512, LDS_BYTES) != hipSuccess || per_cu < 1) { fprintf(stderr, "kernel_launch: occupancy query says %d\n", per_cu); per_cu = 1; }
        (void)hipGetLastError();
        grid = cus;
    }
    if (grid < 0) return;
    if (hipMemsetAsync((unsigned char*)d_ws + OFF_BAR, 0, 256, stream) != hipSuccess) { fprintf(stderr, "kernel_launch: memset failed\n"); return; }
    KArgs ka{};
    for (int i = 0; i < 20; ++i) ka.in[i] = (const float*)d_in[i];
    ka.out = (float*)d_out; ka.ws = (unsigned char*)d_ws;
    int lo = 0, hi = N_PHASES;
    void* args[] = {&ka, &lo, &hi};
    hipError_t e = hipLaunchCooperativeKernel((const void*)mega, dim3(grid), dim3(512), args, LDS_BYTES, stream);
    if (e != hipSuccess) fprintf(stderr, "kernel_launch: cooperative launch failed: %s (grid %d)\n", hipGetErrorString(e), grid);
}
```

```cpp
#include <hip/hip_runtime.h>
#include <hip/hip_cooperative_groups.h>
#include <cstdio>
namespace cg = cooperative_groups;

#define LAS __attribute__((address_space(3)))
typedef unsigned short u16;
typedef short bf16x8 __attribute__((ext_vector_type(8)));
typedef float f32x4 __attribute__((ext_vector_type(4)));
typedef unsigned u32x4 __attribute__((ext_vector_type(4)));
typedef unsigned u32x2 __attribute__((ext_vector_type(2)));
typedef float f32x3 __attribute__((ext_vector_type(3)));

constexpr int D = 2048, DEPTH = 2;
constexpr int CTXROWS = 512, MROWS = 16896;
constexpr int NIN = 13408, NPAD = 13568, PW = 13312, GDW = 96, QW = 5120, G2W = 176;
constexpr float LN_EPS = 1e-5f;
constexpr float ALPHA = 1.4142135623730951f;
constexpr int LDS_BYTES = 139264;

constexpr size_t SZ_WTIN1 = (size_t)NPAD * 2048 * 2, SZ_WTOUT1 = (size_t)2048 * 4096 * 2, SZ_WL = SZ_WTIN1 + SZ_WTOUT1;
constexpr size_t SZ_P = (size_t)MROWS * PW * 2, SZ_GD = (size_t)MROWS * GDW * 4, SZ_U = (size_t)MROWS * 2048 * 2;
constexpr size_t SZ_QKX = (size_t)MROWS * QW * 2, SZ_MOD = (size_t)DEPTH * 3 * 6144 * 4, SZ_RC = (size_t)CTXROWS * 2048 * 4;
constexpr size_t OFF_W = 0, OFF_P = OFF_W + DEPTH * SZ_WL, OFF_GD = OFF_P + SZ_P, OFF_U = OFF_GD + SZ_GD,
                 OFF_QKX = OFF_U + SZ_U, OFF_MOD = OFF_QKX + SZ_QKX, OFF_RC = OFF_MOD + SZ_MOD, OFF_BAR = OFF_RC + SZ_RC, OFF_G2 = OFF_BAR + 256, WS_END = OFF_G2 + (size_t)MROWS * 176 * 4 + 256;

struct Params {
    const float *x, *c, *ctx, *c_ctx, *w_ada, *b_ada, *w_in, *conv_qk_w, *conv_qk_b, *gate_b, *mh_w, *conv_xbc_w, *conv_xbc_b, *dt_bias, *a_log, *d_skip,
        *ssm_w, *w_out, *ln_g, *ln_b;
    float* out;
    u16 *wt_in, *wt_out, *P, *U, *QKX, *HB, *YB;
    float *GD, *MOD, *RC, *G2;
};
struct KArgs { const float* in[20]; float* out; unsigned char* ws; };
template <int IDX> __device__ __forceinline__ const void* kload() {
    unsigned long r;
    asm volatile("s_load_dwordx2 %0, %1, %2\n\ts_waitcnt lgkmcnt(0)" : "=s"(r) : "s"(__builtin_amdgcn_kernarg_segment_ptr()), "n"(IDX * 8) : "memory");
    return (const void*)(const __attribute__((address_space(1))) char*)r;
}
#define KIN(i) ((const float*)kload<(i)>())
#define KOUT() ((float*)kload<20>())
#define KWS() ((unsigned char*)kload<21>())

__device__ __forceinline__ int tid_() { int t = threadIdx.x; asm volatile("" : "+v"(t)); return t; }
__device__ __forceinline__ int bid_() { int b = blockIdx.x; asm volatile("" : "+s"(b)); return b; }
__device__ __forceinline__ int gdim_() { int g = gridDim.x; asm volatile("" : "+s"(g)); return g; }
#define TIDX tid_()
#define BIDX bid_()
#define GDIM gdim_()

typedef float f32x2_t __attribute__((ext_vector_type(2)));
typedef __bf16 bf16x2_t __attribute__((ext_vector_type(2)));
__device__ __forceinline__ u16 f2bf(float f) { return __builtin_bit_cast(u16, (__bf16)f); }
__device__ __forceinline__ float bf2f(unsigned h) { return __uint_as_float(h << 16); }
__device__ __forceinline__ float bflo(unsigned w) { return __uint_as_float(w << 16); }
__device__ __forceinline__ float bfhi(unsigned w) { return __uint_as_float(w & 0xFFFF0000u); }
__device__ __forceinline__ unsigned pk2(float lo, float hi) { const f32x2_t v = {lo, hi}; return __builtin_bit_cast(unsigned, __builtin_convertvector(v, bf16x2_t)); }
__device__ __forceinline__ unsigned cvt_pk_bf16(float lo, float hi) { unsigned r; asm volatile("v_cvt_pk_bf16_f32 %0, %1, %2" : "=v"(r) : "v"(lo), "v"(hi)); return r; }
__device__ __forceinline__ float wsum(float v) {
#pragma unroll
    for (int o = 32; o > 0; o >>= 1) v += __shfl_xor(v, o, 64);
    return v;
}
__device__ __forceinline__ float siluf(float v) { return v / (1.f + __expf(-v)); }
__device__ __forceinline__ float sigmf(float v) { return 1.f / (1.f + __expf(-v)); }
__device__ __forceinline__ float scan_add(float v, int lane) {
#pragma unroll
    for (int d = 1; d < 64; d <<= 1) { float t = __shfl_up(v, d, 64); if (lane >= d) v += t; }
    return v;
}
__device__ __forceinline__ float scan_max(float v, int lane) {
#pragma unroll
    for (int d = 1; d < 64; d <<= 1) { float t = __shfl_up(v, d, 64); if (lane >= d) v = fmaxf(v, t); }
    return v;
}
__device__ __forceinline__ int src_col(int n) {
    if (n < 8192) return n;
    if (n < 11264) return n + 32;
    if (n < 13312) return n + 96;
    if (n < 13344) return n - 5120;
    if (n < 13408) return n - 2048;
    return -1;
}

namespace pg8 {
constexpr int BM = 256, BK = 64, HALF = 128, HTB = HALF * BK * 2, STAGE_BYTES = 8 * HTB, NXCD = 8, WGM = 8;
__host__ __device__ __forceinline__ int lds_byte(int r, int c) { const int st = (r >> 4) * 2 + (c >> 5), rr = r & 15, cc = c & 31, ob = rr * 64 + cc * 2; return st * 1024 + (ob ^ (((ob >> 9) & 1) << 5)); }
__host__ __device__ __forceinline__ void stage_rc(int b, int& R, int& C) { const int st = b / 1024, sb = b % 1024, swz = sb ^ (((sb >> 9) & 1) << 5); R = (st >> 1) * 16 + swz / 64; C = (st & 1) * 32 + (swz % 64) / 2; }
__host__ __device__ __forceinline__ int perm32(int rho) { const int n = rho >> 4, i = rho & 15; return 8 * (i >> 2) + 4 * n + (i & 3); }
struct Unit { int pm, pn; };
struct Gemm { const u16* A; const u16* Bt; int M, N, K, lda; };
struct StaticOrder {
    int nM, nN, nwg, G, c;
    __device__ void init(int M, int N, int G_, int c_) { nM = M / BM; nN = N / BM; nwg = nM * nN; G = G_; c = c_; }
    __device__ bool next(int i, Unit& u) const {
        const long L = (long)i * G + c; if (L >= nwg) return false;
        int wgid = (int)L; { const int q = nwg / NXCD, r = nwg % NXCD, xcd = wgid % NXCD, off = wgid / NXCD; wgid = (xcd < r ? xcd * (q + 1) : r * (q + 1) + (xcd - r) * q) + off; }
        const int nig = WGM * nN, gid = wgid / nig, fm = gid * WGM, gsz = (nM - fm) < WGM ? (nM - fm) : WGM;
        u.pm = fm + ((wgid % nig) % gsz); u.pn = (wgid % nig) / gsz; return true;
    }
};

template <class Epi>
__device__ __forceinline__ void gemm_phase(LAS unsigned char* lds, const Gemm g, const StaticOrder& S, const Epi& E) {
    const int tid = TIDX, wid = __builtin_amdgcn_readfirstlane(tid >> 6), lane = tid & 63, wr = wid >> 2, wc = wid & 3, fr = lane & 15, fq = lane >> 4;
    const int K = g.K, nt = K / BK, lda = g.lda;
    unsigned voffA[2], voffB[2];
#pragma unroll
    for (int i = 0; i < 2; ++i) { int R, C; stage_rc(tid * 16 + i * 8192, R, C); const int Rb = Epi::PERM ? ((R & ~31) + perm32(R & 31)) : R;
        voffA[i] = (unsigned)(R * lda + C) * 2u; voffB[i] = (unsigned)(Rb * K + C) * 2u; }
    const size_t kstep = (size_t)(BK * 2);
    const size_t hA = (size_t)HALF * lda * 2, hB = (size_t)HALF * K * 2;
    const size_t tA = 2 * hA, tB = 2 * hB;
    const unsigned ldsw = (unsigned)wid * 1024u;
    const int aoff = lds_byte(wr * 64 + fr, fq * 8), boff = lds_byte(wc * 32 + fr, fq * 8);
#define PG8_SA(b, h) (((b) * 2 + (h)) * HTB)
#define PG8_SB(b, h) ((4 + (b) * 2 + (h)) * HTB)
#define PG8_STAGE(bufoff, gbase, voff) do { _Pragma("unroll") for (int _i = 0; _i < 2; ++_i) \
        __builtin_amdgcn_global_load_lds((const unsigned*)((const char*)(gbase) + (voff)[_i]), (LAS unsigned*)(lds + (bufoff) + ldsw + _i * 8192), 16, 0, 0); } while (0)
#define PG8_LDA(dst, b, h) do { _Pragma("unroll") for (int m = 0; m < 4; ++m) _Pragma("unroll") for (int k = 0; k < 2; ++k) dst[m][k] = *(const LAS bf16x8*)(lds + PG8_SA(b, h) + aoff + m * 2048 + k * 1024); } while (0)
#define PG8_LDB(dst, b, h) do { _Pragma("unroll") for (int n = 0; n < 2; ++n) _Pragma("unroll") for (int k = 0; k < 2; ++k) dst[n][k] = *(const LAS bf16x8*)(lds + PG8_SB(b, h) + boff + n * 2048 + k * 1024); } while (0)
#define PG8_MMA(ai, bj, At, Bt) do { __builtin_amdgcn_s_setprio(1); _Pragma("unroll") for (int m = 0; m < 4; ++m) _Pragma("unroll") for (int n = 0; n < 2; ++n) _Pragma("unroll") for (int k = 0; k < 2; ++k) \
        acc[ai][bj][m][n] = __builtin_amdgcn_mfma_f32_16x16x32_bf16(Bt[n][k], At[m][k], acc[ai][bj][m][n], 0, 0, 0); __builtin_amdgcn_s_setprio(0); } while (0)
#define PG8_WAIT_V(n) asm volatile("s_waitcnt vmcnt(" #n ")" ::: "memory")
#define PG8_WAIT_L(n) asm volatile("s_waitcnt lgkmcnt(" #n ")" ::: "memory")
#define PG8_BAR __builtin_amdgcn_s_barrier()
#define PG8_SCHED __builtin_amdgcn_sched_barrier(0)
    Unit cur, nxt; int ui = 0;
    if (!S.next(0, cur)) return;
    f32x4 acc[2][2][4][2];
#pragma unroll
    for (int a = 0; a < 2; ++a)
#pragma unroll
        for (int b = 0; b < 2; ++b)
#pragma unroll
            for (int m = 0; m < 4; ++m)
#pragma unroll
                for (int n = 0; n < 2; ++n) acc[a][b][m][n] = (f32x4){0.f, 0.f, 0.f, 0.f};
    bf16x8 At[4][2], B0[2][2], B1[2][2];
    const char* cA = (const char*)g.A + (size_t)cur.pm * tA; const char* cB = (const char*)g.Bt + (size_t)cur.pn * tB;
    PG8_STAGE(PG8_SB(0, 0), cB, voffB); PG8_STAGE(PG8_SA(0, 0), cA, voffA); PG8_STAGE(PG8_SB(0, 1), cB + hB, voffB); PG8_STAGE(PG8_SA(0, 1), cA + hA, voffA);
    if (wr == 1) PG8_BAR;
    PG8_WAIT_V(4); PG8_BAR;
    PG8_STAGE(PG8_SB(1, 0), cB + kstep, voffB); PG8_STAGE(PG8_SA(1, 0), cA + kstep, voffA); PG8_STAGE(PG8_SB(1, 1), cB + hB + kstep, voffB);
    PG8_WAIT_V(6); PG8_BAR;
    for (;;) {
        const bool has_next = S.next(ui + 1, nxt);
        const char* nA = has_next ? (const char*)g.A + (size_t)nxt.pm * tA : cA; const char* nB = has_next ? (const char*)g.Bt + (size_t)nxt.pn * tB : cB;
        for (int t = 0; t < nt; t += 2) {
            const bool last = (t == nt - 2);
            const char* a1 = cA + (size_t)(t + 1) * kstep;
            const char* a2 = last ? nA : cA + (size_t)(t + 2) * kstep; const char* b2 = last ? nB : cB + (size_t)(t + 2) * kstep;
            const char* a3 = a2 + kstep; const char* b3 = b2 + kstep;
            PG8_LDB(B0, 0, 0); PG8_SCHED; PG8_LDA(At, 0, 0); PG8_STAGE(PG8_SA(1, 1), a1 + hA, voffA);
            PG8_WAIT_L(8); PG8_BAR; PG8_WAIT_L(0); PG8_MMA(0, 0, At, B0); PG8_BAR; PG8_SCHED;
            PG8_LDB(B1, 0, 1); PG8_STAGE(PG8_SB(0, 0), b2, voffB);
            PG8_BAR; PG8_WAIT_L(0); PG8_MMA(0, 1, At, B1); PG8_BAR;
            PG8_LDA(At, 0, 1); PG8_STAGE(PG8_SA(0, 0), a2, voffA);
            PG8_BAR; PG8_WAIT_L(0); PG8_MMA(1, 0, At, B0); PG8_BAR; PG8_SCHED;
            PG8_STAGE(PG8_SB(0, 1), b2 + hB, voffB);
            PG8_WAIT_V(6); PG8_BAR; PG8_MMA(1, 1, At, B1); PG8_BAR;
            PG8_LDB(B0, 1, 0); PG8_SCHED; PG8_LDA(At, 1, 0); PG8_STAGE(PG8_SA(0, 1), a2 + hA, voffA);
            PG8_WAIT_L(8); PG8_BAR; PG8_WAIT_L(0); PG8_MMA(0, 0, At, B0); PG8_BAR; PG8_SCHED;
            PG8_LDB(B1, 1, 1); PG8_STAGE(PG8_SB(1, 0), b3, voffB);
            PG8_BAR; PG8_WAIT_L(0); PG8_MMA(0, 1, At, B1); PG8_BAR;
            PG8_LDA(At, 1, 1); PG8_STAGE(PG8_SA(1, 0), a3, voffA);
            PG8_BAR; PG8_WAIT_L(0); PG8_MMA(1, 0, At, B0); PG8_BAR; PG8_SCHED;
            PG8_STAGE(PG8_SB(1, 1), b3 + hB, voffB);
            PG8_WAIT_V(6); PG8_BAR; PG8_MMA(1, 1, At, B1); PG8_BAR;
        }
        E(acc, cur, wr, wc, fr, fq);
        if (!has_next) break;
#pragma unroll
        for (int a = 0; a < 2; ++a)
#pragma unroll
            for (int b = 0; b < 2; ++b)
#pragma unroll
                for (int m = 0; m < 4; ++m)
#pragma unroll
                    for (int n = 0; n < 2; ++n) acc[a][b][m][n] = (f32x4){0.f, 0.f, 0.f, 0.f};
        cur = nxt; cA = nA; cB = nB; ++ui;
    }
    PG8_WAIT_V(0);
    if (wr == 0) PG8_BAR;
    PG8_BAR;
#undef PG8_SA
#undef PG8_SB
#undef PG8_STAGE
#undef PG8_LDA
#undef PG8_LDB
#undef PG8_MMA
#undef PG8_WAIT_V
#undef PG8_WAIT_L
#undef PG8_BAR
#undef PG8_SCHED
}
}

struct EpiG1 {
    static constexpr bool PERM = true;
    u16* P; float* GD;
    __device__ __forceinline__ void operator()(const f32x4 (&acc)[2][2][4][2], const pg8::Unit& u, int wr, int wc, int fr, int fq) const {
        const int row0 = u.pm * 256 + wr * 64 + fr;
        if (u.pn < 52) {
            const int col0 = u.pn * 256 + wc * 32 + 8 * fq;
#pragma unroll
            for (int ai = 0; ai < 2; ++ai)
#pragma unroll
                for (int m = 0; m < 4; ++m) { u16* rowp = P + (size_t)(row0 + ai * 128 + m * 16) * PW + col0;
#pragma unroll
                    for (int bj = 0; bj < 2; ++bj) { const f32x4 v0 = acc[ai][bj][m][0], v1 = acc[ai][bj][m][1];
                        u32x4 w; w.x = cvt_pk_bf16(v0[0], v0[1]); w.y = cvt_pk_bf16(v0[2], v0[3]); w.z = cvt_pk_bf16(v1[0], v1[1]); w.w = cvt_pk_bf16(v1[2], v1[3]);
                        *(u32x4*)(rowp + bj * 128) = w; } }
        } else if (wc < 3) {
            const int cc0 = wc * 32 + 8 * fq;
#pragma unroll
            for (int ai = 0; ai < 2; ++ai)
#pragma unroll
                for (int m = 0; m < 4; ++m) { float* rowp = GD + (size_t)(row0 + ai * 128 + m * 16) * GDW + cc0;
                    *(f32x4*)(rowp) = acc[ai][0][m][0]; *(f32x4*)(rowp + 4) = acc[ai][0][m][1]; }
        }
    }
};
struct EpiG2 {
    static constexpr bool PERM = false;
    const float* xres_lat; const float* xres_ctx; float* dst_lat; float* dst_ctx; const float* modl; int row_off;
    __device__ __forceinline__ void operator()(const f32x4 (&acc)[2][2][4][2], const pg8::Unit& u, int wr, int wc, int fr, int fq) const {
        const int g0 = u.pm * 256 + row_off;
        const bool isctx = g0 < CTXROWS;
        const int b = isctx ? (g0 >> 8) : ((g0 - CTXROWS) >> 13);
        const float* gate = modl + (size_t)(isctx ? 2 : b) * 6144 + 4096;
        const float* xr = isctx ? xres_ctx + (size_t)g0 * D : xres_lat + (size_t)(g0 - CTXROWS) * D;
        float* ds = isctx ? dst_ctx + (size_t)g0 * D : dst_lat + (size_t)(g0 - CTXROWS) * D;
        const int col0 = u.pn * 256 + wc * 32 + 4 * fq;
        f32x4 gv[2][2];
#pragma unroll
        for (int bj = 0; bj < 2; ++bj)
#pragma unroll
            for (int n = 0; n < 2; ++n) gv[bj][n] = *(const f32x4*)(gate + col0 + bj * 128 + n * 16);
#pragma unroll
        for (int ai = 0; ai < 2; ++ai)
#pragma unroll
            for (int m = 0; m < 4; ++m) { const size_t ro = (size_t)(wr * 64 + fr + ai * 128 + m * 16) * D + col0;
#pragma unroll
                for (int bj = 0; bj < 2; ++bj)
#pragma unroll
                    for (int n = 0; n < 2; ++n) { const f32x4 xv = *(const f32x4*)(xr + ro + bj * 128 + n * 16);
                        *(f32x4*)(ds + ro + bj * 128 + n * 16) = xv * ALPHA + gv[bj][n] * acc[ai][bj][m][n]; } }
    }
};

struct TrTile { const float* src; u16* dst; int Nsrc, K, n0, k0, perm; };
__device__ __forceinline__ void tr_load(const TrTile& t, float (&v)[16], int tid) {
    const int nl = tid & 63, kb = tid >> 6; const int n = t.n0 + nl; const int sc = t.perm ? src_col(n) : n;
#pragma unroll
    for (int i = 0; i < 16; ++i) { const int kl = i * 8 + kb; v[i] = sc >= 0 ? t.src[(size_t)(t.k0 + kl) * t.Nsrc + sc] : 0.f; }
}
__device__ __forceinline__ void tr_to_lds(const float (&v)[16], float* sf, int tid) {
    const int nl = tid & 63, kb = tid >> 6;
#pragma unroll
    for (int i = 0; i < 16; ++i) sf[(i * 8 + kb) * 65 + nl] = v[i];
}
__device__ __forceinline__ void tr_store(const TrTile& t, const float* sf, int tid) {
    const int nl2 = tid >> 3;
#pragma unroll
    for (int hk = 0; hk < 2; ++hk) { const int kc = (tid & 7) * 8 + hk * 64;
        u32x4 w;
        w.x = pk2(sf[(kc + 0) * 65 + nl2], sf[(kc + 1) * 65 + nl2]); w.y = pk2(sf[(kc + 2) * 65 + nl2], sf[(kc + 3) * 65 + nl2]);
        w.z = pk2(sf[(kc + 4) * 65 + nl2], sf[(kc + 5) * 65 + nl2]); w.w = pk2(sf[(kc + 6) * 65 + nl2], sf[(kc + 7) * 65 + nl2]);
        *(u32x4*)(t.dst + (size_t)(t.n0 + nl2) * t.K + t.k0 + kc) = w; }
}
__device__ __forceinline__ TrTile tr_tile(const Params& p, int t) {
    constexpr int T_IN = (NPAD / 64) * 16, T_OUT = 32 * 32;
    const int l = t / (T_IN + T_OUT), r = t % (T_IN + T_OUT);
    TrTile o;
    if (r < T_IN) { o.src = p.w_in + (size_t)l * 2048 * NIN; o.dst = p.wt_in + (size_t)l * (SZ_WL / 2); o.Nsrc = NIN; o.K = 2048; o.n0 = (r >> 4) * 64; o.k0 = (r & 15) * 128; o.perm = 1; }
    else { const int r2 = r - T_IN; o.src = p.w_out + (size_t)l * 4096 * 2048; o.dst = p.wt_out + (size_t)l * (SZ_WL / 2); o.Nsrc = 2048; o.K = 4096; o.n0 = (r2 >> 5) * 64; o.k0 = (r2 & 31) * 128; o.perm = 0; }
    return o;
}

__device__ void weight_tiles(const Params& p, float* sf, int l) {
    constexpr int T_L = (NPAD / 64) * 16 + 32 * 32;
    const int tid = TIDX, gd = GDIM;
    const int t_end = (l + 1) * T_L;
    int t = l * T_L + BIDX;
    float v[16];
    __syncthreads();
    if (t < t_end) { const TrTile c0 = tr_tile(p, t); tr_load(c0, v, tid); }
    while (t < t_end) {
        tr_to_lds(v, sf, tid);
        __syncthreads();
        const int tn = t + gd;
        if (tn < t_end) { const TrTile nxt = tr_tile(p, tn); tr_load(nxt, v, tid); }
        { const TrTile cur = tr_tile(p, t); tr_store(cur, sf, tid); }
        __syncthreads();
        t = tn;
    }
}

__device__ void phase_a(const Params& p, unsigned char* lds) {
    float* sf = (float*)lds;
    const int tid = TIDX;
    if (BIDX < 192) {
        for (int i = tid; i < 3 * 2048; i += 512) { const int r = i >> 11, k = i & 2047; const float v = r < 2 ? p.c[r * 2048 + k] : p.c_ctx[k]; sf[i] = siluf(v); }
        __syncthreads();
    }
    for (int t = BIDX; t < 192; t += GDIM) {
        const int l = t / 96, cb = t % 96; const int col = cb * 64 + (tid & 63); const int kg = tid >> 6;
        const float* w = p.w_ada + (size_t)l * 2048 * 6144 + col;
        float a0 = 0.f, a1 = 0.f, a2 = 0.f;
#pragma unroll 8
        for (int k = kg * 256; k < kg * 256 + 256; ++k) { const float wv = w[(size_t)k * 6144]; a0 += sf[k] * wv; a1 += sf[2048 + k] * wv; a2 += sf[4096 + k] * wv; }
        float* red = sf + 6144;
        red[(kg * 3 + 0) * 64 + (tid & 63)] = a0; red[(kg * 3 + 1) * 64 + (tid & 63)] = a1; red[(kg * 3 + 2) * 64 + (tid & 63)] = a2;
        __syncthreads();
        if (tid < 192) { const int r = tid >> 6, cc = tid & 63; float s = 0.f;
#pragma unroll
            for (int g = 0; g < 8; ++g) s += red[(g * 3 + r) * 64 + cc];
            const int col2 = cb * 64 + cc; p.MOD[(size_t)(l * 3 + r) * 6144 + col2] = s + p.b_ada[l * 6144 + col2]; }
        __syncthreads();
    }
    __syncthreads();
    weight_tiles(p, sf, 0);
}

__device__ __forceinline__ void row_stats(const f32x4 (&v)[8], float& mean, float& rstd) {
    float s = 0.f;
#pragma unroll
    for (int i = 0; i < 8; ++i) s += v[i][0] + v[i][1] + v[i][2] + v[i][3];
    mean = wsum(s) * (1.f / 2048.f);
    float q = 0.f;
#pragma unroll
    for (int i = 0; i < 8; ++i) { const f32x4 d = v[i] - mean; q += d[0] * d[0] + d[1] * d[1] + d[2] * d[2] + d[3] * d[3]; }
    rstd = rsqrtf(wsum(q) * (1.f / 2048.f) + LN_EPS);
}
__device__ void phase_ln(const Params& p, int l) {
    const int wid = TIDX >> 6, lane = TIDX & 63;
    const int nw = GDIM * 8;
    const bool fin = (l == DEPTH);
    for (int row = BIDX * 8 + wid; row < MROWS; row += nw) {
        const bool isctx = row < CTXROWS;
        if (fin && isctx) continue;
        const int b = isctx ? (row >> 8) : ((row - CTXROWS) >> 13);
        float* rw = isctx ? p.RC + (size_t)row * D : p.out + (size_t)(row - CTXROWS) * D;
        const float* src = (l == 0) ? (isctx ? p.ctx + (size_t)row * D : p.x + (size_t)(row - CTXROWS) * D) : rw;
        f32x4 v[8];
#pragma unroll
        for (int i = 0; i < 8; ++i) v[i] = *(const f32x4*)(src + i * 256 + lane * 4);
        float mean, rstd;
        if (l > 0) {
            row_stats(v, mean, rstd);
            const float* g = p.ln_g + (size_t)(l - 1) * D; const float* bb = p.ln_b + (size_t)(l - 1) * D;
#pragma unroll
            for (int i = 0; i < 8; ++i) { const f32x4 gv = *(const f32x4*)(g + i * 256 + lane * 4), bv = *(const f32x4*)(bb + i * 256 + lane * 4);
                v[i] = (v[i] - mean) * rstd * gv + bv; *(f32x4*)(rw + i * 256 + lane * 4) = v[i]; }
        }
        if (fin) continue;
        row_stats(v, mean, rstd);
        const float* md = p.MOD + (size_t)(l * 3 + (isctx ? 2 : b)) * 6144;
        u16* ur = p.U + (size_t)row * 2048;
#pragma unroll
        for (int i = 0; i < 8; ++i) { const f32x4 sh = *(const f32x4*)(md + i * 256 + lane * 4), sc = *(const f32x4*)(md + 2048 + i * 256 + lane * 4);
            const f32x4 o = (v[i] - mean) * rstd * (sc + 1.f) + sh;
            u32x2 w; w.x = pk2(o[0], o[1]); w.y = pk2(o[2], o[3]);
            *(u32x2*)(ur + i * 256 + lane * 4) = w; }
    }
}

template <bool ISM> __device__ __forceinline__ int scan_row(int b, int dir, int cc, int i) {
    const bool isctx = cc < 2; const int p0 = isctx ? cc * 128 : (cc - 2) * 128; const int slen = isctx ? 256 : 8192; const int rowbase = isctx ? b * 256 : CTXROWS + b * 8192;
    const int s = dir ? slen - 1 - (p0 + i) : p0 + i;
    return rowbase + ((ISM || isctx) ? s : ((s & 127) * 64 + (s >> 7)));
}

__device__ void phase_conv(const Params& p, int l) {
    const int tid = TIDX;
    {
        const int wv = tid >> 6, lane = tid & 63;
        const int nwv = GDIM * 8;
        for (int task = BIDX * 8 + wv; task < 2 * 2 * 66 * 40; task += nwv) {
            const int hd = task % 40; int r = task / 40; const int cc = r % 66; r /= 66; const int dir = r & 1, b = r >> 1;
            if (hd < 8) {
                const int h = hd; const int row0 = scan_row<true>(b, dir, cc, 2 * lane), row1 = scan_row<true>(b, dir, cc, 2 * lane + 1);
                const float gbi = p.gate_b[l * 32 + (dir * 2) * 8 + h], gbf = p.gate_b[l * 32 + (dir * 2 + 1) * 8 + h];
                const float li0 = p.GD[(size_t)row0 * GDW + (dir * 2) * 8 + h] + gbi, li1 = p.GD[(size_t)row1 * GDW + (dir * 2) * 8 + h] + gbi;
                const float x0 = p.GD[(size_t)row0 * GDW + (dir * 2 + 1) * 8 + h] + gbf, x1 = p.GD[(size_t)row1 * GDW + (dir * 2 + 1) * 8 + h] + gbf;
                const float lf0 = fminf(x0, 0.f) - log1pf(__expf(-fabsf(x0))), lf1 = fminf(x1, 0.f) - log1pf(__expf(-fabsf(x1)));
                const float a1 = lf0 + lf1;
                const float inc = scan_add(a1, lane); const float exc = inc - a1;
                const float b0 = exc + lf0, b1 = exc + a1;
                const float u0 = li0 - b0, u1 = li1 - b1;
                const float incm = scan_max(fmaxf(u0, u1), lane); float excm = __shfl_up(incm, 1, 64); if (lane == 0) excm = -3.0e38f;
                const float M0 = fmaxf(excm, u0), M1 = fmaxf(M0, u1);
                float* o0 = p.G2 + (size_t)row0 * G2W + (dir * 8 + h) * 3; float* o1 = p.G2 + (size_t)row1 * G2W + (dir * 8 + h) * 3;
                o0[0] = b0; o0[1] = u0; o0[2] = M0; o1[0] = b1; o1[1] = u1; o1[2] = M1;
            } else {
                const int hh = hd - 8; const int row0 = scan_row<false>(b, dir, cc, 2 * lane), row1 = scan_row<false>(b, dir, cc, 2 * lane + 1);
                const float dtb = p.dt_bias[(l * 2 + dir) * 32 + hh]; const float Ah = -__expf(p.a_log[(l * 2 + dir) * 32 + hh]);
                const float r0 = p.GD[(size_t)row0 * GDW + 32 + dir * 32 + hh] + dtb, r1 = p.GD[(size_t)row1 * GDW + 32 + dir * 32 + hh] + dtb;
                const float dt0 = fmaxf(r0, 0.f) + log1pf(__expf(-fabsf(r0))), dt1 = fmaxf(r1, 0.f) + log1pf(__expf(-fabsf(r1)));
                const float d0 = dt0 * Ah, d1 = dt1 * Ah;
                const float a1 = d0 + d1;
                const float inc = scan_add(a1, lane); const float exc = inc - a1;
                float* o0 = p.G2 + (size_t)row0 * G2W + 48 + (dir * 32 + hh) * 2; float* o1 = p.G2 + (size_t)row1 * G2W + 48 + (dir * 32 + hh) * 2;
                o0[0] = dt0; o0[1] = exc + d0; o1[0] = dt1; o1[1] = exc + a1;
            }
        }
    }
    const int ci = tid & 127, rs = tid >> 7;
    for (int t = BIDX; t < 528 * 5; t += GDIM) {
        const int cgp = t % 5, rg = t / 5;
        int pcol, ocol, wstride; const float *w, *bias; bool isx; float scale = 1.f;
        if (cgp < 2) { const int c = (cgp * 128 + ci) * 8; pcol = c; ocol = c; w = p.conv_qk_w + (size_t)l * 3 * 2048 + c; bias = p.conv_qk_b + (size_t)l * 2048 + c; wstride = 2048; isx = false;
            if (c < 1024) scale = 0.08838834764831845f; }
        else { const int c = ((cgp - 2) * 128 + ci) * 8; pcol = 8192 + c; ocol = 2048 + c; w = p.conv_xbc_w + (size_t)l * 3 * 3072 + c; bias = p.conv_xbc_b + (size_t)l * 3072 + c; wstride = 3072; isx = true; }
        float w0[8], w1[8], w2[8], bb[8];
#pragma unroll
        for (int e = 0; e < 8; ++e) { w0[e] = w[e]; w1[e] = w[wstride + e]; w2[e] = w[2 * wstride + e]; bb[e] = bias[e]; }
        const int r0 = rg * 32 + rs * 8;
        const bool lat = r0 >= CTXROWS;
        const int seqbase = lat ? (CTXROWS + (((r0 - CTXROWS) >> 13) << 13)) : (r0 & ~255);
        const int seqlen = lat ? 8192 : 256;
        const int sp0 = r0 - seqbase;
        const bool cm = lat && isx;
        u32x4 win[10];
#pragma unroll
        for (int i = 0; i < 10; ++i) { const int sp = sp0 - 1 + i;
            const int row = seqbase + (cm ? ((sp & 127) * 64 + (sp >> 7)) : sp);
            win[i] = (sp >= 0 && sp < seqlen) ? *(const u32x4*)(p.P + (size_t)row * PW + pcol) : (u32x4){0u, 0u, 0u, 0u}; }
#pragma unroll
        for (int i = 0; i < 8; ++i) { const int sp = sp0 + i;
            const int row = seqbase + (cm ? ((sp & 127) * 64 + (sp >> 7)) : sp);
            const u32x4 ap = win[i], a = win[i + 1], an = win[i + 2];
            u32x4 o;
#pragma unroll
            for (int e2 = 0; e2 < 4; ++e2) {
                const float y0 = w0[2 * e2] * bflo(ap[e2]) + w1[2 * e2] * bflo(a[e2]) + w2[2 * e2] * bflo(an[e2]) + bb[2 * e2];
                const float y1 = w0[2 * e2 + 1] * bfhi(ap[e2]) + w1[2 * e2 + 1] * bfhi(a[e2]) + w2[2 * e2 + 1] * bfhi(an[e2]) + bb[2 * e2 + 1];
                o[e2] = pk2(siluf(y0) * scale, siluf(y1) * scale);
            }
            *(u32x4*)(p.QKX + (size_t)row * QW + ocol) = o;
        }
    }
}

constexpr int LDK = 136, LDV = 88;
constexpr int LS_K = 0, LS_V = 34816, LS_VW = LS_V + 128 * LDV * 2, LS_CT = LS_VW + 128 * LDV * 2, LS_F = LS_CT + 80 * LDK * 2;

#define LDS_BAR() do { asm volatile("s_waitcnt lgkmcnt(0)" ::: "memory"); __builtin_amdgcn_s_barrier(); asm volatile("" ::: "memory"); } while (0)
#define TR_RD8(r0, r1, r2, r3, r4, r5, r6, r7, base, o0, o1, o2, o3, o4, o5, o6, o7) \
    asm volatile("ds_read_b64_tr_b16 %0, %8 offset:%9\n\tds_read_b64_tr_b16 %1, %8 offset:%10\n\tds_read_b64_tr_b16 %2, %8 offset:%11\n\tds_read_b64_tr_b16 %3, %8 offset:%12\n\t" \
                 "ds_read_b64_tr_b16 %4, %8 offset:%13\n\tds_read_b64_tr_b16 %5, %8 offset:%14\n\tds_read_b64_tr_b16 %6, %8 offset:%15\n\tds_read_b64_tr_b16 %7, %8 offset:%16\n\ts_waitcnt lgkmcnt(0)" \
                 : "=&v"(r0), "=&v"(r1), "=&v"(r2), "=&v"(r3), "=&v"(r4), "=&v"(r5), "=&v"(r6), "=&v"(r7) \
                 : "v"(base), "n"(o0), "n"(o1), "n"(o2), "n"(o3), "n"(o4), "n"(o5), "n"(o6), "n"(o7) : "memory")
#define TR_RD2(r0, r1, base, o0, o1) \
    asm volatile("ds_read_b64_tr_b16 %0, %2 offset:%3\n\tds_read_b64_tr_b16 %1, %2 offset:%4\n\ts_waitcnt lgkmcnt(0)" : "=&v"(r0), "=&v"(r1) : "v"(base), "n"(o0), "n"(o1) : "memory")
#define TR_ST10(K0_, K1_, A0_, A1_, A2_, A3_, A4_, A5_, A6_, A7_, BK_, BV_, OK0_, OK1_, OV0_, OV1_, OV2_, OV3_, OV4_, OV5_, OV6_, OV7_) \
    asm volatile("ds_read_b64_tr_b16 %[rk0], %[bk] offset:%[ok0]\n\tds_read_b64_tr_b16 %[rk1], %[bk] offset:%[ok1]\n\t" \
                 "ds_read_b64_tr_b16 %[ra0], %[bv] offset:%[ov0]\n\tds_read_b64_tr_b16 %[ra1], %[bv] offset:%[ov1]\n\tds_read_b64_tr_b16 %[ra2], %[bv] offset:%[ov2]\n\tds_read_b64_tr_b16 %[ra3], %[bv] offset:%[ov3]\n\t" \
                 "ds_read_b64_tr_b16 %[ra4], %[bv] offset:%[ov4]\n\tds_read_b64_tr_b16 %[ra5], %[bv] offset:%[ov5]\n\tds_read_b64_tr_b16 %[ra6], %[bv] offset:%[ov6]\n\tds_read_b64_tr_b16 %[ra7], %[bv] offset:%[ov7]\n\ts_waitcnt lgkmcnt(0)" \
                 : [rk0] "=&v"(K0_), [rk1] "=&v"(K1_), [ra0] "=&v"(A0_), [ra1] "=&v"(A1_), [ra2] "=&v"(A2_), [ra3] "=&v"(A3_), [ra4] "=&v"(A4_), [ra5] "=&v"(A5_), [ra6] "=&v"(A6_), [ra7] "=&v"(A7_) \
                 : [bk] "v"(BK_), [bv] "v"(BV_), [ok0] "n"(OK0_), [ok1] "n"(OK1_), [ov0] "n"(OV0_), [ov1] "n"(OV1_), [ov2] "n"(OV2_), [ov3] "n"(OV3_), [ov4] "n"(OV4_), [ov5] "n"(OV5_), [ov6] "n"(OV6_), [ov7] "n"(OV7_) : "memory")
#define TR_ST12(K0_, K1_, A0_, A1_, A2_, A3_, A4_, A5_, A6_, A7_, A8_, A9_, BK_, BV_, OK0_, OK1_, OV0_, OV1_, OV2_, OV3_, OV4_, OV5_, OV6_, OV7_, OV8_, OV9_) \
    asm volatile("ds_read_b64_tr_b16 %[rk0], %[bk] offset:%[ok0]\n\tds_read_b64_tr_b16 %[rk1], %[bk] offset:%[ok1]\n\t" \
                 "ds_read_b64_tr_b16 %[ra0], %[bv] offset:%[ov0]\n\tds_read_b64_tr_b16 %[ra1], %[bv] offset:%[ov1]\n\tds_read_b64_tr_b16 %[ra2], %[bv] offset:%[ov2]\n\tds_read_b64_tr_b16 %[ra3], %[bv] offset:%[ov3]\n\t" \
                 "ds_read_b64_tr_b16 %[ra4], %[bv] offset:%[ov4]\n\tds_read_b64_tr_b16 %[ra5], %[bv] offset:%[ov5]\n\tds_read_b64_tr_b16 %[ra6], %[bv] offset:%[ov6]\n\tds_read_b64_tr_b16 %[ra7], %[bv] offset:%[ov7]\n\t" \
                 "ds_read_b64_tr_b16 %[ra8], %[bv] offset:%[ov8]\n\tds_read_b64_tr_b16 %[ra9], %[bv] offset:%[ov9]\n\ts_waitcnt lgkmcnt(0)" \
                 : [rk0] "=&v"(K0_), [rk1] "=&v"(K1_), [ra0] "=&v"(A0_), [ra1] "=&v"(A1_), [ra2] "=&v"(A2_), [ra3] "=&v"(A3_), [ra4] "=&v"(A4_), [ra5] "=&v"(A5_), [ra6] "=&v"(A6_), [ra7] "=&v"(A7_), [ra8] "=&v"(A8_), [ra9] "=&v"(A9_) \
                 : [bk] "v"(BK_), [bv] "v"(BV_), [ok0] "n"(OK0_), [ok1] "n"(OK1_), [ov0] "n"(OV0_), [ov1] "n"(OV1_), [ov2] "n"(OV2_), [ov3] "n"(OV3_), [ov4] "n"(OV4_), [ov5] "n"(OV5_), [ov6] "n"(OV6_), [ov7] "n"(OV7_), [ov8] "n"(OV8_), [ov9] "n"(OV9_) : "memory")
__device__ __forceinline__ bf16x8 mkfrag(u32x2 lo, u32x2 hi) { const u32x4 w = {lo.x, lo.y, hi.x, hi.y}; return __builtin_bit_cast(bf16x8, w); }

template <bool ISM>
__device__ void scan_item(const Params& p, int l, int item, unsigned char* lds) {
    constexpr int NT = ISM ? 5 : 4;
    constexpr float L2E = 1.4426950408889634f;
    const int tid = TIDX, wid = __builtin_amdgcn_readfirstlane(tid >> 6), lane = tid & 63, fr = lane & 15, fq = lane >> 4;
    const int trq = fr >> 2, trp = fr & 3;
    const int sl = ISM ? (item & 3) : 0, dir = ISM ? ((item >> 2) & 1) : (item & 1), h = ISM ? ((item >> 3) & 7) : ((item >> 1) & 31), b = item >> 6;
    const int qcol = ISM ? h * 128 : 2048 + 2560 + (h >> 3) * 128;
    const int kcol = ISM ? 1024 + h * 128 : 2048 + 2048 + (h >> 3) * 128;
    const int vcol = ISM ? 2048 + h * 256 + sl * 64 : 2048 + h * 64;
    const int ocol = ISM ? h * 256 + sl * 64 : h * 64;
    u16* const obase = dir ? (ISM ? p.HB : p.YB) : (ISM ? p.P : p.P + 8192);
    const unsigned ostride = dir ? 2048u : (unsigned)PW;
    u16* Ks = (u16*)(lds + LS_K); u16* Vs = (u16*)(lds + LS_V); u16* Vw = (u16*)(lds + LS_VW); u16* CT = (u16*)(lds + LS_CT);
    float* F = (float*)(lds + LS_F);
    float *f_c = F, *f_r = F + 128, *f_wi = F + 256, *f_ws = F + 384, *f_em = F + 512;
    const unsigned ldsb = (unsigned)(size_t)(LAS unsigned char*)lds;
    const unsigned trK = ldsb + LS_K + (unsigned)(((fq * 8 + trq) * LDK + 16 * wid + 4 * trp) * 2);
    const unsigned trVw = ldsb + LS_VW + (unsigned)(((fq * 8 + trq) * LDV + 4 * trp) * 2);
    const unsigned trV = ldsb + LS_V + (unsigned)(((fq * 4 + trq) * LDV + 4 * trp) * 2);
    const float Dh = ISM ? 0.f : p.d_skip[l * 32 + h];
    const u16* __restrict__ gQKX = p.QKX; const u16* __restrict__ gP = p.P; const float* __restrict__ gG2 = p.G2;
    const int gcol = ISM ? (dir * 8 + h) * 3 : 48 + (dir * 32 + h) * 2;
    __syncthreads();
    for (int i = tid; i < 128 * 24; i += 512) { const int r = i / 24, cc = 64 + i % 24; Vs[r * LDV + cc] = (ISM && cc == 64) ? (u16)0x3F80 : (u16)0; Vw[r * LDV + cc] = 0; }
    for (int i = tid; i < 80 * LDK; i += 512) CT[i] = 0;
    f32x4 st[NT];
#pragma unroll
    for (int m = 0; m < NT; ++m) st[m] = (f32x4){0.f, 0.f, 0.f, 0.f};
    float m_prev = 0.f;
    unsigned qo, ko[4], vo[2], go, ge, oo[4];
    bf16x8 qf[4]; u32x4 kr[4]; u32x4 vr[2]; f32x3 gv = {0.f, 0.f, 0.f}; float e0 = 0.f, e1 = 0.f;
#define SCAN_PTRS(cc) do { \
        qo = (unsigned)scan_row<ISM>(b, dir, (cc), 16 * wid + fr) * (unsigned)QW + (unsigned)(qcol + fq * 8); \
        _Pragma("unroll") for (int r_ = 0; r_ < 4; ++r_) { const int idx_ = r_ * 512 + tid; ko[r_] = (unsigned)scan_row<ISM>(b, dir, (cc), idx_ >> 4) * (unsigned)QW + (unsigned)(kcol + (idx_ & 15) * 8); } \
        _Pragma("unroll") for (int r_ = 0; r_ < 2; ++r_) { const int idx_ = r_ * 512 + tid; vo[r_] = (unsigned)scan_row<ISM>(b, dir, (cc), idx_ >> 3) * (unsigned)(ISM ? PW : QW) + (unsigned)(vcol + (idx_ & 7) * 8); } \
        go = (unsigned)scan_row<ISM>(b, dir, (cc), tid & 127) * (unsigned)G2W + (unsigned)gcol; ge = (unsigned)scan_row<ISM>(b, dir, (cc), 127) * (unsigned)G2W + (unsigned)gcol; \
        _Pragma("unroll") for (int j_ = 0; j_ < 4; ++j_) oo[j_] = (unsigned)scan_row<ISM>(b, dir, (cc), 16 * wid + fq * 4 + j_) * ostride + (unsigned)(ocol + fr); \
    } while (0)
#define SCAN_ADV(dr) do { const unsigned dq_ = (unsigned)((dr) * QW), dp_ = (unsigned)((dr) * PW), dg_ = (unsigned)((dr) * G2W), do_ = (unsigned)(dr) * ostride; \
        qo += dq_; _Pragma("unroll") for (int r_ = 0; r_ < 4; ++r_) ko[r_] += dq_; vo[0] += ISM ? dp_ : dq_; vo[1] += ISM ? dp_ : dq_; go += dg_; ge += dg_; \
        _Pragma("unroll") for (int j_ = 0; j_ < 4; ++j_) oo[j_] += do_; } while (0)
#define SCAN_LOAD() do { \
        _Pragma("unroll") for (int k_ = 0; k_ < 4; ++k_) qf[k_] = *(const bf16x8*)(gQKX + (size_t)qo + k_ * 32); \
        _Pragma("unroll") for (int r_ = 0; r_ < 4; ++r_) kr[r_] = *(const u32x4*)(gQKX + (size_t)ko[r_]); \
        _Pragma("unroll") for (int r_ = 0; r_ < 2; ++r_) vr[r_] = ISM ? *(const u32x4*)(gP + (size_t)vo[r_]) : *(const u32x4*)(gQKX + (size_t)vo[r_]); \
        if (tid < 128) gv = *(const f32x3*)(gG2 + (size_t)go); \
        if (ISM) { e0 = gG2[(size_t)ge]; e1 = gG2[(size_t)ge + 2]; } else { e0 = gG2[(size_t)ge + 1]; } \
    } while (0)
    SCAN_PTRS(0); SCAN_LOAD();
    const int dr_ctx = dir ? -128 : 128, dr_lat = ISM ? dr_ctx : (dir ? -1 : 1);
    __syncthreads();
#pragma unroll 1
    for (int c = 0; c < 66; ++c) {
#pragma unroll
        for (int rep = 0; rep < 4; ++rep) { const int idx = rep * 512 + tid; *(u32x4*)(Ks + (idx >> 4) * LDK + (idx & 15) * 8) = kr[rep]; }
#pragma unroll
        for (int rep = 0; rep < 2; ++rep) { const int idx = rep * 512 + tid; *(u32x4*)(Vs + (idx >> 3) * LDV + (idx & 7) * 8) = vr[rep]; }
        float decay;
        if (ISM) {
            const float Ml = fmaxf(m_prev, e1);
            if (tid < 128) { const float M = fmaxf(m_prev, gv[2]);
                f_c[tid] = gv[1] * L2E; f_r[tid] = M * L2E; f_wi[tid] = __expf(m_prev - M); f_ws[tid] = __expf(gv[1] - Ml); f_em[tid] = __expf(-(gv[0] + M)); }
            decay = __expf(m_prev - Ml); m_prev = e0 + Ml;
        } else {
            if (tid < 128) { f_c[tid] = (__logf(gv[0]) - gv[1]) * L2E; f_r[tid] = -gv[1] * L2E; f_wi[tid] = __expf(gv[1]); f_ws[tid] = __expf(e0 - gv[1]) * gv[0]; }
            decay = __expf(e0);
        }
        bf16x8 qc[4]; unsigned od[4];
#pragma unroll
        for (int k = 0; k < 4; ++k) qc[k] = qf[k];
#pragma unroll
        for (int j = 0; j < 4; ++j) od[j] = oo[j];
        const u32x4 vc0 = vr[0], vc1 = vr[1];
        LDS_BAR();
        if (c + 1 < 66) { if (c + 1 == 2) SCAN_PTRS(2); else SCAN_ADV(c == 0 ? dr_ctx : dr_lat); SCAN_LOAD(); }
        f32x4 sacc[8];
#pragma unroll
        for (int a = 0; a < 8; ++a) sacc[a] = (f32x4){0.f, 0.f, 0.f, 0.f};
#pragma unroll
        for (int a = 0; a < 8; a += 2) {
            if (a + 1 <= wid) {
                bf16x8 kf[2][4];
#pragma unroll
                for (int h2 = 0; h2 < 2; ++h2)
#pragma unroll
                    for (int ksd = 0; ksd < 4; ++ksd) kf[h2][ksd] = *(const bf16x8*)(Ks + (16 * (a + h2) + fr) * LDK + ksd * 32 + fq * 8);
#pragma unroll
                for (int ksd = 0; ksd < 4; ++ksd) { sacc[a] = __builtin_amdgcn_mfma_f32_16x16x32_bf16(kf[0][ksd], qc[ksd], sacc[a], 0, 0, 0);
                    sacc[a + 1] = __builtin_amdgcn_mfma_f32_16x16x32_bf16(kf[1][ksd], qc[ksd], sacc[a + 1], 0, 0, 0); }
            } else if (a <= wid) {
                bf16x8 kf[4];
#pragma unroll
                for (int ksd = 0; ksd < 4; ++ksd) kf[ksd] = *(const bf16x8*)(Ks + (16 * a + fr) * LDK + ksd * 32 + fq * 8);
#pragma unroll
                for (int ksd = 0; ksd < 4; ++ksd) sacc[a] = __builtin_amdgcn_mfma_f32_16x16x32_bf16(kf[ksd], qc[ksd], sacc[a], 0, 0, 0);
            }
        }
        bf16x8 sf[4]; float dsum = 0.f;
        { const float rt = f_r[16 * wid + fr];
          f32x4 cva[8];
#pragma unroll
          for (int a = 0; a < 8; ++a) cva[a] = *(const f32x4*)(f_c + 16 * a + fq * 4);
#pragma unroll
          for (int ks = 0; ks < 4; ++ks) { u32x4 w;
#pragma unroll
              for (int hf = 0; hf < 2; ++hf) { const int a = 2 * ks + hf; float v[4];
                  if (a < wid) { const f32x4 cv = cva[a];
#pragma unroll
                      for (int j = 0; j < 4; ++j) { v[j] = sacc[a][j] * __builtin_amdgcn_exp2f(cv[j] - rt); dsum += v[j]; }
                  } else if (a == wid) { const f32x4 cv = cva[a];
#pragma unroll
                      for (int j = 0; j < 4; ++j) { const float e = sacc[a][j] * __builtin_amdgcn_exp2f(cv[j] - rt); v[j] = (fq * 4 + j <= fr) ? e : 0.f; dsum += v[j]; }
                  } else { v[0] = 0.f; v[1] = 0.f; v[2] = 0.f; v[3] = 0.f; }
                  w[hf * 2] = pk2(v[0], v[1]); w[hf * 2 + 1] = pk2(v[2], v[3]); }
              sf[ks] = __builtin_bit_cast(bf16x8, w); } }
        dsum += __shfl_xor(dsum, 16, 64); dsum += __shfl_xor(dsum, 32, 64);
        {
#pragma unroll
          for (int rep = 0; rep < 2; ++rep) { const int idx = rep * 512 + tid; const int i = idx >> 3; const float wv = f_ws[i]; const u32x4 vc = rep ? vc1 : vc0; u32x4 o;
#pragma unroll
              for (int e = 0; e < 4; ++e) o[e] = pk2(bflo(vc[e]) * wv, bfhi(vc[e]) * wv);
              *(u32x4*)(Vw + i * LDV + (idx & 7) * 8) = o; }
          if (ISM && tid < 128) Vw[tid * LDV + 64] = f2bf(f_ws[tid]); }
        { f32x4 ia[NT], ib[4];
#pragma unroll
          for (int n = 0; n < NT; ++n) ia[n] = (f32x4){0.f, 0.f, 0.f, 0.f};
#pragma unroll
          for (int n = 0; n < 4; ++n) ib[n] = (f32x4){0.f, 0.f, 0.f, 0.f};
#pragma unroll
          for (int ksd = 0; ksd < 4; ++ksd) { bf16x8 bfr[NT];
#pragma unroll
              for (int n = 0; n < NT; ++n) bfr[n] = *(const bf16x8*)(CT + (n * 16 + fr) * LDK + ksd * 32 + fq * 8);
#pragma unroll
              for (int n = 0; n < NT; ++n) ia[n] = __builtin_amdgcn_mfma_f32_16x16x32_bf16(qc[ksd], bfr[n], ia[n], 0, 0, 0); }
#define SCAN_IB(ks) if (2 * (ks) <= wid) { u32x2 r0, r1, r2, r3, r4, r5, r6, r7; \
              TR_RD8(r0, r1, r2, r3, r4, r5, r6, r7, trV, (ks) * 32 * LDV * 2, (ks) * 32 * LDV * 2 + 16 * LDV * 2, (ks) * 32 * LDV * 2 + 32, (ks) * 32 * LDV * 2 + 16 * LDV * 2 + 32, \
                     (ks) * 32 * LDV * 2 + 64, (ks) * 32 * LDV * 2 + 16 * LDV * 2 + 64, (ks) * 32 * LDV * 2 + 96, (ks) * 32 * LDV * 2 + 16 * LDV * 2 + 96); \
              ib[0] = __builtin_amdgcn_mfma_f32_16x16x32_bf16(sf[ks], mkfrag(r0, r1), ib[0], 0, 0, 0); ib[1] = __builtin_amdgcn_mfma_f32_16x16x32_bf16(sf[ks], mkfrag(r2, r3), ib[1], 0, 0, 0); \
              ib[2] = __builtin_amdgcn_mfma_f32_16x16x32_bf16(sf[ks], mkfrag(r4, r5), ib[2], 0, 0, 0); ib[3] = __builtin_amdgcn_mfma_f32_16x16x32_bf16(sf[ks], mkfrag(r6, r7), ib[3], 0, 0, 0); }
          SCAN_IB(0) SCAN_IB(1) SCAN_IB(2) SCAN_IB(3)
#undef SCAN_IB
#pragma unroll
          for (int j = 0; j < 4; ++j) { const int tl = fq * 4 + j, t = 16 * wid + tl; const float wi = f_wi[t];
              float inv = 1.f;
              if (ISM) { const float qn = __shfl(ia[NT - 1][j], lane & 48, 64); const float dn = __shfl(dsum, tl, 64); inv = __builtin_amdgcn_rcpf(fmaxf(fabsf(wi * qn + dn), f_em[t])); }
              u16* dst = obase + (size_t)od[j];
              float v[4];
#pragma unroll
              for (int n = 0; n < 4; ++n) { v[n] = (wi * ia[n][j] + ib[n][j]) * inv; if (!ISM && dir == 0) v[n] += Dh * bf2f(Vs[t * LDV + n * 16 + fr]); }
              const unsigned p01 = pk2(v[0], v[1]), p23 = pk2(v[2], v[3]);
              dst[0] = (u16)(p01 & 0xFFFFu); dst[16] = (u16)(p01 >> 16); dst[32] = (u16)(p23 & 0xFFFFu); dst[48] = (u16)(p23 >> 16); } }
        LDS_BAR();
        {
#pragma unroll
          for (int m = 0; m < NT; ++m) st[m] *= decay;
#define SCAN_ST(ks) { u32x2 k0, k1, a0, a1, a2, a3, a4, a5, a6, a7, a8, a9; \
              if (ISM) TR_ST12(k0, k1, a0, a1, a2, a3, a4, a5, a6, a7, a8, a9, trK, trVw, (ks) * 32 * LDK * 2, (ks) * 32 * LDK * 2 + 4 * LDK * 2, \
                     (ks) * 32 * LDV * 2, (ks) * 32 * LDV * 2 + 4 * LDV * 2, (ks) * 32 * LDV * 2 + 32, (ks) * 32 * LDV * 2 + 4 * LDV * 2 + 32, \
                     (ks) * 32 * LDV * 2 + 64, (ks) * 32 * LDV * 2 + 4 * LDV * 2 + 64, (ks) * 32 * LDV * 2 + 96, (ks) * 32 * LDV * 2 + 4 * LDV * 2 + 96, \
                     (ks) * 32 * LDV * 2 + 128, (ks) * 32 * LDV * 2 + 4 * LDV * 2 + 128); \
              else TR_ST10(k0, k1, a0, a1, a2, a3, a4, a5, a6, a7, trK, trVw, (ks) * 32 * LDK * 2, (ks) * 32 * LDK * 2 + 4 * LDK * 2, \
                     (ks) * 32 * LDV * 2, (ks) * 32 * LDV * 2 + 4 * LDV * 2, (ks) * 32 * LDV * 2 + 32, (ks) * 32 * LDV * 2 + 4 * LDV * 2 + 32, \
                     (ks) * 32 * LDV * 2 + 64, (ks) * 32 * LDV * 2 + 4 * LDV * 2 + 64, (ks) * 32 * LDV * 2 + 96, (ks) * 32 * LDV * 2 + 4 * LDV * 2 + 96); \
              const bf16x8 kfr = mkfrag(k0, k1); \
              st[0] = __builtin_amdgcn_mfma_f32_16x16x32_bf16(mkfrag(a0, a1), kfr, st[0], 0, 0, 0); st[1] = __builtin_amdgcn_mfma_f32_16x16x32_bf16(mkfrag(a2, a3), kfr, st[1], 0, 0, 0); \
              st[2] = __builtin_amdgcn_mfma_f32_16x16x32_bf16(mkfrag(a4, a5), kfr, st[2], 0, 0, 0); st[3] = __builtin_amdgcn_mfma_f32_16x16x32_bf16(mkfrag(a6, a7), kfr, st[3], 0, 0, 0); \
              if (ISM) st[NT - 1] = __builtin_amdgcn_mfma_f32_16x16x32_bf16(mkfrag(a8, a9), kfr, st[NT - 1], 0, 0, 0); }
          SCAN_ST(0) SCAN_ST(1) SCAN_ST(2) SCAN_ST(3)
#undef SCAN_ST
#pragma unroll
          for (int m = 0; m < NT; ++m) { const unsigned p01 = pk2(st[m][0], st[m][1]), p23 = pk2(st[m][2], st[m][3]);
              u16* cp = CT + (m * 16 + fq * 4) * LDK + 16 * wid + fr;
              cp[0] = (u16)(p01 & 0xFFFFu); cp[LDK] = (u16)(p01 >> 16); cp[2 * LDK] = (u16)(p23 & 0xFFFFu); cp[3 * LDK] = (u16)(p23 >> 16); } }
        LDS_BAR();
    }
#undef SCAN_LOAD
#undef SCAN_ADV
#undef SCAN_PTRS
}

__device__ void phase_scan(const Params& p, int l, unsigned char* lds) {
    for (int blk = BIDX; blk < 256; blk += GDIM) {
        const int xcd = blk & 7, j = blk >> 3;
        if (j < 16) scan_item<true>(p, l, (xcd + 8 * (j >> 2)) * 4 + (j & 3), lds);
        else { const int G = xcd + 8 * ((j - 16) >> 3), r = (j - 16) & 7; const int dir = G & 1, g = (G >> 1) & 3, b = G >> 3;
            scan_item<false>(p, l, dir + 2 * (g * 8 + r) + 64 * b, lds); }
    }
}

__device__ void phase_post(const Params& p, int l) {
    const int wid = TIDX >> 6, lane = TIDX & 63;
    const int nw = GDIM * 8;
    const int c0 = lane * 32;
    for (int row = BIDX * 8 + wid; row < MROWS; row += nw) {
        u16* pr = p.P + (size_t)row * PW;
        {
            float tv[32]; float ss = 0.f;
#pragma unroll
            for (int q = 0; q < 4; ++q) { const u32x4 yv = *(const u32x4*)(pr + 8192 + c0 + q * 8), zv = *(const u32x4*)(pr + 11264 + c0 + q * 8), yb = *(const u32x4*)(p.YB + (size_t)row * 2048 + c0 + q * 8);
#pragma unroll
                for (int e = 0; e < 4; ++e) { const float t0 = (bflo(yv[e]) + bflo(yb[e])) * siluf(bflo(zv[e])), t1 = (bfhi(yv[e]) + bfhi(yb[e])) * siluf(bfhi(zv[e]));
                    tv[q * 8 + 2 * e] = t0; tv[q * 8 + 2 * e + 1] = t1; ss += t0 * t0 + t1 * t1; } }
            const float rstd = rsqrtf(wsum(ss) * (1.f / 2048.f) + LN_EPS);
            const float* sw = p.ssm_w + (size_t)l * 2048 + c0;
#pragma unroll
            for (int q = 0; q < 4; ++q) { const f32x4 wa = *(const f32x4*)(sw + q * 8), wb = *(const f32x4*)(sw + q * 8 + 4);
                u32x4 o; o.x = pk2(tv[q * 8] * rstd * wa[0], tv[q * 8 + 1] * rstd * wa[1]); o.y = pk2(tv[q * 8 + 2] * rstd * wa[2], tv[q * 8 + 3] * rstd * wa[3]);
                o.z = pk2(tv[q * 8 + 4] * rstd * wb[0], tv[q * 8 + 5] * rstd * wb[1]); o.w = pk2(tv[q * 8 + 6] * rstd * wb[2], tv[q * 8 + 7] * rstd * wb[3]);
                *(u32x4*)(pr + 11264 + c0 + q * 8) = o; }
        }
        {
            float hv[32]; float s = 0.f;
#pragma unroll
            for (int q = 0; q < 4; ++q) { const u32x4 a = *(const u32x4*)(pr + c0 + q * 8), ab = *(const u32x4*)(p.HB + (size_t)row * 2048 + c0 + q * 8);
#pragma unroll
                for (int e = 0; e < 4; ++e) { const float h0 = bflo(a[e]) + bflo(ab[e]), h1 = bfhi(a[e]) + bfhi(ab[e]); hv[q * 8 + 2 * e] = h0; hv[q * 8 + 2 * e + 1] = h1; s += h0 + h1; } }
            s += __shfl_xor(s, 1, 64); s += __shfl_xor(s, 2, 64); s += __shfl_xor(s, 4, 64);
            const float mean = s * (1.f / 256.f);
            float q2 = 0.f;
#pragma unroll
            for (int e = 0; e < 32; ++e) { const float d = hv[e] - mean; q2 += d * d; }
            q2 += __shfl_xor(q2, 1, 64); q2 += __shfl_xor(q2, 2, 64); q2 += __shfl_xor(q2, 4, 64);
            const float rstd = rsqrtf(q2 * (1.f / 256.f) + LN_EPS);
            const float* mw = p.mh_w + (size_t)l * 2048 + c0;
#pragma unroll
            for (int q = 0; q < 4; ++q) { const u32x4 ov = *(const u32x4*)(pr + 4096 + c0 + q * 8), zv = *(const u32x4*)(pr + 6144 + c0 + q * 8);
                const f32x4 wa = *(const f32x4*)(mw + q * 8), wb = *(const f32x4*)(mw + q * 8 + 4);
                float r[8];
#pragma unroll
                for (int e = 0; e < 4; ++e) {
                    const float m0 = (e < 2 ? wa[2 * e] : wb[2 * e - 4]), m1 = (e < 2 ? wa[2 * e + 1] : wb[2 * e - 3]);
                    r[2 * e] = sigmf(bflo(ov[e])) * ((hv[q * 8 + 2 * e] - mean) * rstd * m0) * siluf(bflo(zv[e]));
                    r[2 * e + 1] = sigmf(bfhi(ov[e])) * ((hv[q * 8 + 2 * e + 1] - mean) * rstd * m1) * siluf(bfhi(zv[e])); }
                u32x4 o; o.x = pk2(r[0], r[1]); o.y = pk2(r[2], r[3]); o.z = pk2(r[4], r[5]); o.w = pk2(r[6], r[7]);
                *(u32x4*)(pr + 9216 + c0 + q * 8) = o; }
        }
    }
}

__device__ __forceinline__ void grid_barrier(unsigned* ctr, unsigned target) {
    __syncthreads();
    if (threadIdx.x == 0) {
        __builtin_amdgcn_fence(__ATOMIC_RELEASE, "agent");
        asm volatile("s_waitcnt vmcnt(0)" ::: "memory");
        __hip_atomic_fetch_add(ctr, 1u, __ATOMIC_RELAXED, __HIP_MEMORY_SCOPE_AGENT);
        while (__hip_atomic_load(ctr, __ATOMIC_RELAXED, __HIP_MEMORY_SCOPE_AGENT) < target) __builtin_amdgcn_s_sleep(2);
        __builtin_amdgcn_fence(__ATOMIC_ACQUIRE, "agent");
        asm volatile("s_waitcnt vmcnt(0)" ::: "memory");
    }
    __syncthreads();
}
__device__ __forceinline__ void acquire_workgroup() {
    if (threadIdx.x == 0) { __builtin_amdgcn_fence(__ATOMIC_ACQUIRE, "agent"); asm volatile("s_waitcnt vmcnt(0)" ::: "memory"); }
    __syncthreads();
}

constexpr int N_PHASES = 2 + 6 * DEPTH;
__global__ __launch_bounds__(512, 2) void mega(KArgs ka, int ph_lo, int ph_hi) {
    extern __shared__ __attribute__((aligned(16))) unsigned char shm[];
    cg::grid_group grid = cg::this_grid();
#pragma unroll 1
    for (int ph = ph_lo; ph < ph_hi; ++ph) {
        if (ph == 0) {
            Params q{}; unsigned char* ws = KWS();
            q.c = KIN(1); q.c_ctx = KIN(3); q.w_ada = KIN(4); q.b_ada = KIN(5); q.w_in = KIN(6); q.w_out = KIN(17);
            q.MOD = (float*)(ws + OFF_MOD); q.wt_in = (u16*)(ws + OFF_W); q.wt_out = (u16*)(ws + OFF_W + SZ_WTIN1);
            phase_a(q, shm);
        } else {
            const int l = (ph == N_PHASES - 1) ? DEPTH : (ph - 1) / 6, k = (ph == N_PHASES - 1) ? 0 : (ph - 1) % 6;
            if (k == 0) {
                Params q{}; unsigned char* ws = KWS();
                q.x = KIN(0); q.ctx = KIN(2); q.ln_g = KIN(18); q.ln_b = KIN(19); q.out = KOUT();
                q.RC = (float*)(ws + OFF_RC); q.MOD = (float*)(ws + OFF_MOD); q.U = (u16*)(ws + OFF_U);
                phase_ln(q, l);
                if (l >= 1 && l < DEPTH) {
                    q.w_in = KIN(6); q.w_out = KIN(17); q.wt_in = (u16*)(ws + OFF_W); q.wt_out = (u16*)(ws + OFF_W + SZ_WTIN1);
                    weight_tiles(q, (float*)shm, l);
                }
            } else if (k == 1) {
                unsigned char* ws = KWS();
                pg8::Gemm g{(const u16*)(ws + OFF_U), (const u16*)(ws + OFF_W + (size_t)l * SZ_WL), MROWS, NPAD, 2048, 2048};
                pg8::StaticOrder S; S.init(MROWS, NPAD, GDIM, BIDX);
                EpiG1 E{(u16*)(ws + OFF_P), (float*)(ws + OFF_GD)};
                pg8::gemm_phase<EpiG1>((LAS unsigned char*)shm, g, S, E);
            } else if (k == 2) {
                Params q{}; unsigned char* ws = KWS();
                q.conv_qk_w = KIN(7); q.conv_qk_b = KIN(8); q.conv_xbc_w = KIN(11); q.conv_xbc_b = KIN(12); q.gate_b = KIN(9); q.dt_bias = KIN(13); q.a_log = KIN(14);
                q.P = (u16*)(ws + OFF_P); q.QKX = (u16*)(ws + OFF_QKX); q.GD = (float*)(ws + OFF_GD); q.G2 = (float*)(ws + OFF_G2);
                phase_conv(q, l);
            } else if (k == 3) {
                Params q{}; unsigned char* ws = KWS();
                q.gate_b = KIN(9); q.dt_bias = KIN(13); q.a_log = KIN(14); q.d_skip = KIN(15);
                q.P = (u16*)(ws + OFF_P); q.QKX = (u16*)(ws + OFF_QKX); q.G2 = (float*)(ws + OFF_G2);
                q.HB = (u16*)(ws + OFF_U); q.YB = (u16*)(ws + OFF_W + (size_t)((l + 1) & 1) * SZ_WL);
                phase_scan(q, l, shm);
            } else if (k == 4) {
                Params q{}; unsigned char* ws = KWS();
                q.mh_w = KIN(10); q.ssm_w = KIN(16); q.P = (u16*)(ws + OFF_P);
                q.HB = (u16*)(ws + OFF_U); q.YB = (u16*)(ws + OFF_W + (size_t)((l + 1) & 1) * SZ_WL);
                phase_post(q, l);
            } else {
                unsigned char* ws = KWS(); float* outp = KOUT();
                const float* xin = KIN(0); const float* cin = KIN(2);
                float* rc = (float*)(ws + OFF_RC);
                const int roff = (l == DEPTH - 1) ? CTXROWS : 0;
                pg8::Gemm g{(const u16*)(ws + OFF_P) + (size_t)roff * PW + 9216, (const u16*)(ws + OFF_W + (size_t)l * SZ_WL + SZ_WTIN1), MROWS - roff, 2048, 4096, PW};
                pg8::StaticOrder S; S.init(MROWS - roff, 2048, GDIM, BIDX);
                EpiG2 E{l == 0 ? xin : outp, l == 0 ? cin : rc, outp, rc, (const float*)(ws + OFF_MOD) + (size_t)l * 3 * 6144, roff};
                pg8::gemm_phase<EpiG2>((LAS unsigned char*)shm, g, S, E);
            }
        }
        if (ph + 1 < ph_hi) {
            if (ph_hi > N_PHASES) { grid.sync(); acquire_workgroup(); }
            grid_barrier((unsigned*)(KWS() + OFF_BAR), (unsigned)(ph - ph_lo + 1) * (unsigned)GDIM);
        }
    }
}

extern "C" void kernel_launch(void* const* d_in, const int* in_sizes, int n_in, void* d_out, int out_size, void* d_ws, size_t ws_size, hipStream_t stream) {
    static int grid = 0;
    if (grid == 0) {
        if (n_in != 20 || ws_size < WS_END) { fprintf(stderr, "kernel_launch: unexpected n_in %d or ws_size %zu (< %zu)\n", n_in, ws_size, (size_t)WS_END); grid = -1; return; }
        int dev = 0, cus = 0, per_cu = 0;
        hipGetDevice(&dev);
        hipDeviceGetAttribute(&cus, hipDeviceAttributeMultiprocessorCount, dev);
        if (hipFuncSetAttribute((const void*)mega, hipFuncAttributeMaxDynamicSharedMemorySize, LDS_BYTES) != hipSuccess) { fprintf(stderr, "kernel_launch: hipFuncSetAttribute failed\n"); grid = -1; return; }
        if (hipOccupancyMaxActiveBlocksPerMultiprocessor(&per_cu, (const void*)mega, 512, LDS_BYTES) != hipSuccess || per_cu < 1) { fprintf(stderr, "kernel_launch: occupancy query says %d\n", per_cu); per_cu = 1; }
        (void)hipGetLastError();
        grid = cus;
    }
    if (grid < 0) return;
    if (hipMemsetAsync((unsigned char*)d_ws + OFF_BAR, 0, 256, stream) != hipSuccess) { fprintf(stderr, "kernel_launch: memset failed\n"); return; }
    KArgs ka{};
    for (int i = 0; i < 20; ++i) ka.in[i] = (const float*)d_in[i];
    ka.out = (float*)d_out; ka.ws = (unsigned char*)d_ws;
    int lo = 0, hi = N_PHASES;
    void* args[] = {&ka, &lo, &hi};
    hipError_t e = hipLaunchCooperativeKernel((const void*)mega, dim3(grid), dim3(512), args, LDS_BYTES, stream);
    if (e != hipSuccess) fprintf(stderr, "kernel_launch: cooperative launch failed: %s (grid %d)\n", hipGetErrorString(e), grid);
}
```

```cpp
#include <hip/hip_runtime.h>
#include <hip/hip_cooperative_groups.h>
#include <cstdio>
namespace cg = cooperative_groups;

#define LAS __attribute__((address_space(3)))
typedef unsigned short u16;
typedef short bf16x8 __attribute__((ext_vector_type(8)));
typedef float f32x4 __attribute__((ext_vector_type(4)));
typedef unsigned u32x4 __attribute__((ext_vector_type(4)));
typedef unsigned u32x2 __attribute__((ext_vector_type(2)));
typedef float f32x3 __attribute__((ext_vector_type(3)));

constexpr int D = 2048, DEPTH = 2;
constexpr int CTXROWS = 512, MROWS = 16896;
constexpr int NIN = 13408, NPAD = 13568, PW = 13312, GDW = 96, QW = 5120, G2W = 176;
constexpr float LN_EPS = 1e-5f;
constexpr float ALPHA = 1.4142135623730951f;
constexpr int LDS_BYTES = 139264;

constexpr size_t SZ_WTIN1 = (size_t)NPAD * 2048 * 2, SZ_WTOUT1 = (size_t)2048 * 4096 * 2, SZ_WL = SZ_WTIN1 + SZ_WTOUT1;
constexpr size_t SZ_P = (size_t)MROWS * PW * 2, SZ_GD = (size_t)MROWS * GDW * 4, SZ_U = (size_t)MROWS * 2048 * 2;
constexpr size_t SZ_QKX = (size_t)MROWS * QW * 2, SZ_MOD = (size_t)DEPTH * 3 * 6144 * 4, SZ_RC = (size_t)CTXROWS * 2048 * 4;
constexpr size_t OFF_W = 0, OFF_P = OFF_W + DEPTH * SZ_WL, OFF_GD = OFF_P + SZ_P, OFF_U = OFF_GD + SZ_GD,
                 OFF_QKX = OFF_U + SZ_U, OFF_MOD = OFF_QKX + SZ_QKX, OFF_RC = OFF_MOD + SZ_MOD, OFF_BAR = OFF_RC + SZ_RC, OFF_G2 = OFF_BAR + 256, WS_END = OFF_G2 + (size_t)MROWS * 176 * 4 + 256;

struct Params {
    const float *x, *c, *ctx, *c_ctx, *w_ada, *b_ada, *w_in, *conv_qk_w, *conv_qk_b, *gate_b, *mh_w, *conv_xbc_w, *conv_xbc_b, *dt_bias, *a_log, *d_skip,
        *ssm_w, *w_out, *ln_g, *ln_b;
    float* out;
    u16 *wt_in, *wt_out, *P, *U, *QKX, *HB, *YB;
    float *GD, *MOD, *RC, *G2;
};
struct KArgs { const float* in[20]; float* out; unsigned char* ws; };
template <int IDX> __device__ __forceinline__ const void* kload() {
    unsigned long r;
    asm volatile("s_load_dwordx2 %0, %1, %2\n\ts_waitcnt lgkmcnt(0)" : "=s"(r) : "s"(__builtin_amdgcn_kernarg_segment_ptr()), "n"(IDX * 8) : "memory");
    return (const void*)(const __attribute__((address_space(1))) char*)r;
}
#define KIN(i) ((const float*)kload<(i)>())
#define KOUT() ((float*)kload<20>())
#define KWS() ((unsigned char*)kload<21>())

__device__ __forceinline__ int tid_() { int t = threadIdx.x; asm volatile("" : "+v"(t)); return t; }
__device__ __forceinline__ int bid_() { int b = blockIdx.x; asm volatile("" : "+s"(b)); return b; }
__device__ __forceinline__ int gdim_() { int g = gridDim.x; asm volatile("" : "+s"(g)); return g; }
#define TIDX tid_()
#define BIDX bid_()
#define GDIM gdim_()

typedef float f32x2_t __attribute__((ext_vector_type(2)));
typedef __bf16 bf16x2_t __attribute__((ext_vector_type(2)));
__device__ __forceinline__ u16 f2bf(float f) { return __builtin_bit_cast(u16, (__bf16)f); }
__device__ __forceinline__ float bf2f(unsigned h) { return __uint_as_float(h << 16); }
__device__ __forceinline__ float bflo(unsigned w) { return __uint_as_float(w << 16); }
__device__ __forceinline__ float bfhi(unsigned w) { return __uint_as_float(w & 0xFFFF0000u); }
__device__ __forceinline__ unsigned pk2(float lo, float hi) { const f32x2_t v = {lo, hi}; return __builtin_bit_cast(unsigned, __builtin_convertvector(v, bf16x2_t)); }
__device__ __forceinline__ unsigned cvt_pk_bf16(float lo, float hi) { unsigned r; asm volatile("v_cvt_pk_bf16_f32 %0, %1, %2" : "=v"(r) : "v"(lo), "v"(hi)); return r; }
__device__ __forceinline__ float wsum(float v) {
#pragma unroll
    for (int o = 32; o > 0; o >>= 1) v += __shfl_xor(v, o, 64);
    return v;
}
__device__ __forceinline__ float siluf(float v) { return v / (1.f + __expf(-v)); }
__device__ __forceinline__ float sigmf(float v) { return 1.f / (1.f + __expf(-v)); }
__device__ __forceinline__ float scan_add(float v, int lane) {
#pragma unroll
    for (int d = 1; d < 64; d <<= 1) { float t = __shfl_up(v, d, 64); if (lane >= d) v += t; }
    return v;
}
__device__ __forceinline__ float scan_max(float v, int lane) {
#pragma unroll
    for (int d = 1; d < 64; d <<= 1) { float t = __shfl_up(v, d, 64); if (lane >= d) v = fmaxf(v, t); }
    return v;
}
__device__ __forceinline__ int src_col(int n) {
    if (n < 8192) return n;
    if (n < 11264) return n + 32;
    if (n < 13312) return n + 96;
    if (n < 13344) return n - 5120;
    if (n < 13408) return n - 2048;
    return -1;
}

namespace pg8 {
constexpr int BM = 256, BK = 64, HALF = 128, HTB = HALF * BK * 2, STAGE_BYTES = 8 * HTB, NXCD = 8, WGM = 8;
__host__ __device__ __forceinline__ int lds_byte(int r, int c) { const int st = (r >> 4) * 2 + (c >> 5), rr = r & 15, cc = c & 31, ob = rr * 64 + cc * 2; return st * 1024 + (ob ^ (((ob >> 9) & 1) << 5)); }
__host__ __device__ __forceinline__ void stage_rc(int b, int& R, int& C) { const int st = b / 1024, sb = b % 1024, swz = sb ^ (((sb >> 9) & 1) << 5); R = (st >> 1) * 16 + swz / 64; C = (st & 1) * 32 + (swz % 64) / 2; }
__host__ __device__ __forceinline__ int perm32(int rho) { const int n = rho >> 4, i = rho & 15; return 8 * (i >> 2) + 4 * n + (i & 3); }
struct Unit { int pm, pn; };
struct Gemm { const u16* A; const u16* Bt; int M, N, K, lda; };
struct StaticOrder {
    int nM, nN, nwg, G, c;
    __device__ void init(int M, int N, int G_, int c_) { nM = M / BM; nN = N / BM; nwg = nM * nN; G = G_; c = c_; }
    __device__ bool next(int i, Unit& u) const {
        const long L = (long)i * G + c; if (L >= nwg) return false;
        int wgid = (int)L; { const int q = nwg / NXCD, r = nwg % NXCD, xcd = wgid % NXCD, off = wgid / NXCD; wgid = (xcd < r ? xcd * (q + 1) : r * (q + 1) + (xcd - r) * q) + off; }
        const int nig = WGM * nN, gid = wgid / nig, fm = gid * WGM, gsz = (nM - fm) < WGM ? (nM - fm) : WGM;
        u.pm = fm + ((wgid % nig) % gsz); u.pn = (wgid % nig) / gsz; return true;
    }
};

template <class Epi>
__device__ __forceinline__ void gemm_phase(LAS unsigned char* lds, const Gemm g, const StaticOrder& S, const Epi& E) {
    const int tid = TIDX, wid = __builtin_amdgcn_readfirstlane(tid >> 6), lane = tid & 63, wr = wid >> 2, wc = wid & 3, fr = lane & 15, fq = lane >> 4;
    const int K = g.K, nt = K / BK, lda = g.lda;
    unsigned voffA[2], voffB[2];
#pragma unroll
    for (int i = 0; i < 2; ++i) { int R, C; stage_rc(tid * 16 + i * 8192, R, C); const int Rb = Epi::PERM ? ((R & ~31) + perm32(R & 31)) : R;
        voffA[i] = (unsigned)(R * lda + C) * 2u; voffB[i] = (unsigned)(Rb * K + C) * 2u; }
    const size_t kstep = (size_t)(BK * 2);
    const size_t hA = (size_t)HALF * lda * 2, hB = (size_t)HALF * K * 2;
    const size_t tA = 2 * hA, tB = 2 * hB;
    const unsigned ldsw = (unsigned)wid * 1024u;
    const int aoff = lds_byte(wr * 64 + fr, fq * 8), boff = lds_byte(wc * 32 + fr, fq * 8);
#define PG8_SA(b, h) (((b) * 2 + (h)) * HTB)
#define PG8_SB(b, h) ((4 + (b) * 2 + (h)) * HTB)
#define PG8_STAGE(bufoff, gbase, voff) do { _Pragma("unroll") for (int _i = 0; _i < 2; ++_i) \
        __builtin_amdgcn_global_load_lds((const unsigned*)((const char*)(gbase) + (voff)[_i]), (LAS unsigned*)(lds + (bufoff) + ldsw + _i * 8192), 16, 0, 0); } while (0)
#define PG8_LDA(dst, b, h) do { _Pragma("unroll") for (int m = 0; m < 4; ++m) _Pragma("unroll") for (int k = 0; k < 2; ++k) dst[m][k] = *(const LAS bf16x8*)(lds + PG8_SA(b, h) + aoff + m * 2048 + k * 1024); } while (0)
#define PG8_LDB(dst, b, h) do { _Pragma("unroll") for (int n = 0; n < 2; ++n) _Pragma("unroll") for (int k = 0; k < 2; ++k) dst[n][k] = *(const LAS bf16x8*)(lds + PG8_SB(b, h) + boff + n * 2048 + k * 1024); } while (0)
#define PG8_MMA(ai, bj, At, Bt) do { __builtin_amdgcn_s_setprio(1); _Pragma("unroll") for (int m = 0; m < 4; ++m) _Pragma("unroll") for (int n = 0; n < 2; ++n) _Pragma("unroll") for (int k = 0; k < 2; ++k) \
        acc[ai][bj][m][n] = __builtin_amdgcn_mfma_f32_16x16x32_bf16(Bt[n][k], At[m][k], acc[ai][bj][m][n], 0, 0, 0); __builtin_amdgcn_s_setprio(0); } while (0)
#define PG8_WAIT_V(n) asm volatile("s_waitcnt vmcnt(" #n ")" ::: "memory")
#define PG8_WAIT_L(n) asm volatile("s_waitcnt lgkmcnt(" #n ")" ::: "memory")
#define PG8_BAR __builtin_amdgcn_s_barrier()
#define PG8_SCHED __builtin_amdgcn_sched_barrier(0)
    Unit cur, nxt; int ui = 0;
    if (!S.next(0, cur)) return;
    f32x4 acc[2][2][4][2];
#pragma unroll
    for (int a = 0; a < 2; ++a)
#pragma unroll
        for (int b = 0; b < 2; ++b)
#pragma unroll
            for (int m = 0; m < 4; ++m)
#pragma unroll
                for (int n = 0; n < 2; ++n) acc[a][b][m][n] = (f32x4){0.f, 0.f, 0.f, 0.f};
    bf16x8 At[4][2], B0[2][2], B1[2][2];
    const char* cA = (const char*)g.A + (size_t)cur.pm * tA; const char* cB = (const char*)g.Bt + (size_t)cur.pn * tB;
    PG8_STAGE(PG8_SB(0, 0), cB, voffB); PG8_STAGE(PG8_SA(0, 0), cA, voffA); PG8_STAGE(PG8_SB(0, 1), cB + hB, voffB); PG8_STAGE(PG8_SA(0, 1), cA + hA, voffA);
    if (wr == 1) PG8_BAR;
    PG8_WAIT_V(4); PG8_BAR;
    PG8_STAGE(PG8_SB(1, 0), cB + kstep, voffB); PG8_STAGE(PG8_SA(1, 0), cA + kstep, voffA); PG8_STAGE(PG8_SB(1, 1), cB + hB + kstep, voffB);
    PG8_WAIT_V(6); PG8_BAR;
    for (;;) {
        const bool has_next = S.next(ui + 1, nxt);
        const char* nA = has_next ? (const char*)g.A + (size_t)nxt.pm * tA : cA; const char* nB = has_next ? (const char*)g.Bt + (size_t)nxt.pn * tB : cB;
        for (int t = 0; t < nt; t += 2) {
            const bool last = (t == nt - 2);
            const char* a1 = cA + (size_t)(t + 1) * kstep;
            const char* a2 = last ? nA : cA + (size_t)(t + 2) * kstep; const char* b2 = last ? nB : cB + (size_t)(t + 2) * kstep;
            const char* a3 = a2 + kstep; const char* b3 = b2 + kstep;
            PG8_LDB(B0, 0, 0); PG8_SCHED; PG8_LDA(At, 0, 0); PG8_STAGE(PG8_SA(1, 1), a1 + hA, voffA);
            PG8_WAIT_L(8); PG8_BAR; PG8_WAIT_L(0); PG8_MMA(0, 0, At, B0); PG8_BAR; PG8_SCHED;
            PG8_LDB(B1, 0, 1); PG8_STAGE(PG8_SB(0, 0), b2, voffB);
            PG8_BAR; PG8_WAIT_L(0); PG8_MMA(0, 1, At, B1); PG8_BAR;
            PG8_LDA(At, 0, 1); PG8_STAGE(PG8_SA(0, 0), a2, voffA);
            PG8_BAR; PG8_WAIT_L(0); PG8_MMA(1, 0, At, B0); PG8_BAR; PG8_SCHED;
            PG8_STAGE(PG8_SB(0, 1), b2 + hB, voffB);
            PG8_WAIT_V(6); PG8_BAR; PG8_MMA(1, 1, At, B1); PG8_BAR;
            PG8_LDB(B0, 1, 0); PG8_SCHED; PG8_LDA(At, 1, 0); PG8_STAGE(PG8_SA(0, 1), a2 + hA, voffA);
            PG8_WAIT_L(8); PG8_BAR; PG8_WAIT_L(0); PG8_MMA(0, 0, At, B0); PG8_BAR; PG8_SCHED;
            PG8_LDB(B1, 1, 1); PG8_STAGE(PG8_SB(1, 0), b3, voffB);
            PG8_BAR; PG8_WAIT_L(0); PG8_MMA(0, 1, At, B1); PG8_BAR;
            PG8_LDA(At, 1, 1); PG8_STAGE(PG8_SA(1, 0), a3, voffA);
            PG8_BAR; PG8_WAIT_L(0); PG8_MMA(1, 0, At, B0); PG8_BAR; PG8_SCHED;
            PG8_STAGE(PG8_SB(1, 1), b3 + hB, voffB);
            PG8_WAIT_V(6); PG8_BAR; PG8_MMA(1, 1, At, B1); PG8_BAR;
        }
        E(acc, cur, wr, wc, fr, fq);
        if (!has_next) break;
#pragma unroll
        for (int a = 0; a < 2; ++a)
#pragma unroll
            for (int b = 0; b < 2; ++b)
#pragma unroll
                for (int m = 0; m < 4; ++m)
#pragma unroll
                    for (int n = 0; n < 2; ++n) acc[a][b][m][n] = (f32x4){0.f, 0.f, 0.f, 0.f};
        cur = nxt; cA = nA; cB = nB; ++ui;
    }
    PG8_WAIT_V(0);
    if (wr == 0) PG8_BAR;
    PG8_BAR;
#undef PG8_SA
#undef PG8_SB
#undef PG8_STAGE
#undef PG8_LDA
#undef PG8_LDB
#undef PG8_MMA
#undef PG8_WAIT_V
#undef PG8_WAIT_L
#undef PG8_BAR
#undef PG8_SCHED
}
}

struct EpiG1 {
    static constexpr bool PERM = true;
    u16* P; float* GD;
    __device__ __forceinline__ void operator()(const f32x4 (&acc)[2][2][4][2], const pg8::Unit& u, int wr, int wc, int fr, int fq) const {
        const int row0 = u.pm * 256 + wr * 64 + fr;
        if (u.pn < 52) {
            const int col0 = u.pn * 256 + wc * 32 + 8 * fq;
#pragma unroll
            for (int ai = 0; ai < 2; ++ai)
#pragma unroll
                for (int m = 0; m < 4; ++m) { u16* rowp = P + (size_t)(row0 + ai * 128 + m * 16) * PW + col0;
#pragma unroll
                    for (int bj = 0; bj < 2; ++bj) { const f32x4 v0 = acc[ai][bj][m][0], v1 = acc[ai][bj][m][1];
                        u32x4 w; w.x = cvt_pk_bf16(v0[0], v0[1]); w.y = cvt_pk_bf16(v0[2], v0[3]); w.z = cvt_pk_bf16(v1[0], v1[1]); w.w = cvt_pk_bf16(v1[2], v1[3]);
                        *(u32x4*)(rowp + bj * 128) = w; } }
        } else if (wc < 3) {
            const int cc0 = wc * 32 + 8 * fq;
#pragma unroll
            for (int ai = 0; ai < 2; ++ai)
#pragma unroll
                for (int m = 0; m < 4; ++m) { float* rowp = GD + (size_t)(row0 + ai * 128 + m * 16) * GDW + cc0;
                    *(f32x4*)(rowp) = acc[ai][0][m][0]; *(f32x4*)(rowp + 4) = acc[ai][0][m][1]; }
        }
    }
};
struct EpiG2 {
    static constexpr bool PERM = false;
    const float* xres_lat; const float* xres_ctx; float* dst_lat; float* dst_ctx; const float* modl; int row_off;
    __device__ __forceinline__ void operator()(const f32x4 (&acc)[2][2][4][2], const pg8::Unit& u, int wr, int wc, int fr, int fq) const {
        const int g0 = u.pm * 256 + row_off;
        const bool isctx = g0 < CTXROWS;
        const int b = isctx ? (g0 >> 8) : ((g0 - CTXROWS) >> 13);
        const float* gate = modl + (size_t)(isctx ? 2 : b) * 6144 + 4096;
        const float* xr = isctx ? xres_ctx + (size_t)g0 * D : xres_lat + (size_t)(g0 - CTXROWS) * D;
        float* ds = isctx ? dst_ctx + (size_t)g0 * D : dst_lat + (size_t)(g0 - CTXROWS) * D;
        const int col0 = u.pn * 256 + wc * 32 + 4 * fq;
        f32x4 gv[2][2];
#pragma unroll
        for (int bj = 0; bj < 2; ++bj)
#pragma unroll
            for (int n = 0; n < 2; ++n) gv[bj][n] = *(const f32x4*)(gate + col0 + bj * 128 + n * 16);
#pragma unroll
        for (int ai = 0; ai < 2; ++ai)
#pragma unroll
            for (int m = 0; m < 4; ++m) { const size_t ro = (size_t)(wr * 64 + fr + ai * 128 + m * 16) * D + col0;
#pragma unroll
                for (int bj = 0; bj < 2; ++bj)
#pragma unroll
                    for (int n = 0; n < 2; ++n) { const f32x4 xv = *(const f32x4*)(xr + ro + bj * 128 + n * 16);
                        *(f32x4*)(ds + ro + bj * 128 + n * 16) = xv * ALPHA + gv[bj][n] * acc[ai][bj][m][n]; } }
    }
};

struct TrTile { const float* src; u16* dst; int Nsrc, K, n0, k0, perm; };
__device__ __forceinline__ void tr_load(const TrTile& t, float (&v)[16], int tid) {
    const int nl = tid & 63, kb = tid >> 6; const int n = t.n0 + nl; const int sc = t.perm ? src_col(n) : n;
#pragma unroll
    for (int i = 0; i < 16; ++i) { const int kl = i * 8 + kb; v[i] = sc >= 0 ? t.src[(size_t)(t.k0 + kl) * t.Nsrc + sc] : 0.f; }
}
__device__ __forceinline__ void tr_to_lds(const float (&v)[16], float* sf, int tid) {
    const int nl = tid & 63, kb = tid >> 6;
#pragma unroll
    for (int i = 0; i < 16; ++i) sf[(i * 8 + kb) * 65 + nl] = v[i];
}
__device__ __forceinline__ void tr_store(const TrTile& t, const float* sf, int tid) {
    const int nl2 = tid >> 3;
#pragma unroll
    for (int hk = 0; hk < 2; ++hk) { const int kc = (tid & 7) * 8 + hk * 64;
        u32x4 w;
        w.x = pk2(sf[(kc + 0) * 65 + nl2], sf[(kc + 1) * 65 + nl2]); w.y = pk2(sf[(kc + 2) * 65 + nl2], sf[(kc + 3) * 65 + nl2]);
        w.z = pk2(sf[(kc + 4) * 65 + nl2], sf[(kc + 5) * 65 + nl2]); w.w = pk2(sf[(kc + 6) * 65 + nl2], sf[(kc + 7) * 65 + nl2]);
        *(u32x4*)(t.dst + (size_t)(t.n0 + nl2) * t.K + t.k0 + kc) = w; }
}
__device__ __forceinline__ TrTile tr_tile(const Params& p, int t) {
    constexpr int T_IN = (NPAD / 64) * 16, T_OUT = 32 * 32;
    const int l = t / (T_IN + T_OUT), r = t % (T_IN + T_OUT);
    TrTile o;
    if (r < T_IN) { o.src = p.w_in + (size_t)l * 2048 * NIN; o.dst = p.wt_in + (size_t)l * (SZ_WL / 2); o.Nsrc = NIN; o.K = 2048; o.n0 = (r >> 4) * 64; o.k0 = (r & 15) * 128; o.perm = 1; }
    else { const int r2 = r - T_IN; o.src = p.w_out + (size_t)l * 4096 * 2048; o.dst = p.wt_out + (size_t)l * (SZ_WL / 2); o.Nsrc = 2048; o.K = 4096; o.n0 = (r2 >> 5) * 64; o.k0 = (r2 & 31) * 128; o.perm = 0; }
    return o;
}

__device__ void weight_tiles(const Params& p, float* sf, int l) {
    constexpr int T_L = (NPAD / 64) * 16 + 32 * 32;
    const int tid = TIDX, gd = GDIM;
    const int t_end = (l + 1) * T_L;
    int t = l * T_L + BIDX;
    float v[16];
    __syncthreads();
    if (t < t_end) { const TrTile c0 = tr_tile(p, t); tr_load(c0, v, tid); }
    while (t < t_end) {
        tr_to_lds(v, sf, tid);
        __syncthreads();
        const int tn = t + gd;
        if (tn < t_end) { const TrTile nxt = tr_tile(p, tn); tr_load(nxt, v, tid); }
        { const TrTile cur = tr_tile(p, t); tr_store(cur, sf, tid); }
        __syncthreads();
        t = tn;
    }
}

__device__ void phase_a(const Params& p, unsigned char* lds) {
    float* sf = (float*)lds;
    const int tid = TIDX;
    if (BIDX < 192) {
        for (int i = tid; i < 3 * 2048; i += 512) { const int r = i >> 11, k = i & 2047; const float v = r < 2 ? p.c[r * 2048 + k] : p.c_ctx[k]; sf[i] = siluf(v); }
        __syncthreads();
    }
    for (int t = BIDX; t < 192; t += GDIM) {
        const int l = t / 96, cb = t % 96; const int col = cb * 64 + (tid & 63); const int kg = tid >> 6;
        const float* w = p.w_ada + (size_t)l * 2048 * 6144 + col;
        float a0 = 0.f, a1 = 0.f, a2 = 0.f;
#pragma unroll 8
        for (int k = kg * 256; k < kg * 256 + 256; ++k) { const float wv = w[(size_t)k * 6144]; a0 += sf[k] * wv; a1 += sf[2048 + k] * wv; a2 += sf[4096 + k] * wv; }
        float* red = sf + 6144;
        red[(kg * 3 + 0) * 64 + (tid & 63)] = a0; red[(kg * 3 + 1) * 64 + (tid & 63)] = a1; red[(kg * 3 + 2) * 64 + (tid & 63)] = a2;
        __syncthreads();
        if (tid < 192) { const int r = tid >> 6, cc = tid & 63; float s = 0.f;
#pragma unroll
            for (int g = 0; g < 8; ++g) s += red[(g * 3 + r) * 64 + cc];
            const int col2 = cb * 64 + cc; p.MOD[(size_t)(l * 3 + r) * 6144 + col2] = s + p.b_ada[l * 6144 + col2]; }
        __syncthreads();
    }
    __syncthreads();
    weight_tiles(p, sf, 0);
}

__device__ __forceinline__ void row_stats(const f32x4 (&v)[8], float& mean, float& rstd) {
    float s = 0.f;
#pragma unroll
    for (int i = 0; i < 8; ++i) s += v[i][0] + v[i][1] + v[i][2] + v[i][3];
    mean = wsum(s) * (1.f / 2048.f);
    float q = 0.f;
#pragma unroll
    for (int i = 0; i < 8; ++i) { const f32x4 d = v[i] - mean; q += d[0] * d[0] + d[1] * d[1] + d[2] * d[2] + d[3] * d[3]; }
    rstd = rsqrtf(wsum(q) * (1.f / 2048.f) + LN_EPS);
}
__device__ void phase_ln(const Params& p, int l) {
    const int wid = TIDX >> 6, lane = TIDX & 63;
    const int nw = GDIM * 8;
    const bool fin = (l == DEPTH);
    for (int row = BIDX * 8 + wid; row < MROWS; row += nw) {
        const bool isctx = row < CTXROWS;
        if (fin && isctx) continue;
        const int b = isctx ? (row >> 8) : ((row - CTXROWS) >> 13);
        float* rw = isctx ? p.RC + (size_t)row * D : p.out + (size_t)(row - CTXROWS) * D;
        const float* src = (l == 0) ? (isctx ? p.ctx + (size_t)row * D : p.x + (size_t)(row - CTXROWS) * D) : rw;
        f32x4 v[8];
#pragma unroll
        for (int i = 0; i < 8; ++i) v[i] = *(const f32x4*)(src + i * 256 + lane * 4);
        float mean, rstd;
        if (l > 0) {
            row_stats(v, mean, rstd);
            const float* g = p.ln_g + (size_t)(l - 1) * D; const float* bb = p.ln_b + (size_t)(l - 1) * D;
#pragma unroll
            for (int i = 0; i < 8; ++i) { const f32x4 gv = *(const f32x4*)(g + i * 256 + lane * 4), bv = *(const f32x4*)(bb + i * 256 + lane * 4);
                v[i] = (v[i] - mean) * rstd * gv + bv; *(f32x4*)(rw + i * 256 + lane * 4) = v[i]; }
        }
        if (fin) continue;
        row_stats(v, mean, rstd);
        const float* md = p.MOD + (size_t)(l * 3 + (isctx ? 2 : b)) * 6144;
        u16* ur = p.U + (size_t)row * 2048;
#pragma unroll
        for (int i = 0; i < 8; ++i) { const f32x4 sh = *(const f32x4*)(md + i * 256 + lane * 4), sc = *(const f32x4*)(md + 2048 + i * 256 + lane * 4);
            const f32x4 o = (v[i] - mean) * rstd * (sc + 1.f) + sh;
            u32x2 w; w.x = pk2(o[0], o[1]); w.y = pk2(o[2], o[3]);
            *(u32x2*)(ur + i * 256 + lane * 4) = w; }
    }
}

template <bool ISM> __device__ __forceinline__ int scan_row(int b, int dir, int cc, int i) {
    const bool isctx = cc < 2; const int p0 = isctx ? cc * 128 : (cc - 2) * 128; const int slen = isctx ? 256 : 8192; const int rowbase = isctx ? b * 256 : CTXROWS + b * 8192;
    const int s = dir ? slen - 1 - (p0 + i) : p0 + i;
    return rowbase + ((ISM || isctx) ? s : ((s & 127) * 64 + (s >> 7)));
}

__device__ void phase_conv(const Params& p, int l) {
    const int tid = TIDX;
    {
        const int wv = tid >> 6, lane = tid & 63;
        const int nwv = GDIM * 8;
        for (int task = BIDX * 8 + wv; task < 2 * 2 * 66 * 40; task += nwv) {
            const int hd = task % 40; int r = task / 40; const int cc = r % 66; r /= 66; const int dir = r & 1, b = r >> 1;
            if (hd < 8) {
                const int h = hd; const int row0 = scan_row<true>(b, dir, cc, 2 * lane), row1 = scan_row<true>(b, dir, cc, 2 * lane + 1);
                const float gbi = p.gate_b[l * 32 + (dir * 2) * 8 + h], gbf = p.gate_b[l * 32 + (dir * 2 + 1) * 8 + h];
                const float li0 = p.GD[(size_t)row0 * GDW + (dir * 2) * 8 + h] + gbi, li1 = p.GD[(size_t)row1 * GDW + (dir * 2) * 8 + h] + gbi;
                const float x0 = p.GD[(size_t)row0 * GDW + (dir * 2 + 1) * 8 + h] + gbf, x1 = p.GD[(size_t)row1 * GDW + (dir * 2 + 1) * 8 + h] + gbf;
                const float lf0 = fminf(x0, 0.f) - __logf(1.f + __expf(-fabsf(x0))), lf1 = fminf(x1, 0.f) - __logf(1.f + __expf(-fabsf(x1)));
                const float a1 = lf0 + lf1;
                const float inc = scan_add(a1, lane); const float exc = inc - a1;
                const float b0 = exc + lf0, b1 = exc + a1;
                const float u0 = li0 - b0, u1 = li1 - b1;
                const float incm = scan_max(fmaxf(u0, u1), lane); float excm = __shfl_up(incm, 1, 64); if (lane == 0) excm = -3.0e38f;
                const float M0 = fmaxf(excm, u0), M1 = fmaxf(M0, u1);
                float* o0 = p.G2 + (size_t)row0 * G2W + (dir * 8 + h) * 3; float* o1 = p.G2 + (size_t)row1 * G2W + (dir * 8 + h) * 3;
                o0[0] = b0; o0[1] = u0; o0[2] = M0; o1[0] = b1; o1[1] = u1; o1[2] = M1;
            } else {
                const int hh = hd - 8; const int row0 = scan_row<false>(b, dir, cc, 2 * lane), row1 = scan_row<false>(b, dir, cc, 2 * lane + 1);
                const float dtb = p.dt_bias[(l * 2 + dir) * 32 + hh]; const float Ah = -__expf(p.a_log[(l * 2 + dir) * 32 + hh]);
                const float r0 = p.GD[(size_t)row0 * GDW + 32 + dir * 32 + hh] + dtb, r1 = p.GD[(size_t)row1 * GDW + 32 + dir * 32 + hh] + dtb;
                const float dt0 = fmaxf(r0, 0.f) + __logf(1.f + __expf(-fabsf(r0))), dt1 = fmaxf(r1, 0.f) + __logf(1.f + __expf(-fabsf(r1)));
                const float d0 = dt0 * Ah, d1 = dt1 * Ah;
                const float a1 = d0 + d1;
                const float inc = scan_add(a1, lane); const float exc = inc - a1;
                float* o0 = p.G2 + (size_t)row0 * G2W + 48 + (dir * 32 + hh) * 2; float* o1 = p.G2 + (size_t)row1 * G2W + 48 + (dir * 32 + hh) * 2;
                o0[0] = dt0; o0[1] = exc + d0; o1[0] = dt1; o1[1] = exc + a1;
            }
        }
    }
    const int ci = tid & 127, rs = tid >> 7;
    for (int t = BIDX; t < 528 * 5; t += GDIM) {
        const int cgp = t % 5, rg = t / 5;
        int pcol, ocol, wstride; const float *w, *bias; bool isx; float scale = 1.f;
        if (cgp < 2) { const int c = (cgp * 128 + ci) * 8; pcol = c; ocol = c; w = p.conv_qk_w + (size_t)l * 3 * 2048 + c; bias = p.conv_qk_b + (size_t)l * 2048 + c; wstride = 2048; isx = false;
            if (c < 1024) scale = 0.08838834764831845f; }
        else { const int c = ((cgp - 2) * 128 + ci) * 8; pcol = 8192 + c; ocol = 2048 + c; w = p.conv_xbc_w + (size_t)l * 3 * 3072 + c; bias = p.conv_xbc_b + (size_t)l * 3072 + c; wstride = 3072; isx = true; }
        float w0[8], w1[8], w2[8], bb[8];
#pragma unroll
        for (int e = 0; e < 8; ++e) { w0[e] = w[e]; w1[e] = w[wstride + e]; w2[e] = w[2 * wstride + e]; bb[e] = bias[e]; }
        const int r0 = rg * 32 + rs * 8;
        const bool lat = r0 >= CTXROWS;
        const int seqbase = lat ? (CTXROWS + (((r0 - CTXROWS) >> 13) << 13)) : (r0 & ~255);
        const int seqlen = lat ? 8192 : 256;
        const int sp0 = r0 - seqbase;
        const bool cm = lat && isx;
        u32x4 win[10];
#pragma unroll
        for (int i = 0; i < 10; ++i) { const int sp = sp0 - 1 + i;
            const int row = seqbase + (cm ? ((sp & 127) * 64 + (sp >> 7)) : sp);
            win[i] = (sp >= 0 && sp < seqlen) ? *(const u32x4*)(p.P + (size_t)row * PW + pcol) : (u32x4){0u, 0u, 0u, 0u}; }
#pragma unroll
        for (int i = 0; i < 8; ++i) { const int sp = sp0 + i;
            const int row = seqbase + (cm ? ((sp & 127) * 64 + (sp >> 7)) : sp);
            const u32x4 ap = win[i], a = win[i + 1], an = win[i + 2];
            u32x4 o;
#pragma unroll
            for (int e2 = 0; e2 < 4; ++e2) {
                const float y0 = w0[2 * e2] * bflo(ap[e2]) + w1[2 * e2] * bflo(a[e2]) + w2[2 * e2] * bflo(an[e2]) + bb[2 * e2];
                const float y1 = w0[2 * e2 + 1] * bfhi(ap[e2]) + w1[2 * e2 + 1] * bfhi(a[e2]) + w2[2 * e2 + 1] * bfhi(an[e2]) + bb[2 * e2 + 1];
                o[e2] = pk2(siluf(y0) * scale, siluf(y1) * scale);
            }
            *(u32x4*)(p.QKX + (size_t)row * QW + ocol) = o;
        }
    }
}

constexpr int LDK = 136, LDV = 88;
constexpr int LS_K = 0, LS_V = 34816, LS_VW = LS_V + 128 * LDV * 2, LS_CT = LS_VW + 128 * LDV * 2, LS_F = LS_CT + 80 * LDK * 2;

#define LDS_BAR() do { asm volatile("s_waitcnt lgkmcnt(0)" ::: "memory"); __builtin_amdgcn_s_barrier(); asm volatile("" ::: "memory"); } while (0)
#define TR_RD8(r0, r1, r2, r3, r4, r5, r6, r7, base, o0, o1, o2, o3, o4, o5, o6, o7) \
    asm volatile("ds_read_b64_tr_b16 %0, %8 offset:%9\n\tds_read_b64_tr_b16 %1, %8 offset:%10\n\tds_read_b64_tr_b16 %2, %8 offset:%11\n\tds_read_b64_tr_b16 %3, %8 offset:%12\n\t" \
                 "ds_read_b64_tr_b16 %4, %8 offset:%13\n\tds_read_b64_tr_b16 %5, %8 offset:%14\n\tds_read_b64_tr_b16 %6, %8 offset:%15\n\tds_read_b64_tr_b16 %7, %8 offset:%16\n\ts_waitcnt lgkmcnt(0)" \
                 : "=&v"(r0), "=&v"(r1), "=&v"(r2), "=&v"(r3), "=&v"(r4), "=&v"(r5), "=&v"(r6), "=&v"(r7) \
                 : "v"(base), "n"(o0), "n"(o1), "n"(o2), "n"(o3), "n"(o4), "n"(o5), "n"(o6), "n"(o7) : "memory")
#define TR_RD2(r0, r1, base, o0, o1) \
    asm volatile("ds_read_b64_tr_b16 %0, %2 offset:%3\n\tds_read_b64_tr_b16 %1, %2 offset:%4\n\ts_waitcnt lgkmcnt(0)" : "=&v"(r0), "=&v"(r1) : "v"(base), "n"(o0), "n"(o1) : "memory")
#define TR_ST10(K0_, K1_, A0_, A1_, A2_, A3_, A4_, A5_, A6_, A7_, BK_, BV_, OK0_, OK1_, OV0_, OV1_, OV2_, OV3_, OV4_, OV5_, OV6_, OV7_) \
    asm volatile("ds_read_b64_tr_b16 %[rk0], %[bk] offset:%[ok0]\n\tds_read_b64_tr_b16 %[rk1], %[bk] offset:%[ok1]\n\t" \
                 "ds_read_b64_tr_b16 %[ra0], %[bv] offset:%[ov0]\n\tds_read_b64_tr_b16 %[ra1], %[bv] offset:%[ov1]\n\tds_read_b64_tr_b16 %[ra2], %[bv] offset:%[ov2]\n\tds_read_b64_tr_b16 %[ra3], %[bv] offset:%[ov3]\n\t" \
                 "ds_read_b64_tr_b16 %[ra4], %[bv] offset:%[ov4]\n\tds_read_b64_tr_b16 %[ra5], %[bv] offset:%[ov5]\n\tds_read_b64_tr_b16 %[ra6], %[bv] offset:%[ov6]\n\tds_read_b64_tr_b16 %[ra7], %[bv] offset:%[ov7]\n\ts_waitcnt lgkmcnt(0)" \
                 : [rk0] "=&v"(K0_), [rk1] "=&v"(K1_), [ra0] "=&v"(A0_), [ra1] "=&v"(A1_), [ra2] "=&v"(A2_), [ra3] "=&v"(A3_), [ra4] "=&v"(A4_), [ra5] "=&v"(A5_), [ra6] "=&v"(A6_), [ra7] "=&v"(A7_) \
                 : [bk] "v"(BK_), [bv] "v"(BV_), [ok0] "n"(OK0_), [ok1] "n"(OK1_), [ov0] "n"(OV0_), [ov1] "n"(OV1_), [ov2] "n"(OV2_), [ov3] "n"(OV3_), [ov4] "n"(OV4_), [ov5] "n"(OV5_), [ov6] "n"(OV6_), [ov7] "n"(OV7_) : "memory")
#define TR_ST12(K0_, K1_, A0_, A1_, A2_, A3_, A4_, A5_, A6_, A7_, A8_, A9_, BK_, BV_, OK0_, OK1_, OV0_, OV1_, OV2_, OV3_, OV4_, OV5_, OV6_, OV7_, OV8_, OV9_) \
    asm volatile("ds_read_b64_tr_b16 %[rk0], %[bk] offset:%[ok0]\n\tds_read_b64_tr_b16 %[rk1], %[bk] offset:%[ok1]\n\t" \
                 "ds_read_b64_tr_b16 %[ra0], %[bv] offset:%[ov0]\n\tds_read_b64_tr_b16 %[ra1], %[bv] offset:%[ov1]\n\tds_read_b64_tr_b16 %[ra2], %[bv] offset:%[ov2]\n\tds_read_b64_tr_b16 %[ra3], %[bv] offset:%[ov3]\n\t" \
                 "ds_read_b64_tr_b16 %[ra4], %[bv] offset:%[ov4]\n\tds_read_b64_tr_b16 %[ra5], %[bv] offset:%[ov5]\n\tds_read_b64_tr_b16 %[ra6], %[bv] offset:%[ov6]\n\tds_read_b64_tr_b16 %[ra7], %[bv] offset:%[ov7]\n\t" \
                 "ds_read_b64_tr_b16 %[ra8], %[bv] offset:%[ov8]\n\tds_read_b64_tr_b16 %[ra9], %[bv] offset:%[ov9]\n\ts_waitcnt lgkmcnt(0)" \
                 : [rk0] "=&v"(K0_), [rk1] "=&v"(K1_), [ra0] "=&v"(A0_), [ra1] "=&v"(A1_), [ra2] "=&v"(A2_), [ra3] "=&v"(A3_), [ra4] "=&v"(A4_), [ra5] "=&v"(A5_), [ra6] "=&v"(A6_), [ra7] "=&v"(A7_), [ra8] "=&v"(A8_), [ra9] "=&v"(A9_) \
                 : [bk] "v"(BK_), [bv] "v"(BV_), [ok0] "n"(OK0_), [ok1] "n"(OK1_), [ov0] "n"(OV0_), [ov1] "n"(OV1_), [ov2] "n"(OV2_), [ov3] "n"(OV3_), [ov4] "n"(OV4_), [ov5] "n"(OV5_), [ov6] "n"(OV6_), [ov7] "n"(OV7_), [ov8] "n"(OV8_), [ov9] "n"(OV9_) : "memory")
__device__ __forceinline__ bf16x8 mkfrag(u32x2 lo, u32x2 hi) { const u32x4 w = {lo.x, lo.y, hi.x, hi.y}; return __builtin_bit_cast(bf16x8, w); }

template <bool ISM>
__device__ void scan_item(const Params& p, int l, int item, unsigned char* lds) {
    constexpr int NT = ISM ? 5 : 4;
    constexpr float L2E = 1.4426950408889634f;
    const int tid = TIDX, wid = __builtin_amdgcn_readfirstlane(tid >> 6), lane = tid & 63, fr = lane & 15, fq = lane >> 4;
    const int trq = fr >> 2, trp = fr & 3;
    const int sl = ISM ? (item & 3) : 0, dir = ISM ? ((item >> 2) & 1) : (item & 1), h = ISM ? ((item >> 3) & 7) : ((item >> 1) & 31), b = item >> 6;
    const int qcol = ISM ? h * 128 : 2048 + 2560 + (h >> 3) * 128;
    const int kcol = ISM ? 1024 + h * 128 : 2048 + 2048 + (h >> 3) * 128;
    const int vcol = ISM ? 2048 + h * 256 + sl * 64 : 2048 + h * 64;
    const int ocol = ISM ? h * 256 + sl * 64 : h * 64;
    u16* const obase = dir ? (ISM ? p.HB : p.YB) : (ISM ? p.P : p.P + 8192);
    const unsigned ostride = dir ? 2048u : (unsigned)PW;
    u16* Ks = (u16*)(lds + LS_K); u16* Vs = (u16*)(lds + LS_V); u16* Vw = (u16*)(lds + LS_VW); u16* CT = (u16*)(lds + LS_CT);
    float* F = (float*)(lds + LS_F);
    float *f_c = F, *f_r = F + 128, *f_wi = F + 256, *f_ws = F + 384, *f_em = F + 512;
    const unsigned ldsb = (unsigned)(size_t)(LAS unsigned char*)lds;
    const unsigned trK = ldsb + LS_K + (unsigned)(((fq * 8 + trq) * LDK + 16 * wid + 4 * trp) * 2);
    const unsigned trVw = ldsb + LS_VW + (unsigned)(((fq * 8 + trq) * LDV + 4 * trp) * 2);
    const unsigned trV = ldsb + LS_V + (unsigned)(((fq * 4 + trq) * LDV + 4 * trp) * 2);
    const float Dh = ISM ? 0.f : p.d_skip[l * 32 + h];
    const u16* __restrict__ gQKX = p.QKX; const u16* __restrict__ gP = p.P; const float* __restrict__ gG2 = p.G2;
    const int gcol = ISM ? (dir * 8 + h) * 3 : 48 + (dir * 32 + h) * 2;
    __syncthreads();
    for (int i = tid; i < 128 * 24; i += 512) { const int r = i / 24, cc = 64 + i % 24; Vs[r * LDV + cc] = (ISM && cc == 64) ? (u16)0x3F80 : (u16)0; Vw[r * LDV + cc] = 0; }
    for (int i = tid; i < 80 * LDK; i += 512) CT[i] = 0;
    f32x4 st[NT];
#pragma unroll
    for (int m = 0; m < NT; ++m) st[m] = (f32x4){0.f, 0.f, 0.f, 0.f};
    float m_prev = 0.f;
    unsigned qo, ko[4], vo[2], go, ge, oo[4];
    bf16x8 qf[4]; u32x4 kr[4]; u32x4 vr[2]; f32x3 gv = {0.f, 0.f, 0.f}; float e0 = 0.f, e1 = 0.f;
#define SCAN_PTRS(cc) do { \
        qo = (unsigned)scan_row<ISM>(b, dir, (cc), 16 * wid + fr) * (unsigned)QW + (unsigned)(qcol + fq * 8); \
        _Pragma("unroll") for (int r_ = 0; r_ < 4; ++r_) { const int idx_ = r_ * 512 + tid; ko[r_] = (unsigned)scan_row<ISM>(b, dir, (cc), idx_ >> 4) * (unsigned)QW + (unsigned)(kcol + (idx_ & 15) * 8); } \
        _Pragma("unroll") for (int r_ = 0; r_ < 2; ++r_) { const int idx_ = r_ * 512 + tid; vo[r_] = (unsigned)scan_row<ISM>(b, dir, (cc), idx_ >> 3) * (unsigned)(ISM ? PW : QW) + (unsigned)(vcol + (idx_ & 7) * 8); } \
        go = (unsigned)scan_row<ISM>(b, dir, (cc), tid & 127) * (unsigned)G2W + (unsigned)gcol; ge = (unsigned)scan_row<ISM>(b, dir, (cc), 127) * (unsigned)G2W + (unsigned)gcol; \
        _Pragma("unroll") for (int j_ = 0; j_ < 4; ++j_) oo[j_] = (unsigned)scan_row<ISM>(b, dir, (cc), 16 * wid + fq * 4 + j_) * ostride + (unsigned)(ocol + fr); \
    } while (0)
#define SCAN_ADV(dr) do { const unsigned dq_ = (unsigned)((dr) * QW), dp_ = (unsigned)((dr) * PW), dg_ = (unsigned)((dr) * G2W), do_ = (unsigned)(dr) * ostride; \
        qo += dq_; _Pragma("unroll") for (int r_ = 0; r_ < 4; ++r_) ko[r_] += dq_; vo[0] += ISM ? dp_ : dq_; vo[1] += ISM ? dp_ : dq_; go += dg_; ge += dg_; \
        _Pragma("unroll") for (int j_ = 0; j_ < 4; ++j_) oo[j_] += do_; } while (0)
#define SCAN_LOAD() do { \
        _Pragma("unroll") for (int k_ = 0; k_ < 4; ++k_) qf[k_] = *(const bf16x8*)(gQKX + (size_t)qo + k_ * 32); \
        _Pragma("unroll") for (int r_ = 0; r_ < 4; ++r_) kr[r_] = *(const u32x4*)(gQKX + (size_t)ko[r_]); \
        _Pragma("unroll") for (int r_ = 0; r_ < 2; ++r_) vr[r_] = ISM ? *(const u32x4*)(gP + (size_t)vo[r_]) : *(const u32x4*)(gQKX + (size_t)vo[r_]); \
        if (tid < 128) gv = *(const f32x3*)(gG2 + (size_t)go); \
        if (ISM) { e0 = gG2[(size_t)ge]; e1 = gG2[(size_t)ge + 2]; } else { e0 = gG2[(size_t)ge + 1]; } \
    } while (0)
    SCAN_PTRS(0); SCAN_LOAD();
    const int dr_ctx = dir ? -128 : 128, dr_lat = ISM ? dr_ctx : (dir ? -1 : 1);
    __syncthreads();
#pragma unroll 1
    for (int c = 0; c < 66; ++c) {
#pragma unroll
        for (int rep = 0; rep < 4; ++rep) { const int idx = rep * 512 + tid; *(u32x4*)(Ks + (idx >> 4) * LDK + (idx & 15) * 8) = kr[rep]; }
#pragma unroll
        for (int rep = 0; rep < 2; ++rep) { const int idx = rep * 512 + tid; *(u32x4*)(Vs + (idx >> 3) * LDV + (idx & 7) * 8) = vr[rep]; }
        float decay;
        if (ISM) {
            const float Ml = fmaxf(m_prev, e1);
            if (tid < 128) { const float M = fmaxf(m_prev, gv[2]);
                f_c[tid] = gv[1] * L2E; f_r[tid] = M * L2E; f_wi[tid] = __expf(m_prev - M); f_ws[tid] = __expf(gv[1] - Ml); f_em[tid] = __expf(-(gv[0] + M)); }
            decay = __expf(m_prev - Ml); m_prev = e0 + Ml;
        } else {
            if (tid < 128) { f_c[tid] = (__logf(gv[0]) - gv[1]) * L2E; f_r[tid] = -gv[1] * L2E; f_wi[tid] = __expf(gv[1]); f_ws[tid] = __expf(e0 - gv[1]) * gv[0]; }
            decay = __expf(e0);
        }
        bf16x8 qc[4]; unsigned od[4];
#pragma unroll
        for (int k = 0; k < 4; ++k) qc[k] = qf[k];
#pragma unroll
        for (int j = 0; j < 4; ++j) od[j] = oo[j];
        const u32x4 vc0 = vr[0], vc1 = vr[1];
        LDS_BAR();
        if (c + 1 < 66) { if (c + 1 == 2) SCAN_PTRS(2); else SCAN_ADV(c == 0 ? dr_ctx : dr_lat); SCAN_LOAD(); }
        f32x4 sacc[8];
#pragma unroll
        for (int a = 0; a < 8; ++a) sacc[a] = (f32x4){0.f, 0.f, 0.f, 0.f};
#pragma unroll
        for (int a = 0; a < 8; a += 2) {
            if (a + 1 <= wid) {
                bf16x8 kf[2][4];
#pragma unroll
                for (int h2 = 0; h2 < 2; ++h2)
#pragma unroll
                    for (int ksd = 0; ksd < 4; ++ksd) kf[h2][ksd] = *(const bf16x8*)(Ks + (16 * (a + h2) + fr) * LDK + ksd * 32 + fq * 8);
#pragma unroll
                for (int ksd = 0; ksd < 4; ++ksd) { sacc[a] = __builtin_amdgcn_mfma_f32_16x16x32_bf16(kf[0][ksd], qc[ksd], sacc[a], 0, 0, 0);
                    sacc[a + 1] = __builtin_amdgcn_mfma_f32_16x16x32_bf16(kf[1][ksd], qc[ksd], sacc[a + 1], 0, 0, 0); }
            } else if (a <= wid) {
                bf16x8 kf[4];
#pragma unroll
                for (int ksd = 0; ksd < 4; ++ksd) kf[ksd] = *(const bf16x8*)(Ks + (16 * a + fr) * LDK + ksd * 32 + fq * 8);
#pragma unroll
                for (int ksd = 0; ksd < 4; ++ksd) sacc[a] = __builtin_amdgcn_mfma_f32_16x16x32_bf16(kf[ksd], qc[ksd], sacc[a], 0, 0, 0);
            }
        }
        bf16x8 sf[4]; float dsum = 0.f;
        { const float rt = f_r[16 * wid + fr];
          f32x4 cva[8];
#pragma unroll
          for (int a = 0; a < 8; ++a) cva[a] = *(const f32x4*)(f_c + 16 * a + fq * 4);
#pragma unroll
          for (int ks = 0; ks < 4; ++ks) { u32x4 w;
#pragma unroll
              for (int hf = 0; hf < 2; ++hf) { const int a = 2 * ks + hf; float v[4];
                  if (a < wid) { const f32x4 cv = cva[a];
#pragma unroll
                      for (int j = 0; j < 4; ++j) { v[j] = sacc[a][j] * __builtin_amdgcn_exp2f(cv[j] - rt); dsum += v[j]; }
                  } else if (a == wid) { const f32x4 cv = cva[a];
#pragma unroll
                      for (int j = 0; j < 4; ++j) { const float e = sacc[a][j] * __builtin_amdgcn_exp2f(cv[j] - rt); v[j] = (fq * 4 + j <= fr) ? e : 0.f; dsum += v[j]; }
                  } else { v[0] = 0.f; v[1] = 0.f; v[2] = 0.f; v[3] = 0.f; }
                  w[hf * 2] = pk2(v[0], v[1]); w[hf * 2 + 1] = pk2(v[2], v[3]); }
              sf[ks] = __builtin_bit_cast(bf16x8, w); } }
        dsum += __shfl_xor(dsum, 16, 64); dsum += __shfl_xor(dsum, 32, 64);
        {
#pragma unroll
          for (int rep = 0; rep < 2; ++rep) { const int idx = rep * 512 + tid; const int i = idx >> 3; const float wv = f_ws[i]; const u32x4 vc = rep ? vc1 : vc0; u32x4 o;
#pragma unroll
              for (int e = 0; e < 4; ++e) o[e] = pk2(bflo(vc[e]) * wv, bfhi(vc[e]) * wv);
              *(u32x4*)(Vw + i * LDV + (idx & 7) * 8) = o; }
          if (ISM && tid < 128) Vw[tid * LDV + 64] = f2bf(f_ws[tid]); }
        { f32x4 ia[NT], ib[4];
#pragma unroll
          for (int n = 0; n < NT; ++n) ia[n] = (f32x4){0.f, 0.f, 0.f, 0.f};
#pragma unroll
          for (int n = 0; n < 4; ++n) ib[n] = (f32x4){0.f, 0.f, 0.f, 0.f};
#pragma unroll
          for (int ksd = 0; ksd < 4; ++ksd) { bf16x8 bfr[NT];
#pragma unroll
              for (int n = 0; n < NT; ++n) bfr[n] = *(const bf16x8*)(CT + (n * 16 + fr) * LDK + ksd * 32 + fq * 8);
#pragma unroll
              for (int n = 0; n < NT; ++n) ia[n] = __builtin_amdgcn_mfma_f32_16x16x32_bf16(qc[ksd], bfr[n], ia[n], 0, 0, 0); }
#define SCAN_IB(ks) if (2 * (ks) <= wid) { u32x2 r0, r1, r2, r3, r4, r5, r6, r7; \
              TR_RD8(r0, r1, r2, r3, r4, r5, r6, r7, trV, (ks) * 32 * LDV * 2, (ks) * 32 * LDV * 2 + 16 * LDV * 2, (ks) * 32 * LDV * 2 + 32, (ks) * 32 * LDV * 2 + 16 * LDV * 2 + 32, \
                     (ks) * 32 * LDV * 2 + 64, (ks) * 32 * LDV * 2 + 16 * LDV * 2 + 64, (ks) * 32 * LDV * 2 + 96, (ks) * 32 * LDV * 2 + 16 * LDV * 2 + 96); \
              ib[0] = __builtin_amdgcn_mfma_f32_16x16x32_bf16(sf[ks], mkfrag(r0, r1), ib[0], 0, 0, 0); ib[1] = __builtin_amdgcn_mfma_f32_16x16x32_bf16(sf[ks], mkfrag(r2, r3), ib[1], 0, 0, 0); \
              ib[2] = __builtin_amdgcn_mfma_f32_16x16x32_bf16(sf[ks], mkfrag(r4, r5), ib[2], 0, 0, 0); ib[3] = __builtin_amdgcn_mfma_f32_16x16x32_bf16(sf[ks], mkfrag(r6, r7), ib[3], 0, 0, 0); }
          SCAN_IB(0) SCAN_IB(1) SCAN_IB(2) SCAN_IB(3)
#undef SCAN_IB
#pragma unroll
          for (int j = 0; j < 4; ++j) { const int tl = fq * 4 + j, t = 16 * wid + tl; const float wi = f_wi[t];
              float inv = 1.f;
              if (ISM) { const float qn = __shfl(ia[NT - 1][j], lane & 48, 64); const float dn = __shfl(dsum, tl, 64); inv = __builtin_amdgcn_rcpf(fmaxf(fabsf(wi * qn + dn), f_em[t])); }
              u16* dst = obase + (size_t)od[j];
              float v[4];
#pragma unroll
              for (int n = 0; n < 4; ++n) { v[n] = (wi * ia[n][j] + ib[n][j]) * inv; if (!ISM && dir == 0) v[n] += Dh * bf2f(Vs[t * LDV + n * 16 + fr]); }
              const unsigned p01 = pk2(v[0], v[1]), p23 = pk2(v[2], v[3]);
              dst[0] = (u16)(p01 & 0xFFFFu); dst[16] = (u16)(p01 >> 16); dst[32] = (u16)(p23 & 0xFFFFu); dst[48] = (u16)(p23 >> 16); } }
        LDS_BAR();
        {
#pragma unroll
          for (int m = 0; m < NT; ++m) st[m] *= decay;
#define SCAN_ST(ks) { u32x2 k0, k1, a0, a1, a2, a3, a4, a5, a6, a7, a8, a9; \
              if (ISM) TR_ST12(k0, k1, a0, a1, a2, a3, a4, a5, a6, a7, a8, a9, trK, trVw, (ks) * 32 * LDK * 2, (ks) * 32 * LDK * 2 + 4 * LDK * 2, \
                     (ks) * 32 * LDV * 2, (ks) * 32 * LDV * 2 + 4 * LDV * 2, (ks) * 32 * LDV * 2 + 32, (ks) * 32 * LDV * 2 + 4 * LDV * 2 + 32, \
                     (ks) * 32 * LDV * 2 + 64, (ks) * 32 * LDV * 2 + 4 * LDV * 2 + 64, (ks) * 32 * LDV * 2 + 96, (ks) * 32 * LDV * 2 + 4 * LDV * 2 + 96, \
                     (ks) * 32 * LDV * 2 + 128, (ks) * 32 * LDV * 2 + 4 * LDV * 2 + 128); \
              else TR_ST10(k0, k1, a0, a1, a2, a3, a4, a5, a6, a7, trK, trVw, (ks) * 32 * LDK * 2, (ks) * 32 * LDK * 2 + 4 * LDK * 2, \
                     (ks) * 32 * LDV * 2, (ks) * 32 * LDV * 2 + 4 * LDV * 2, (ks) * 32 * LDV * 2 + 32, (ks) * 32 * LDV * 2 + 4 * LDV * 2 + 32, \
                     (ks) * 32 * LDV * 2 + 64, (ks) * 32 * LDV * 2 + 4 * LDV * 2 + 64, (ks) * 32 * LDV * 2 + 96, (ks) * 32 * LDV * 2 + 4 * LDV * 2 + 96); \
              const bf16x8 kfr = mkfrag(k0, k1); \
              st[0] = __builtin_amdgcn_mfma_f32_16x16x32_bf16(mkfrag(a0, a1), kfr, st[0], 0, 0, 0); st[1] = __builtin_amdgcn_mfma_f32_16x16x32_bf16(mkfrag(a2, a3), kfr, st[1], 0, 0, 0); \
              st[2] = __builtin_amdgcn_mfma_f32_16x16x32_bf16(mkfrag(a4, a5), kfr, st[2], 0, 0, 0); st[3] = __builtin_amdgcn_mfma_f32_16x16x32_bf16(mkfrag(a6, a7), kfr, st[3], 0, 0, 0); \
              if (ISM) st[NT - 1] = __builtin_amdgcn_mfma_f32_16x16x32_bf16(mkfrag(a8, a9), kfr, st[NT - 1], 0, 0, 0); }
          SCAN_ST(0) SCAN_ST(1) SCAN_ST(2) SCAN_ST(3)
#undef SCAN_ST
#pragma unroll
          for (int m = 0; m < NT; ++m) { const unsigned p01 = pk2(st[m][0], st[m][1]), p23 = pk2(st[m][2], st[m][3]);
              u16* cp = CT + (m * 16 + fq * 4) * LDK + 16 * wid + fr;
              cp[0] = (u16)(p01 & 0xFFFFu); cp[LDK] = (u16)(p01 >> 16); cp[2 * LDK] = (u16)(p23 & 0xFFFFu); cp[3 * LDK] = (u16)(p23 >> 16); } }
        LDS_BAR();
    }
#undef SCAN_LOAD
#undef SCAN_ADV
#undef SCAN_PTRS
}

__device__ void phase_scan(const Params& p, int l, unsigned char* lds) {
    for (int blk = BIDX; blk < 256; blk += GDIM) {
        const int xcd = blk & 7, j = blk >> 3;
        if (j < 16) scan_item<true>(p, l, (xcd + 8 * (j >> 2)) * 4 + (j & 3), lds);
        else { const int G = xcd + 8 * ((j - 16) >> 3), r = (j - 16) & 7; const int dir = G & 1, g = (G >> 1) & 3, b = G >> 3;
            scan_item<false>(p, l, dir + 2 * (g * 8 + r) + 64 * b, lds); }
    }
}

__device__ void phase_post(const Params& p, int l) {
    const int wid = TIDX >> 6, lane = TIDX & 63;
    const int nw = GDIM * 8;
    const int c0 = lane * 32;
    for (int row = BIDX * 8 + wid; row < MROWS; row += nw) {
        u16* pr = p.P + (size_t)row * PW;
        {
            float tv[32]; float ss = 0.f;
#pragma unroll
            for (int q = 0; q < 4; ++q) { const u32x4 yv = *(const u32x4*)(pr + 8192 + c0 + q * 8), zv = *(const u32x4*)(pr + 11264 + c0 + q * 8), yb = *(const u32x4*)(p.YB + (size_t)row * 2048 + c0 + q * 8);
#pragma unroll
                for (int e = 0; e < 4; ++e) { const float t0 = (bflo(yv[e]) + bflo(yb[e])) * siluf(bflo(zv[e])), t1 = (bfhi(yv[e]) + bfhi(yb[e])) * siluf(bfhi(zv[e]));
                    tv[q * 8 + 2 * e] = t0; tv[q * 8 + 2 * e + 1] = t1; ss += t0 * t0 + t1 * t1; } }
            const float rstd = rsqrtf(wsum(ss) * (1.f / 2048.f) + LN_EPS);
            const float* sw = p.ssm_w + (size_t)l * 2048 + c0;
#pragma unroll
            for (int q = 0; q < 4; ++q) { const f32x4 wa = *(const f32x4*)(sw + q * 8), wb = *(const f32x4*)(sw + q * 8 + 4);
                u32x4 o; o.x = pk2(tv[q * 8] * rstd * wa[0], tv[q * 8 + 1] * rstd * wa[1]); o.y = pk2(tv[q * 8 + 2] * rstd * wa[2], tv[q * 8 + 3] * rstd * wa[3]);
                o.z = pk2(tv[q * 8 + 4] * rstd * wb[0], tv[q * 8 + 5] * rstd * wb[1]); o.w = pk2(tv[q * 8 + 6] * rstd * wb[2], tv[q * 8 + 7] * rstd * wb[3]);
                *(u32x4*)(pr + 11264 + c0 + q * 8) = o; }
        }
        {
            float hv[32]; float s = 0.f;
#pragma unroll
            for (int q = 0; q < 4; ++q) { const u32x4 a = *(const u32x4*)(pr + c0 + q * 8), ab = *(const u32x4*)(p.HB + (size_t)row * 2048 + c0 + q * 8);
#pragma unroll
                for (int e = 0; e < 4; ++e) { const float h0 = bflo(a[e]) + bflo(ab[e]), h1 = bfhi(a[e]) + bfhi(ab[e]); hv[q * 8 + 2 * e] = h0; hv[q * 8 + 2 * e + 1] = h1; s += h0 + h1; } }
            s += __shfl_xor(s, 1, 64); s += __shfl_xor(s, 2, 64); s += __shfl_xor(s, 4, 64);
            const float mean = s * (1.f / 256.f);
            float q2 = 0.f;
#pragma unroll
            for (int e = 0; e < 32; ++e) { const float d = hv[e] - mean; q2 += d * d; }
            q2 += __shfl_xor(q2, 1, 64); q2 += __shfl_xor(q2, 2, 64); q2 += __shfl_xor(q2, 4, 64);
            const float rstd = rsqrtf(q2 * (1.f / 256.f) + LN_EPS);
            const float* mw = p.mh_w + (size_t)l * 2048 + c0;
#pragma unroll
            for (int q = 0; q < 4; ++q) { const u32x4 ov = *(const u32x4*)(pr + 4096 + c0 + q * 8), zv = *(const u32x4*)(pr + 6144 + c0 + q * 8);
                const f32x4 wa = *(const f32x4*)(mw + q * 8), wb = *(const f32x4*)(mw + q * 8 + 4);
                float r[8];
#pragma unroll
                for (int e = 0; e < 4; ++e) {
                    const float m0 = (e < 2 ? wa[2 * e] : wb[2 * e - 4]), m1 = (e < 2 ? wa[2 * e + 1] : wb[2 * e - 3]);
                    r[2 * e] = sigmf(bflo(ov[e])) * ((hv[q * 8 + 2 * e] - mean) * rstd * m0) * siluf(bflo(zv[e]));
                    r[2 * e + 1] = sigmf(bfhi(ov[e])) * ((hv[q * 8 + 2 * e + 1] - mean) * rstd * m1) * siluf(bfhi(zv[e])); }
                u32x4 o; o.x = pk2(r[0], r[1]); o.y = pk2(r[2], r[3]); o.z = pk2(r[4], r[5]); o.w = pk2(r[6], r[7]);
                *(u32x4*)(pr + 9216 + c0 + q * 8) = o; }
        }
    }
}

__device__ __forceinline__ void grid_barrier(unsigned* ctr, unsigned target) {
    __syncthreads();
    if (threadIdx.x == 0) {
        __builtin_amdgcn_fence(__ATOMIC_RELEASE, "agent");
        asm volatile("s_waitcnt vmcnt(0)" ::: "memory");
        __hip_atomic_fetch_add(ctr, 1u, __ATOMIC_RELAXED, __HIP_MEMORY_SCOPE_AGENT);
        while (__hip_atomic_load(ctr, __ATOMIC_RELAXED, __HIP_MEMORY_SCOPE_AGENT) < target) __builtin_amdgcn_s_sleep(2);
        __builtin_amdgcn_fence(__ATOMIC_ACQUIRE, "agent");
        asm volatile("s_waitcnt vmcnt(0)" ::: "memory");
    }
    __syncthreads();
}
__device__ __forceinline__ void acquire_workgroup() {
    if (threadIdx.x == 0) { __builtin_amdgcn_fence(__ATOMIC_ACQUIRE, "agent"); asm volatile("s_waitcnt vmcnt(0)" ::: "memory"); }
    __syncthreads();
}

constexpr int N_PHASES = 2 + 6 * DEPTH;
__global__ __launch_bounds__(512, 2) void mega(KArgs ka, int ph_lo, int ph_hi) {
    extern __shared__ __attribute__((aligned(16))) unsigned char shm[];
    cg::grid_group grid = cg::this_grid();
#pragma unroll 1
    for (int ph = ph_lo; ph < ph_hi; ++ph) {
        if (ph == 0) {
            Params q{}; unsigned char* ws = KWS();
            q.c = KIN(1); q.c_ctx = KIN(3); q.w_ada = KIN(4); q.b_ada = KIN(5); q.w_in = KIN(6); q.w_out = KIN(17);
            q.MOD = (float*)(ws + OFF_MOD); q.wt_in = (u16*)(ws + OFF_W); q.wt_out = (u16*)(ws + OFF_W + SZ_WTIN1);
            phase_a(q, shm);
        } else {
            const int l = (ph == N_PHASES - 1) ? DEPTH : (ph - 1) / 6, k = (ph == N_PHASES - 1) ? 0 : (ph - 1) % 6;
            if (k == 0) {
                Params q{}; unsigned char* ws = KWS();
                q.x = KIN(0); q.ctx = KIN(2); q.ln_g = KIN(18); q.ln_b = KIN(19); q.out = KOUT();
                q.RC = (float*)(ws + OFF_RC); q.MOD = (float*)(ws + OFF_MOD); q.U = (u16*)(ws + OFF_U);
                phase_ln(q, l);
                if (l >= 1 && l < DEPTH) {
                    q.w_in = KIN(6); q.w_out = KIN(17); q.wt_in = (u16*)(ws + OFF_W); q.wt_out = (u16*)(ws + OFF_W + SZ_WTIN1);
                    weight_tiles(q, (float*)shm, l);
                }
            } else if (k == 1) {
                unsigned char* ws = KWS();
                pg8::Gemm g{(const u16*)(ws + OFF_U), (const u16*)(ws + OFF_W + (size_t)l * SZ_WL), MROWS, NPAD, 2048, 2048};
                pg8::StaticOrder S; S.init(MROWS, NPAD, GDIM, BIDX);
                EpiG1 E{(u16*)(ws + OFF_P), (float*)(ws + OFF_GD)};
                pg8::gemm_phase<EpiG1>((LAS unsigned char*)shm, g, S, E);
            } else if (k == 2) {
                Params q{}; unsigned char* ws = KWS();
                q.conv_qk_w = KIN(7); q.conv_qk_b = KIN(8); q.conv_xbc_w = KIN(11); q.conv_xbc_b = KIN(12); q.gate_b = KIN(9); q.dt_bias = KIN(13); q.a_log = KIN(14);
                q.P = (u16*)(ws + OFF_P); q.QKX = (u16*)(ws + OFF_QKX); q.GD = (float*)(ws + OFF_GD); q.G2 = (float*)(ws + OFF_G2);
                phase_conv(q, l);
            } else if (k == 3) {
                Params q{}; unsigned char* ws = KWS();
                q.gate_b = KIN(9); q.dt_bias = KIN(13); q.a_log = KIN(14); q.d_skip = KIN(15);
                q.P = (u16*)(ws + OFF_P); q.QKX = (u16*)(ws + OFF_QKX); q.G2 = (float*)(ws + OFF_G2);
                q.HB = (u16*)(ws + OFF_U); q.YB = (u16*)(ws + OFF_W + (size_t)((l + 1) & 1) * SZ_WL);
                phase_scan(q, l, shm);
            } else if (k == 4) {
                Params q{}; unsigned char* ws = KWS();
                q.mh_w = KIN(10); q.ssm_w = KIN(16); q.P = (u16*)(ws + OFF_P);
                q.HB = (u16*)(ws + OFF_U); q.YB = (u16*)(ws + OFF_W + (size_t)((l + 1) & 1) * SZ_WL);
                phase_post(q, l);
            } else {
                unsigned char* ws = KWS(); float* outp = KOUT();
                const float* xin = KIN(0); const float* cin = KIN(2);
                float* rc = (float*)(ws + OFF_RC);
                const int roff = (l == DEPTH - 1) ? CTXROWS : 0;
                pg8::Gemm g{(const u16*)(ws + OFF_P) + (size_t)roff * PW + 9216, (const u16*)(ws + OFF_W + (size_t)l * SZ_WL + SZ_WTIN1), MROWS - roff, 2048, 4096, PW};
                pg8::StaticOrder S; S.init(MROWS - roff, 2048, GDIM, BIDX);
                EpiG2 E{l == 0 ? xin : outp, l == 0 ? cin : rc, outp, rc, (const float*)(ws + OFF_MOD) + (size_t)l * 3 * 6144, roff};
                pg8::gemm_phase<EpiG2>((LAS unsigned char*)shm, g, S, E);
            }
        }
        if (ph + 1 < ph_hi) {
            if (ph_hi > N_PHASES) { grid.sync(); acquire_workgroup(); }
            grid_barrier((unsigned*)(KWS() + OFF_BAR), (unsigned)(ph - ph_lo + 1) * (unsigned)GDIM);
        }
    }
}

extern "C" void kernel_launch(void* const* d_in, const int* in_sizes, int n_in, void* d_out, int out_size, void* d_ws, size_t ws_size, hipStream_t stream) {
    static int grid = 0;
    if (grid == 0) {
        if (n_in != 20 || ws_size < WS_END) { fprintf(stderr, "kernel_launch: unexpected n_in %d or ws_size %zu (< %zu)\n", n_in, ws_size, (size_t)WS_END); grid = -1; return; }
        int dev = 0, cus = 0, per_cu = 0;
        hipGetDevice(&dev);
        hipDeviceGetAttribute(&cus, hipDeviceAttributeMultiprocessorCount, dev);
        if (hipFuncSetAttribute((const void*)mega, hipFuncAttributeMaxDynamicSharedMemorySize, LDS_BYTES) != hipSuccess) { fprintf(stderr, "kernel_launch: hipFuncSetAttribute failed\n"); grid = -1; return; }
        if (hipOccupancyMaxActiveBlocksPerMultiprocessor(&per_cu, (const void*)mega, 512, LDS_BYTES) != hipSuccess || per_cu < 1) { fprintf(stderr, "kernel_launch: occupancy query says %d\n", per_cu); per_cu = 1; }
        (void)hipGetLastError();
        grid = cus;
    }
    if (grid < 0) return;
    if (hipMemsetAsync((unsigned char*)d_ws + OFF_BAR, 0, 256, stream) != hipSuccess) { fprintf(stderr, "kernel_launch: memset failed\n"); return; }
    KArgs ka{};
    for (int i = 0; i < 20; ++i) ka.in[i] = (const float*)d_in[i];
    ka.out = (float*)d_out; ka.ws = (unsigned char*)d_ws;
    int lo = 0, hi = N_PHASES;
    void* args[] = {&ka, &lo, &hi};
    hipError_t e = hipLaunchCooperativeKernel((const void*)mega, dim3(grid), dim3(512), args, LDS_BYTES, stream);
    if (e != hipSuccess) fprintf(stderr, "kernel_launch: cooperative launch failed: %s (grid %d)\n", hipGetErrorString(e), grid);
}
```

```cpp
#include <hip/hip_runtime.h>
#include <hip/hip_cooperative_groups.h>
#include <cstdio>
namespace cg = cooperative_groups;

#define LAS __attribute__((address_space(3)))
typedef unsigned short u16;
typedef short bf16x8 __attribute__((ext_vector_type(8)));
typedef float f32x4 __attribute__((ext_vector_type(4)));
typedef unsigned u32x4 __attribute__((ext_vector_type(4)));
typedef unsigned u32x2 __attribute__((ext_vector_type(2)));
typedef float f32x3 __attribute__((ext_vector_type(3)));

constexpr int D = 2048, DEPTH = 2;
constexpr int CTXROWS = 512, MROWS = 16896;
constexpr int NIN = 13408, NPAD = 13568, PW = 13312, GDW = 96, QW = 5120, G2W = 176;
constexpr float LN_EPS = 1e-5f;
constexpr float ALPHA = 1.4142135623730951f;
constexpr int LDS_BYTES = 139264;

constexpr size_t SZ_WTIN1 = (size_t)NPAD * 2048 * 2, SZ_WTOUT1 = (size_t)2048 * 4096 * 2, SZ_WL = SZ_WTIN1 + SZ_WTOUT1;
constexpr size_t SZ_P = (size_t)MROWS * PW * 2, SZ_GD = (size_t)MROWS * GDW * 4, SZ_U = (size_t)MROWS * 2048 * 2;
constexpr size_t SZ_QKX = (size_t)MROWS * QW * 2, SZ_MOD = (size_t)DEPTH * 3 * 6144 * 4, SZ_RC = (size_t)CTXROWS * 2048 * 4;
constexpr size_t OFF_W = 0, OFF_P = OFF_W + DEPTH * SZ_WL, OFF_GD = OFF_P + SZ_P, OFF_U = OFF_GD + SZ_GD,
                 OFF_QKX = OFF_U + SZ_U, OFF_MOD = OFF_QKX + SZ_QKX, OFF_RC = OFF_MOD + SZ_MOD, OFF_BAR = OFF_RC + SZ_RC, OFF_G2 = OFF_BAR + 256, WS_END = OFF_G2 + (size_t)MROWS * 176 * 4 + 256;

struct Params {
    const float *x, *c, *ctx, *c_ctx, *w_ada, *b_ada, *w_in, *conv_qk_w, *conv_qk_b, *gate_b, *mh_w, *conv_xbc_w, *conv_xbc_b, *dt_bias, *a_log, *d_skip,
        *ssm_w, *w_out, *ln_g, *ln_b;
    float* out;
    u16 *wt_in, *wt_out, *P, *U, *QKX, *HB, *YB;
    float *GD, *MOD, *RC, *G2;
};
struct KArgs { const float* in[20]; float* out; unsigned char* ws; };
template <int IDX> __device__ __forceinline__ const void* kload() {
    unsigned long r;
    asm volatile("s_load_dwordx2 %0, %1, %2\n\ts_waitcnt lgkmcnt(0)" : "=s"(r) : "s"(__builtin_amdgcn_kernarg_segment_ptr()), "n"(IDX * 8) : "memory");
    return (const void*)(const __attribute__((address_space(1))) char*)r;
}
#define KIN(i) ((const float*)kload<(i)>())
#define KOUT() ((float*)kload<20>())
#define KWS() ((unsigned char*)kload<21>())

__device__ __forceinline__ int tid_() { int t = threadIdx.x; asm volatile("" : "+v"(t)); return t; }
__device__ __forceinline__ int bid_() { int b = blockIdx.x; asm volatile("" : "+s"(b)); return b; }
__device__ __forceinline__ int gdim_() { int g = gridDim.x; asm volatile("" : "+s"(g)); return g; }
#define TIDX tid_()
#define BIDX bid_()
#define GDIM gdim_()

typedef float f32x2_t __attribute__((ext_vector_type(2)));
typedef __bf16 bf16x2_t __attribute__((ext_vector_type(2)));
__device__ __forceinline__ u16 f2bf(float f) { return __builtin_bit_cast(u16, (__bf16)f); }
__device__ __forceinline__ float bf2f(unsigned h) { return __uint_as_float(h << 16); }
__device__ __forceinline__ float bflo(unsigned w) { return __uint_as_float(w << 16); }
__device__ __forceinline__ float bfhi(unsigned w) { return __uint_as_float(w & 0xFFFF0000u); }
__device__ __forceinline__ unsigned pk2(float lo, float hi) { const f32x2_t v = {lo, hi}; return __builtin_bit_cast(unsigned, __builtin_convertvector(v, bf16x2_t)); }
__device__ __forceinline__ unsigned cvt_pk_bf16(float lo, float hi) { unsigned r; asm volatile("v_cvt_pk_bf16_f32 %0, %1, %2" : "=v"(r) : "v"(lo), "v"(hi)); return r; }
__device__ __forceinline__ float wsum(float v) {
#pragma unroll
    for (int o = 32; o > 0; o >>= 1) v += __shfl_xor(v, o, 64);
    return v;
}
__device__ __forceinline__ float siluf(float v) { return v * __builtin_amdgcn_rcpf(1.f + __expf(-v)); }
__device__ __forceinline__ float sigmf(float v) { return __builtin_amdgcn_rcpf(1.f + __expf(-v)); }
__device__ __forceinline__ float scan_add(float v, int lane) {
#pragma unroll
    for (int d = 1; d < 64; d <<= 1) { float t = __shfl_up(v, d, 64); if (lane >= d) v += t; }
    return v;
}
__device__ __forceinline__ float scan_max(float v, int lane) {
#pragma unroll
    for (int d = 1; d < 64; d <<= 1) { float t = __shfl_up(v, d, 64); if (lane >= d) v = fmaxf(v, t); }
    return v;
}
__device__ __forceinline__ int src_col(int n) {
    if (n < 8192) return n;
    if (n < 11264) return n + 32;
    if (n < 13312) return n + 96;
    if (n < 13344) return n - 5120;
    if (n < 13408) return n - 2048;
    return -1;
}

namespace pg8 {
constexpr int BM = 256, BK = 64, HALF = 128, HTB = HALF * BK * 2, STAGE_BYTES = 8 * HTB, NXCD = 8, WGM = 8;
__host__ __device__ __forceinline__ int lds_byte(int r, int c) { const int st = (r >> 4) * 2 + (c >> 5), rr = r & 15, cc = c & 31, ob = rr * 64 + cc * 2; return st * 1024 + (ob ^ (((ob >> 9) & 1) << 5)); }
__host__ __device__ __forceinline__ void stage_rc(int b, int& R, int& C) { const int st = b / 1024, sb = b % 1024, swz = sb ^ (((sb >> 9) & 1) << 5); R = (st >> 1) * 16 + swz / 64; C = (st & 1) * 32 + (swz % 64) / 2; }
__host__ __device__ __forceinline__ int perm32(int rho) { const int n = rho >> 4, i = rho & 15; return 8 * (i >> 2) + 4 * n + (i & 3); }
struct Unit { int pm, pn; };
struct Gemm { const u16* A; const u16* Bt; int M, N, K, lda; };
struct StaticOrder {
    int nM, nN, nwg, G, c;
    __device__ void init(int M, int N, int G_, int c_) { nM = M / BM; nN = N / BM; nwg = nM * nN; G = G_; c = c_; }
    __device__ bool next(int i, Unit& u) const {
        const long L = (long)i * G + c; if (L >= nwg) return false;
        int wgid = (int)L; { const int q = nwg / NXCD, r = nwg % NXCD, xcd = wgid % NXCD, off = wgid / NXCD; wgid = (xcd < r ? xcd * (q + 1) : r * (q + 1) + (xcd - r) * q) + off; }
        const int nig = WGM * nN, gid = wgid / nig, fm = gid * WGM, gsz = (nM - fm) < WGM ? (nM - fm) : WGM;
        u.pm = fm + ((wgid % nig) % gsz); u.pn = (wgid % nig) / gsz; return true;
    }
};

template <class Epi>
__device__ __forceinline__ void gemm_phase(LAS unsigned char* lds, const Gemm g, const StaticOrder& S, const Epi& E) {
    const int tid = TIDX, wid = __builtin_amdgcn_readfirstlane(tid >> 6), lane = tid & 63, wr = wid >> 2, wc = wid & 3, fr = lane & 15, fq = lane >> 4;
    const int K = g.K, nt = K / BK, lda = g.lda;
    unsigned voffA[2], voffB[2];
#pragma unroll
    for (int i = 0; i < 2; ++i) { int R, C; stage_rc(tid * 16 + i * 8192, R, C); const int Rb = Epi::PERM ? ((R & ~31) + perm32(R & 31)) : R;
        voffA[i] = (unsigned)(R * lda + C) * 2u; voffB[i] = (unsigned)(Rb * K + C) * 2u; }
    const size_t kstep = (size_t)(BK * 2);
    const size_t hA = (size_t)HALF * lda * 2, hB = (size_t)HALF * K * 2;
    const size_t tA = 2 * hA, tB = 2 * hB;
    const unsigned ldsw = (unsigned)wid * 1024u;
    const int aoff = lds_byte(wr * 64 + fr, fq * 8), boff = lds_byte(wc * 32 + fr, fq * 8);
#define PG8_SA(b, h) (((b) * 2 + (h)) * HTB)
#define PG8_SB(b, h) ((4 + (b) * 2 + (h)) * HTB)
#define PG8_STAGE(bufoff, gbase, voff) do { _Pragma("unroll") for (int _i = 0; _i < 2; ++_i) \
        __builtin_amdgcn_global_load_lds((const unsigned*)((const char*)(gbase) + (voff)[_i]), (LAS unsigned*)(lds + (bufoff) + ldsw + _i * 8192), 16, 0, 0); } while (0)
#define PG8_LDA(dst, b, h) do { _Pragma("unroll") for (int m = 0; m < 4; ++m) _Pragma("unroll") for (int k = 0; k < 2; ++k) dst[m][k] = *(const LAS bf16x8*)(lds + PG8_SA(b, h) + aoff + m * 2048 + k * 1024); } while (0)
#define PG8_LDB(dst, b, h) do { _Pragma("unroll") for (int n = 0; n < 2; ++n) _Pragma("unroll") for (int k = 0; k < 2; ++k) dst[n][k] = *(const LAS bf16x8*)(lds + PG8_SB(b, h) + boff + n * 2048 + k * 1024); } while (0)
#define PG8_MMA(ai, bj, At, Bt) do { __builtin_amdgcn_s_setprio(1); _Pragma("unroll") for (int m = 0; m < 4; ++m) _Pragma("unroll") for (int n = 0; n < 2; ++n) _Pragma("unroll") for (int k = 0; k < 2; ++k) \
        acc[ai][bj][m][n] = __builtin_amdgcn_mfma_f32_16x16x32_bf16(Bt[n][k], At[m][k], acc[ai][bj][m][n], 0, 0, 0); __builtin_amdgcn_s_setprio(0); } while (0)
#define PG8_WAIT_V(n) asm volatile("s_waitcnt vmcnt(" #n ")" ::: "memory")
#define PG8_WAIT_L(n) asm volatile("s_waitcnt lgkmcnt(" #n ")" ::: "memory")
#define PG8_BAR __builtin_amdgcn_s_barrier()
#define PG8_SCHED __builtin_amdgcn_sched_barrier(0)
    Unit cur, nxt; int ui = 0;
    if (!S.next(0, cur)) return;
    f32x4 acc[2][2][4][2];
#pragma unroll
    for (int a = 0; a < 2; ++a)
#pragma unroll
        for (int b = 0; b < 2; ++b)
#pragma unroll
            for (int m = 0; m < 4; ++m)
#pragma unroll
                for (int n = 0; n < 2; ++n) acc[a][b][m][n] = (f32x4){0.f, 0.f, 0.f, 0.f};
    bf16x8 At[4][2], B0[2][2], B1[2][2];
    const char* cA = (const char*)g.A + (size_t)cur.pm * tA; const char* cB = (const char*)g.Bt + (size_t)cur.pn * tB;
    PG8_STAGE(PG8_SB(0, 0), cB, voffB); PG8_STAGE(PG8_SA(0, 0), cA, voffA); PG8_STAGE(PG8_SB(0, 1), cB + hB, voffB); PG8_STAGE(PG8_SA(0, 1), cA + hA, voffA);
    if (wr == 1) PG8_BAR;
    PG8_WAIT_V(4); PG8_BAR;
    PG8_STAGE(PG8_SB(1, 0), cB + kstep, voffB); PG8_STAGE(PG8_SA(1, 0), cA + kstep, voffA); PG8_STAGE(PG8_SB(1, 1), cB + hB + kstep, voffB);
    PG8_WAIT_V(6); PG8_BAR;
    for (;;) {
        const bool has_next = S.next(ui + 1, nxt);
        const char* nA = has_next ? (const char*)g.A + (size_t)nxt.pm * tA : cA; const char* nB = has_next ? (const char*)g.Bt + (size_t)nxt.pn * tB : cB;
        for (int t = 0; t < nt; t += 2) {
            const bool last = (t == nt - 2);
            const char* a1 = cA + (size_t)(t + 1) * kstep;
            const char* a2 = last ? nA : cA + (size_t)(t + 2) * kstep; const char* b2 = last ? nB : cB + (size_t)(t + 2) * kstep;
            const char* a3 = a2 + kstep; const char* b3 = b2 + kstep;
            PG8_LDB(B0, 0, 0); PG8_SCHED; PG8_LDA(At, 0, 0); PG8_STAGE(PG8_SA(1, 1), a1 + hA, voffA);
            PG8_WAIT_L(8); PG8_BAR; PG8_WAIT_L(0); PG8_MMA(0, 0, At, B0); PG8_BAR; PG8_SCHED;
            PG8_LDB(B1, 0, 1); PG8_STAGE(PG8_SB(0, 0), b2, voffB);
            PG8_BAR; PG8_WAIT_L(0); PG8_MMA(0, 1, At, B1); PG8_BAR;
            PG8_LDA(At, 0, 1); PG8_STAGE(PG8_SA(0, 0), a2, voffA);
            PG8_BAR; PG8_WAIT_L(0); PG8_MMA(1, 0, At, B0); PG8_BAR; PG8_SCHED;
            PG8_STAGE(PG8_SB(0, 1), b2 + hB, voffB);
            PG8_WAIT_V(6); PG8_BAR; PG8_MMA(1, 1, At, B1); PG8_BAR;
            PG8_LDB(B0, 1, 0); PG8_SCHED; PG8_LDA(At, 1, 0); PG8_STAGE(PG8_SA(0, 1), a2 + hA, voffA);
            PG8_WAIT_L(8); PG8_BAR; PG8_WAIT_L(0); PG8_MMA(0, 0, At, B0); PG8_BAR; PG8_SCHED;
            PG8_LDB(B1, 1, 1); PG8_STAGE(PG8_SB(1, 0), b3, voffB);
            PG8_BAR; PG8_WAIT_L(0); PG8_MMA(0, 1, At, B1); PG8_BAR;
            PG8_LDA(At, 1, 1); PG8_STAGE(PG8_SA(1, 0), a3, voffA);
            PG8_BAR; PG8_WAIT_L(0); PG8_MMA(1, 0, At, B0); PG8_BAR; PG8_SCHED;
            PG8_STAGE(PG8_SB(1, 1), b3 + hB, voffB);
            PG8_WAIT_V(6); PG8_BAR; PG8_MMA(1, 1, At, B1); PG8_BAR;
        }
        E(acc, cur, wr, wc, fr, fq);
        if (!has_next) break;
#pragma unroll
        for (int a = 0; a < 2; ++a)
#pragma unroll
            for (int b = 0; b < 2; ++b)
#pragma unroll
                for (int m = 0; m < 4; ++m)
#pragma unroll
                    for (int n = 0; n < 2; ++n) acc[a][b][m][n] = (f32x4){0.f, 0.f, 0.f, 0.f};
        cur = nxt; cA = nA; cB = nB; ++ui;
    }
    PG8_WAIT_V(0);
    if (wr == 0) PG8_BAR;
    PG8_BAR;
#undef PG8_SA
#undef PG8_SB
#undef PG8_STAGE
#undef PG8_LDA
#undef PG8_LDB
#undef PG8_MMA
#undef PG8_WAIT_V
#undef PG8_WAIT_L
#undef PG8_BAR
#undef PG8_SCHED
}
}

struct EpiG1 {
    static constexpr bool PERM = true;
    u16* P; float* GD;
    __device__ __forceinline__ void operator()(const f32x4 (&acc)[2][2][4][2], const pg8::Unit& u, int wr, int wc, int fr, int fq) const {
        const int row0 = u.pm * 256 + wr * 64 + fr;
        if (u.pn < 52) {
            const int col0 = u.pn * 256 + wc * 32 + 8 * fq;
#pragma unroll
            for (int ai = 0; ai < 2; ++ai)
#pragma unroll
                for (int m = 0; m < 4; ++m) { u16* rowp = P + (size_t)(row0 + ai * 128 + m * 16) * PW + col0;
#pragma unroll
                    for (int bj = 0; bj < 2; ++bj) { const f32x4 v0 = acc[ai][bj][m][0], v1 = acc[ai][bj][m][1];
                        u32x4 w; w.x = cvt_pk_bf16(v0[0], v0[1]); w.y = cvt_pk_bf16(v0[2], v0[3]); w.z = cvt_pk_bf16(v1[0], v1[1]); w.w = cvt_pk_bf16(v1[2], v1[3]);
                        *(u32x4*)(rowp + bj * 128) = w; } }
        } else if (wc < 3) {
            const int cc0 = wc * 32 + 8 * fq;
#pragma unroll
            for (int ai = 0; ai < 2; ++ai)
#pragma unroll
                for (int m = 0; m < 4; ++m) { float* rowp = GD + (size_t)(row0 + ai * 128 + m * 16) * GDW + cc0;
                    *(f32x4*)(rowp) = acc[ai][0][m][0]; *(f32x4*)(rowp + 4) = acc[ai][0][m][1]; }
        }
    }
};
struct EpiG2 {
    static constexpr bool PERM = false;
    const float* xres_lat; const float* xres_ctx; float* dst_lat; float* dst_ctx; const float* modl; int row_off;
    __device__ __forceinline__ void operator()(const f32x4 (&acc)[2][2][4][2], const pg8::Unit& u, int wr, int wc, int fr, int fq) const {
        const int g0 = u.pm * 256 + row_off;
        const bool isctx = g0 < CTXROWS;
        const int b = isctx ? (g0 >> 8) : ((g0 - CTXROWS) >> 13);
        const float* gate = modl + (size_t)(isctx ? 2 : b) * 6144 + 4096;
        const float* xr = isctx ? xres_ctx + (size_t)g0 * D : xres_lat + (size_t)(g0 - CTXROWS) * D;
        float* ds = isctx ? dst_ctx + (size_t)g0 * D : dst_lat + (size_t)(g0 - CTXROWS) * D;
        const int col0 = u.pn * 256 + wc * 32 + 4 * fq;
        f32x4 gv[2][2];
#pragma unroll
        for (int bj = 0; bj < 2; ++bj)
#pragma unroll
            for (int n = 0; n < 2; ++n) gv[bj][n] = *(const f32x4*)(gate + col0 + bj * 128 + n * 16);
#pragma unroll
        for (int ai = 0; ai < 2; ++ai)
#pragma unroll
            for (int m = 0; m < 4; ++m) { const size_t ro = (size_t)(wr * 64 + fr + ai * 128 + m * 16) * D + col0;
#pragma unroll
                for (int bj = 0; bj < 2; ++bj)
#pragma unroll
                    for (int n = 0; n < 2; ++n) { const f32x4 xv = *(const f32x4*)(xr + ro + bj * 128 + n * 16);
                        *(f32x4*)(ds + ro + bj * 128 + n * 16) = xv * ALPHA + gv[bj][n] * acc[ai][bj][m][n]; } }
    }
};

struct TrTile { const float* src; u16* dst; int Nsrc, K, n0, k0, perm; };
__device__ __forceinline__ void tr_load(const TrTile& t, float (&v)[16], int tid) {
    const int nl = tid & 63, kb = tid >> 6; const int n = t.n0 + nl; const int sc = t.perm ? src_col(n) : n;
#pragma unroll
    for (int i = 0; i < 16; ++i) { const int kl = i * 8 + kb; v[i] = sc >= 0 ? t.src[(size_t)(t.k0 + kl) * t.Nsrc + sc] : 0.f; }
}
__device__ __forceinline__ void tr_to_lds(const float (&v)[16], float* sf, int tid) {
    const int nl = tid & 63, kb = tid >> 6;
#pragma unroll
    for (int i = 0; i < 16; ++i) sf[(i * 8 + kb) * 65 + nl] = v[i];
}
__device__ __forceinline__ void tr_store(const TrTile& t, const float* sf, int tid) {
    const int nl2 = tid >> 3;
#pragma unroll
    for (int hk = 0; hk < 2; ++hk) { const int kc = (tid & 7) * 8 + hk * 64;
        u32x4 w;
        w.x = pk2(sf[(kc + 0) * 65 + nl2], sf[(kc + 1) * 65 + nl2]); w.y = pk2(sf[(kc + 2) * 65 + nl2], sf[(kc + 3) * 65 + nl2]);
        w.z = pk2(sf[(kc + 4) * 65 + nl2], sf[(kc + 5) * 65 + nl2]); w.w = pk2(sf[(kc + 6) * 65 + nl2], sf[(kc + 7) * 65 + nl2]);
        *(u32x4*)(t.dst + (size_t)(t.n0 + nl2) * t.K + t.k0 + kc) = w; }
}
__device__ __forceinline__ TrTile tr_tile(const Params& p, int t) {
    constexpr int T_IN = (NPAD / 64) * 16, T_OUT = 32 * 32;
    const int l = t / (T_IN + T_OUT), r = t % (T_IN + T_OUT);
    TrTile o;
    if (r < T_IN) { o.src = p.w_in + (size_t)l * 2048 * NIN; o.dst = p.wt_in + (size_t)l * (SZ_WL / 2); o.Nsrc = NIN; o.K = 2048; o.n0 = (r >> 4) * 64; o.k0 = (r & 15) * 128; o.perm = 1; }
    else { const int r2 = r - T_IN; o.src = p.w_out + (size_t)l * 4096 * 2048; o.dst = p.wt_out + (size_t)l * (SZ_WL / 2); o.Nsrc = 2048; o.K = 4096; o.n0 = (r2 >> 5) * 64; o.k0 = (r2 & 31) * 128; o.perm = 0; }
    return o;
}

__device__ void weight_tiles(const Params& p, float* sf, int l) {
    constexpr int T_L = (NPAD / 64) * 16 + 32 * 32;
    const int tid = TIDX, gd = GDIM;
    const int t_end = (l + 1) * T_L;
    int t = l * T_L + BIDX;
    float v[16];
    __syncthreads();
    if (t < t_end) { const TrTile c0 = tr_tile(p, t); tr_load(c0, v, tid); }
    while (t < t_end) {
        tr_to_lds(v, sf, tid);
        __syncthreads();
        const int tn = t + gd;
        if (tn < t_end) { const TrTile nxt = tr_tile(p, tn); tr_load(nxt, v, tid); }
        { const TrTile cur = tr_tile(p, t); tr_store(cur, sf, tid); }
        __syncthreads();
        t = tn;
    }
}

__device__ void phase_a(const Params& p, unsigned char* lds) {
    float* sf = (float*)lds;
    const int tid = TIDX;
    if (BIDX < 192) {
        for (int i = tid; i < 3 * 2048; i += 512) { const int r = i >> 11, k = i & 2047; const float v = r < 2 ? p.c[r * 2048 + k] : p.c_ctx[k]; sf[i] = siluf(v); }
        __syncthreads();
    }
    for (int t = BIDX; t < 192; t += GDIM) {
        const int l = t / 96, cb = t % 96; const int col = cb * 64 + (tid & 63); const int kg = tid >> 6;
        const float* w = p.w_ada + (size_t)l * 2048 * 6144 + col;
        float a0 = 0.f, a1 = 0.f, a2 = 0.f;
#pragma unroll 8
        for (int k = kg * 256; k < kg * 256 + 256; ++k) { const float wv = w[(size_t)k * 6144]; a0 += sf[k] * wv; a1 += sf[2048 + k] * wv; a2 += sf[4096 + k] * wv; }
        float* red = sf + 6144;
        red[(kg * 3 + 0) * 64 + (tid & 63)] = a0; red[(kg * 3 + 1) * 64 + (tid & 63)] = a1; red[(kg * 3 + 2) * 64 + (tid & 63)] = a2;
        __syncthreads();
        if (tid < 192) { const int r = tid >> 6, cc = tid & 63; float s = 0.f;
#pragma unroll
            for (int g = 0; g < 8; ++g) s += red[(g * 3 + r) * 64 + cc];
            const int col2 = cb * 64 + cc; p.MOD[(size_t)(l * 3 + r) * 6144 + col2] = s + p.b_ada[l * 6144 + col2]; }
        __syncthreads();
    }
    __syncthreads();
    weight_tiles(p, sf, 0);
}

__device__ __forceinline__ void row_stats(const f32x4 (&v)[8], float& mean, float& rstd) {
    float s = 0.f;
#pragma unroll
    for (int i = 0; i < 8; ++i) s += v[i][0] + v[i][1] + v[i][2] + v[i][3];
    mean = wsum(s) * (1.f / 2048.f);
    float q = 0.f;
#pragma unroll
    for (int i = 0; i < 8; ++i) { const f32x4 d = v[i] - mean; q += d[0] * d[0] + d[1] * d[1] + d[2] * d[2] + d[3] * d[3]; }
    rstd = rsqrtf(wsum(q) * (1.f / 2048.f) + LN_EPS);
}
__device__ void phase_ln(const Params& p, int l) {
    const int wid = TIDX >> 6, lane = TIDX & 63;
    const int nw = GDIM * 8;
    const bool fin = (l == DEPTH);
    for (int row = BIDX * 8 + wid; row < MROWS; row += nw) {
        const bool isctx = row < CTXROWS;
        if (fin && isctx) continue;
        const int b = isctx ? (row >> 8) : ((row - CTXROWS) >> 13);
        float* rw = isctx ? p.RC + (size_t)row * D : p.out + (size_t)(row - CTXROWS) * D;
        const float* src = (l == 0) ? (isctx ? p.ctx + (size_t)row * D : p.x + (size_t)(row - CTXROWS) * D) : rw;
        f32x4 v[8];
#pragma unroll
        for (int i = 0; i < 8; ++i) v[i] = *(const f32x4*)(src + i * 256 + lane * 4);
        float mean, rstd;
        if (l > 0) {
            row_stats(v, mean, rstd);
            const float* g = p.ln_g + (size_t)(l - 1) * D; const float* bb = p.ln_b + (size_t)(l - 1) * D;
#pragma unroll
            for (int i = 0; i < 8; ++i) { const f32x4 gv = *(const f32x4*)(g + i * 256 + lane * 4), bv = *(const f32x4*)(bb + i * 256 + lane * 4);
                v[i] = (v[i] - mean) * rstd * gv + bv; *(f32x4*)(rw + i * 256 + lane * 4) = v[i]; }
        }
        if (fin) continue;
        row_stats(v, mean, rstd);
        const float* md = p.MOD + (size_t)(l * 3 + (isctx ? 2 : b)) * 6144;
        u16* ur = p.U + (size_t)row * 2048;
#pragma unroll
        for (int i = 0; i < 8; ++i) { const f32x4 sh = *(const f32x4*)(md + i * 256 + lane * 4), sc = *(const f32x4*)(md + 2048 + i * 256 + lane * 4);
            const f32x4 o = (v[i] - mean) * rstd * (sc + 1.f) + sh;
            u32x2 w; w.x = pk2(o[0], o[1]); w.y = pk2(o[2], o[3]);
            *(u32x2*)(ur + i * 256 + lane * 4) = w; }
    }
}

template <bool ISM> __device__ __forceinline__ int scan_row(int b, int dir, int cc, int i) {
    const bool isctx = cc < 2; const int p0 = isctx ? cc * 128 : (cc - 2) * 128; const int slen = isctx ? 256 : 8192; const int rowbase = isctx ? b * 256 : CTXROWS + b * 8192;
    const int s = dir ? slen - 1 - (p0 + i) : p0 + i;
    return rowbase + ((ISM || isctx) ? s : ((s & 127) * 64 + (s >> 7)));
}

__device__ void phase_conv(const Params& p, int l) {
    const int tid = TIDX;
    {
        const int wv = tid >> 6, lane = tid & 63;
        const int nwv = GDIM * 8;
        for (int task = BIDX * 8 + wv; task < 2 * 2 * 66 * 40; task += nwv) {
            const int hd = task % 40; int r = task / 40; const int cc = r % 66; r /= 66; const int dir = r & 1, b = r >> 1;
            if (hd < 8) {
                const int h = hd; const int row0 = scan_row<true>(b, dir, cc, 2 * lane), row1 = scan_row<true>(b, dir, cc, 2 * lane + 1);
                const float gbi = p.gate_b[l * 32 + (dir * 2) * 8 + h], gbf = p.gate_b[l * 32 + (dir * 2 + 1) * 8 + h];
                const float li0 = p.GD[(size_t)row0 * GDW + (dir * 2) * 8 + h] + gbi, li1 = p.GD[(size_t)row1 * GDW + (dir * 2) * 8 + h] + gbi;
                const float x0 = p.GD[(size_t)row0 * GDW + (dir * 2 + 1) * 8 + h] + gbf, x1 = p.GD[(size_t)row1 * GDW + (dir * 2 + 1) * 8 + h] + gbf;
                const float lf0 = fminf(x0, 0.f) - __logf(1.f + __expf(-fabsf(x0))), lf1 = fminf(x1, 0.f) - __logf(1.f + __expf(-fabsf(x1)));
                const float a1 = lf0 + lf1;
                const float inc = scan_add(a1, lane); const float exc = inc - a1;
                const float b0 = exc + lf0, b1 = exc + a1;
                const float u0 = li0 - b0, u1 = li1 - b1;
                const float incm = scan_max(fmaxf(u0, u1), lane); float excm = __shfl_up(incm, 1, 64); if (lane == 0) excm = -3.0e38f;
                const float M0 = fmaxf(excm, u0), M1 = fmaxf(M0, u1);
                float* o0 = p.G2 + (size_t)row0 * G2W + (dir * 8 + h) * 3; float* o1 = p.G2 + (size_t)row1 * G2W + (dir * 8 + h) * 3;
                o0[0] = b0; o0[1] = u0; o0[2] = M0; o1[0] = b1; o1[1] = u1; o1[2] = M1;
            } else {
                const int hh = hd - 8; const int row0 = scan_row<false>(b, dir, cc, 2 * lane), row1 = scan_row<false>(b, dir, cc, 2 * lane + 1);
                const float dtb = p.dt_bias[(l * 2 + dir) * 32 + hh]; const float Ah = -__expf(p.a_log[(l * 2 + dir) * 32 + hh]);
                const float r0 = p.GD[(size_t)row0 * GDW + 32 + dir * 32 + hh] + dtb, r1 = p.GD[(size_t)row1 * GDW + 32 + dir * 32 + hh] + dtb;
                const float dt0 = fmaxf(r0, 0.f) + __logf(1.f + __expf(-fabsf(r0))), dt1 = fmaxf(r1, 0.f) + __logf(1.f + __expf(-fabsf(r1)));
                const float d0 = dt0 * Ah, d1 = dt1 * Ah;
                const float a1 = d0 + d1;
                const float inc = scan_add(a1, lane); const float exc = inc - a1;
                float* o0 = p.G2 + (size_t)row0 * G2W + 48 + (dir * 32 + hh) * 2; float* o1 = p.G2 + (size_t)row1 * G2W + 48 + (dir * 32 + hh) * 2;
                o0[0] = dt0; o0[1] = exc + d0; o1[0] = dt1; o1[1] = exc + a1;
            }
        }
    }
    const int ci = tid & 127, rs = tid >> 7;
    for (int t = BIDX; t < 528 * 5; t += GDIM) {
        const int cgp = t % 5, rg = t / 5;
        int pcol, ocol, wstride; const float *w, *bias; bool isx; float scale = 1.f;
        if (cgp < 2) { const int c = (cgp * 128 + ci) * 8; pcol = c; ocol = c; w = p.conv_qk_w + (size_t)l * 3 * 2048 + c; bias = p.conv_qk_b + (size_t)l * 2048 + c; wstride = 2048; isx = false;
            if (c < 1024) scale = 0.08838834764831845f; }
        else { const int c = ((cgp - 2) * 128 + ci) * 8; pcol = 8192 + c; ocol = 2048 + c; w = p.conv_xbc_w + (size_t)l * 3 * 3072 + c; bias = p.conv_xbc_b + (size_t)l * 3072 + c; wstride = 3072; isx = true; }
        float w0[8], w1[8], w2[8], bb[8];
#pragma unroll
        for (int e = 0; e < 8; ++e) { w0[e] = w[e]; w1[e] = w[wstride + e]; w2[e] = w[2 * wstride + e]; bb[e] = bias[e]; }
        const int r0 = rg * 32 + rs * 8;
        const bool lat = r0 >= CTXROWS;
        const int seqbase = lat ? (CTXROWS + (((r0 - CTXROWS) >> 13) << 13)) : (r0 & ~255);
        const int seqlen = lat ? 8192 : 256;
        const int sp0 = r0 - seqbase;
        const bool cm = lat && isx;
        u32x4 win[10];
#pragma unroll
        for (int i = 0; i < 10; ++i) { const int sp = sp0 - 1 + i;
            const int row = seqbase + (cm ? ((sp & 127) * 64 + (sp >> 7)) : sp);
            win[i] = (sp >= 0 && sp < seqlen) ? *(const u32x4*)(p.P + (size_t)row * PW + pcol) : (u32x4){0u, 0u, 0u, 0u}; }
#pragma unroll
        for (int i = 0; i < 8; ++i) { const int sp = sp0 + i;
            const int row = seqbase + (cm ? ((sp & 127) * 64 + (sp >> 7)) : sp);
            const u32x4 ap = win[i], a = win[i + 1], an = win[i + 2];
            u32x4 o;
#pragma unroll
            for (int e2 = 0; e2 < 4; ++e2) {
                const float y0 = w0[2 * e2] * bflo(ap[e2]) + w1[2 * e2] * bflo(a[e2]) + w2[2 * e2] * bflo(an[e2]) + bb[2 * e2];
                const float y1 = w0[2 * e2 + 1] * bfhi(ap[e2]) + w1[2 * e2 + 1] * bfhi(a[e2]) + w2[2 * e2 + 1] * bfhi(an[e2]) + bb[2 * e2 + 1];
                o[e2] = pk2(siluf(y0) * scale, siluf(y1) * scale);
            }
            *(u32x4*)(p.QKX + (size_t)row * QW + ocol) = o;
        }
    }
}

constexpr int LDK = 136, LDV = 88;
constexpr int LS_K = 0, LS_V = 34816, LS_VW = LS_V + 128 * LDV * 2, LS_CT = LS_VW + 128 * LDV * 2, LS_F = LS_CT + 80 * LDK * 2;

#define LDS_BAR() do { asm volatile("s_waitcnt lgkmcnt(0)" ::: "memory"); __builtin_amdgcn_s_barrier(); asm volatile("" ::: "memory"); } while (0)
#define TR_RD8(r0, r1, r2, r3, r4, r5, r6, r7, base, o0, o1, o2, o3, o4, o5, o6, o7) \
    asm volatile("ds_read_b64_tr_b16 %0, %8 offset:%9\n\tds_read_b64_tr_b16 %1, %8 offset:%10\n\tds_read_b64_tr_b16 %2, %8 offset:%11\n\tds_read_b64_tr_b16 %3, %8 offset:%12\n\t" \
                 "ds_read_b64_tr_b16 %4, %8 offset:%13\n\tds_read_b64_tr_b16 %5, %8 offset:%14\n\tds_read_b64_tr_b16 %6, %8 offset:%15\n\tds_read_b64_tr_b16 %7, %8 offset:%16\n\ts_waitcnt lgkmcnt(0)" \
                 : "=&v"(r0), "=&v"(r1), "=&v"(r2), "=&v"(r3), "=&v"(r4), "=&v"(r5), "=&v"(r6), "=&v"(r7) \
                 : "v"(base), "n"(o0), "n"(o1), "n"(o2), "n"(o3), "n"(o4), "n"(o5), "n"(o6), "n"(o7) : "memory")
#define TR_RD2(r0, r1, base, o0, o1) \
    asm volatile("ds_read_b64_tr_b16 %0, %2 offset:%3\n\tds_read_b64_tr_b16 %1, %2 offset:%4\n\ts_waitcnt lgkmcnt(0)" : "=&v"(r0), "=&v"(r1) : "v"(base), "n"(o0), "n"(o1) : "memory")
#define TR_ST10(K0_, K1_, A0_, A1_, A2_, A3_, A4_, A5_, A6_, A7_, BK_, BV_, OK0_, OK1_, OV0_, OV1_, OV2_, OV3_, OV4_, OV5_, OV6_, OV7_) \
    asm volatile("ds_read_b64_tr_b16 %[rk0], %[bk] offset:%[ok0]\n\tds_read_b64_tr_b16 %[rk1], %[bk] offset:%[ok1]\n\t" \
                 "ds_read_b64_tr_b16 %[ra0], %[bv] offset:%[ov0]\n\tds_read_b64_tr_b16 %[ra1], %[bv] offset:%[ov1]\n\tds_read_b64_tr_b16 %[ra2], %[bv] offset:%[ov2]\n\tds_read_b64_tr_b16 %[ra3], %[bv] offset:%[ov3]\n\t" \
                 "ds_read_b64_tr_b16 %[ra4], %[bv] offset:%[ov4]\n\tds_read_b64_tr_b16 %[ra5], %[bv] offset:%[ov5]\n\tds_read_b64_tr_b16 %[ra6], %[bv] offset:%[ov6]\n\tds_read_b64_tr_b16 %[ra7], %[bv] offset:%[ov7]\n\ts_waitcnt lgkmcnt(0)" \
                 : [rk0] "=&v"(K0_), [rk1] "=&v"(K1_), [ra0] "=&v"(A0_), [ra1] "=&v"(A1_), [ra2] "=&v"(A2_), [ra3] "=&v"(A3_), [ra4] "=&v"(A4_), [ra5] "=&v"(A5_), [ra6] "=&v"(A6_), [ra7] "=&v"(A7_) \
                 : [bk] "v"(BK_), [bv] "v"(BV_), [ok0] "n"(OK0_), [ok1] "n"(OK1_), [ov0] "n"(OV0_), [ov1] "n"(OV1_), [ov2] "n"(OV2_), [ov3] "n"(OV3_), [ov4] "n"(OV4_), [ov5] "n"(OV5_), [ov6] "n"(OV6_), [ov7] "n"(OV7_) : "memory")
#define TR_ST12(K0_, K1_, A0_, A1_, A2_, A3_, A4_, A5_, A6_, A7_, A8_, A9_, BK_, BV_, OK0_, OK1_, OV0_, OV1_, OV2_, OV3_, OV4_, OV5_, OV6_, OV7_, OV8_, OV9_) \
    asm volatile("ds_read_b64_tr_b16 %[rk0], %[bk] offset:%[ok0]\n\tds_read_b64_tr_b16 %[rk1], %[bk] offset:%[ok1]\n\t" \
                 "ds_read_b64_tr_b16 %[ra0], %[bv] offset:%[ov0]\n\tds_read_b64_tr_b16 %[ra1], %[bv] offset:%[ov1]\n\tds_read_b64_tr_b16 %[ra2], %[bv] offset:%[ov2]\n\tds_read_b64_tr_b16 %[ra3], %[bv] offset:%[ov3]\n\t" \
                 "ds_read_b64_tr_b16 %[ra4], %[bv] offset:%[ov4]\n\tds_read_b64_tr_b16 %[ra5], %[bv] offset:%[ov5]\n\tds_read_b64_tr_b16 %[ra6], %[bv] offset:%[ov6]\n\tds_read_b64_tr_b16 %[ra7], %[bv] offset:%[ov7]\n\t" \
                 "ds_read_b64_tr_b16 %[ra8], %[bv] offset:%[ov8]\n\tds_read_b64_tr_b16 %[ra9], %[bv] offset:%[ov9]\n\ts_waitcnt lgkmcnt(0)" \
                 : [rk0] "=&v"(K0_), [rk1] "=&v"(K1_), [ra0] "=&v"(A0_), [ra1] "=&v"(A1_), [ra2] "=&v"(A2_), [ra3] "=&v"(A3_), [ra4] "=&v"(A4_), [ra5] "=&v"(A5_), [ra6] "=&v"(A6_), [ra7] "=&v"(A7_), [ra8] "=&v"(A8_), [ra9] "=&v"(A9_) \
                 : [bk] "v"(BK_), [bv] "v"(BV_), [ok0] "n"(OK0_), [ok1] "n"(OK1_), [ov0] "n"(OV0_), [ov1] "n"(OV1_), [ov2] "n"(OV2_), [ov3] "n"(OV3_), [ov4] "n"(OV4_), [ov5] "n"(OV5_), [ov6] "n"(OV6_), [ov7] "n"(OV7_), [ov8] "n"(OV8_), [ov9] "n"(OV9_) : "memory")
__device__ __forceinline__ bf16x8 mkfrag(u32x2 lo, u32x2 hi) { const u32x4 w = {lo.x, lo.y, hi.x, hi.y}; return __builtin_bit_cast(bf16x8, w); }

template <bool ISM>
__device__ void scan_item(const Params& p, int l, int item, unsigned char* lds) {
    constexpr int NT = ISM ? 5 : 4;
    constexpr float L2E = 1.4426950408889634f;
    const int tid = TIDX, wid = __builtin_amdgcn_readfirstlane(tid >> 6), lane = tid & 63, fr = lane & 15, fq = lane >> 4;
    const int trq = fr >> 2, trp = fr & 3;
    const int sl = ISM ? (item & 3) : 0, dir = ISM ? ((item >> 2) & 1) : (item & 1), h = ISM ? ((item >> 3) & 7) : ((item >> 1) & 31), b = item >> 6;
    const int qcol = ISM ? h * 128 : 2048 + 2560 + (h >> 3) * 128;
    const int kcol = ISM ? 1024 + h * 128 : 2048 + 2048 + (h >> 3) * 128;
    const int vcol = ISM ? 2048 + h * 256 + sl * 64 : 2048 + h * 64;
    const int ocol = ISM ? h * 256 + sl * 64 : h * 64;
    u16* const obase = dir ? (ISM ? p.HB : p.YB) : (ISM ? p.P : p.P + 8192);
    const unsigned ostride = dir ? 2048u : (unsigned)PW;
    u16* Ks = (u16*)(lds + LS_K); u16* Vs = (u16*)(lds + LS_V); u16* Vw = (u16*)(lds + LS_VW); u16* CT = (u16*)(lds + LS_CT);
    float* F = (float*)(lds + LS_F);
    float *f_c = F, *f_r = F + 128, *f_wi = F + 256, *f_ws = F + 384, *f_em = F + 512;
    const unsigned ldsb = (unsigned)(size_t)(LAS unsigned char*)lds;
    const unsigned trK = ldsb + LS_K + (unsigned)(((fq * 8 + trq) * LDK + 16 * wid + 4 * trp) * 2);
    const unsigned trVw = ldsb + LS_VW + (unsigned)(((fq * 8 + trq) * LDV + 4 * trp) * 2);
    const unsigned trV = ldsb + LS_V + (unsigned)(((fq * 4 + trq) * LDV + 4 * trp) * 2);
    const float Dh = ISM ? 0.f : p.d_skip[l * 32 + h];
    const u16* __restrict__ gQKX = p.QKX; const u16* __restrict__ gP = p.P; const float* __restrict__ gG2 = p.G2;
    const int gcol = ISM ? (dir * 8 + h) * 3 : 48 + (dir * 32 + h) * 2;
    __syncthreads();
    for (int i = tid; i < 128 * 24; i += 512) { const int r = i / 24, cc = 64 + i % 24; Vs[r * LDV + cc] = (ISM && cc == 64) ? (u16)0x3F80 : (u16)0; Vw[r * LDV + cc] = 0; }
    for (int i = tid; i < 80 * LDK; i += 512) CT[i] = 0;
    f32x4 st[NT];
#pragma unroll
    for (int m = 0; m < NT; ++m) st[m] = (f32x4){0.f, 0.f, 0.f, 0.f};
    float m_prev = 0.f;
    unsigned qo, ko[4], vo[2], go, ge, oo[4];
    bf16x8 qf[4]; u32x4 kr[4]; u32x4 vr[2]; f32x3 gv = {0.f, 0.f, 0.f}; float e0 = 0.f, e1 = 0.f;
#define SCAN_PTRS(cc) do { \
        qo = (unsigned)scan_row<ISM>(b, dir, (cc), 16 * wid + fr) * (unsigned)QW + (unsigned)(qcol + fq * 8); \
        _Pragma("unroll") for (int r_ = 0; r_ < 4; ++r_) { const int idx_ = r_ * 512 + tid; ko[r_] = (unsigned)scan_row<ISM>(b, dir, (cc), idx_ >> 4) * (unsigned)QW + (unsigned)(kcol + (idx_ & 15) * 8); } \
        _Pragma("unroll") for (int r_ = 0; r_ < 2; ++r_) { const int idx_ = r_ * 512 + tid; vo[r_] = (unsigned)scan_row<ISM>(b, dir, (cc), idx_ >> 3) * (unsigned)(ISM ? PW : QW) + (unsigned)(vcol + (idx_ & 7) * 8); } \
        go = (unsigned)scan_row<ISM>(b, dir, (cc), tid & 127) * (unsigned)G2W + (unsigned)gcol; ge = (unsigned)scan_row<ISM>(b, dir, (cc), 127) * (unsigned)G2W + (unsigned)gcol; \
        _Pragma("unroll") for (int j_ = 0; j_ < 4; ++j_) oo[j_] = (unsigned)scan_row<ISM>(b, dir, (cc), 16 * wid + fq * 4 + j_) * ostride + (unsigned)(ocol + fr); \
    } while (0)
#define SCAN_ADV(dr) do { const unsigned dq_ = (unsigned)((dr) * QW), dp_ = (unsigned)((dr) * PW), dg_ = (unsigned)((dr) * G2W), do_ = (unsigned)(dr) * ostride; \
        qo += dq_; _Pragma("unroll") for (int r_ = 0; r_ < 4; ++r_) ko[r_] += dq_; vo[0] += ISM ? dp_ : dq_; vo[1] += ISM ? dp_ : dq_; go += dg_; ge += dg_; \
        _Pragma("unroll") for (int j_ = 0; j_ < 4; ++j_) oo[j_] += do_; } while (0)
#define SCAN_LOAD() do { \
        _Pragma("unroll") for (int k_ = 0; k_ < 4; ++k_) qf[k_] = *(const bf16x8*)(gQKX + (size_t)qo + k_ * 32); \
        _Pragma("unroll") for (int r_ = 0; r_ < 4; ++r_) kr[r_] = *(const u32x4*)(gQKX + (size_t)ko[r_]); \
        _Pragma("unroll") for (int r_ = 0; r_ < 2; ++r_) vr[r_] = ISM ? *(const u32x4*)(gP + (size_t)vo[r_]) : *(const u32x4*)(gQKX + (size_t)vo[r_]); \
        if (tid < 128) gv = *(const f32x3*)(gG2 + (size_t)go); \
        if (ISM) { e0 = gG2[(size_t)ge]; e1 = gG2[(size_t)ge + 2]; } else { e0 = gG2[(size_t)ge + 1]; } \
    } while (0)
    SCAN_PTRS(0); SCAN_LOAD();
    const int dr_ctx = dir ? -128 : 128, dr_lat = ISM ? dr_ctx : (dir ? -1 : 1);
    __syncthreads();
#pragma unroll 1
    for (int c = 0; c < 66; ++c) {
#pragma unroll
        for (int rep = 0; rep < 4; ++rep) { const int idx = rep * 512 + tid; *(u32x4*)(Ks + (idx >> 4) * LDK + (idx & 15) * 8) = kr[rep]; }
#pragma unroll
        for (int rep = 0; rep < 2; ++rep) { const int idx = rep * 512 + tid; *(u32x4*)(Vs + (idx >> 3) * LDV + (idx & 7) * 8) = vr[rep]; }
        float decay;
        if (ISM) {
            const float Ml = fmaxf(m_prev, e1);
            if (tid < 128) { const float M = fmaxf(m_prev, gv[2]);
                f_c[tid] = gv[1] * L2E; f_r[tid] = M * L2E; f_wi[tid] = __expf(m_prev - M); f_ws[tid] = __expf(gv[1] - Ml); f_em[tid] = __expf(-(gv[0] + M)); }
            decay = __expf(m_prev - Ml); m_prev = e0 + Ml;
        } else {
            if (tid < 128) { f_c[tid] = (__logf(gv[0]) - gv[1]) * L2E; f_r[tid] = -gv[1] * L2E; f_wi[tid] = __expf(gv[1]); f_ws[tid] = __expf(e0 - gv[1]) * gv[0]; }
            decay = __expf(e0);
        }
        bf16x8 qc[4]; unsigned od[4];
#pragma unroll
        for (int k = 0; k < 4; ++k) qc[k] = qf[k];
#pragma unroll
        for (int j = 0; j < 4; ++j) od[j] = oo[j];
        const u32x4 vc0 = vr[0], vc1 = vr[1];
        LDS_BAR();
        if (c + 1 < 66) { if (c + 1 == 2) SCAN_PTRS(2); else SCAN_ADV(c == 0 ? dr_ctx : dr_lat); SCAN_LOAD(); }
        f32x4 sacc[8];
#pragma unroll
        for (int a = 0; a < 8; ++a) sacc[a] = (f32x4){0.f, 0.f, 0.f, 0.f};
#pragma unroll
        for (int a = 0; a < 8; a += 2) {
            if (a + 1 <= wid) {
                bf16x8 kf[2][4];
#pragma unroll
                for (int h2 = 0; h2 < 2; ++h2)
#pragma unroll
                    for (int ksd = 0; ksd < 4; ++ksd) kf[h2][ksd] = *(const bf16x8*)(Ks + (16 * (a + h2) + fr) * LDK + ksd * 32 + fq * 8);
#pragma unroll
                for (int ksd = 0; ksd < 4; ++ksd) { sacc[a] = __builtin_amdgcn_mfma_f32_16x16x32_bf16(kf[0][ksd], qc[ksd], sacc[a], 0, 0, 0);
                    sacc[a + 1] = __builtin_amdgcn_mfma_f32_16x16x32_bf16(kf[1][ksd], qc[ksd], sacc[a + 1], 0, 0, 0); }
            } else if (a <= wid) {
                bf16x8 kf[4];
#pragma unroll
                for (int ksd = 0; ksd < 4; ++ksd) kf[ksd] = *(const bf16x8*)(Ks + (16 * a + fr) * LDK + ksd * 32 + fq * 8);
#pragma unroll
                for (int ksd = 0; ksd < 4; ++ksd) sacc[a] = __builtin_amdgcn_mfma_f32_16x16x32_bf16(kf[ksd], qc[ksd], sacc[a], 0, 0, 0);
            }
        }
        bf16x8 sf[4]; float dsum = 0.f;
        { const float rt = f_r[16 * wid + fr];
          f32x4 cva[8];
#pragma unroll
          for (int a = 0; a < 8; ++a) cva[a] = *(const f32x4*)(f_c + 16 * a + fq * 4);
#pragma unroll
          for (int ks = 0; ks < 4; ++ks) { u32x4 w;
#pragma unroll
              for (int hf = 0; hf < 2; ++hf) { const int a = 2 * ks + hf; float v[4];
                  if (a < wid) { const f32x4 cv = cva[a];
#pragma unroll
                      for (int j = 0; j < 4; ++j) { v[j] = sacc[a][j] * __builtin_amdgcn_exp2f(cv[j] - rt); dsum += v[j]; }
                  } else if (a == wid) { const f32x4 cv = cva[a];
#pragma unroll
                      for (int j = 0; j < 4; ++j) { const float e = sacc[a][j] * __builtin_amdgcn_exp2f(cv[j] - rt); v[j] = (fq * 4 + j <= fr) ? e : 0.f; dsum += v[j]; }
                  } else { v[0] = 0.f; v[1] = 0.f; v[2] = 0.f; v[3] = 0.f; }
                  w[hf * 2] = pk2(v[0], v[1]); w[hf * 2 + 1] = pk2(v[2], v[3]); }
              sf[ks] = __builtin_bit_cast(bf16x8, w); } }
        dsum += __shfl_xor(dsum, 16, 64); dsum += __shfl_xor(dsum, 32, 64);
        {
#pragma unroll
          for (int rep = 0; rep < 2; ++rep) { const int idx = rep * 512 + tid; const int i = idx >> 3; const float wv = f_ws[i]; const u32x4 vc = rep ? vc1 : vc0; u32x4 o;
#pragma unroll
              for (int e = 0; e < 4; ++e) o[e] = pk2(bflo(vc[e]) * wv, bfhi(vc[e]) * wv);
              *(u32x4*)(Vw + i * LDV + (idx & 7) * 8) = o; }
          if (ISM && tid < 128) Vw[tid * LDV + 64] = f2bf(f_ws[tid]); }
        { f32x4 ia[NT], ib[4];
#pragma unroll
          for (int n = 0; n < NT; ++n) ia[n] = (f32x4){0.f, 0.f, 0.f, 0.f};
#pragma unroll
          for (int n = 0; n < 4; ++n) ib[n] = (f32x4){0.f, 0.f, 0.f, 0.f};
#pragma unroll
          for (int ksd = 0; ksd < 4; ++ksd) { bf16x8 bfr[NT];
#pragma unroll
              for (int n = 0; n < NT; ++n) bfr[n] = *(const bf16x8*)(CT + (n * 16 + fr) * LDK + ksd * 32 + fq * 8);
#pragma unroll
              for (int n = 0; n < NT; ++n) ia[n] = __builtin_amdgcn_mfma_f32_16x16x32_bf16(qc[ksd], bfr[n], ia[n], 0, 0, 0); }
#define SCAN_IB(ks) if (2 * (ks) <= wid) { u32x2 r0, r1, r2, r3, r4, r5, r6, r7; \
              TR_RD8(r0, r1, r2, r3, r4, r5, r6, r7, trV, (ks) * 32 * LDV * 2, (ks) * 32 * LDV * 2 + 16 * LDV * 2, (ks) * 32 * LDV * 2 + 32, (ks) * 32 * LDV * 2 + 16 * LDV * 2 + 32, \
                     (ks) * 32 * LDV * 2 + 64, (ks) * 32 * LDV * 2 + 16 * LDV * 2 + 64, (ks) * 32 * LDV * 2 + 96, (ks) * 32 * LDV * 2 + 16 * LDV * 2 + 96); \
              ib[0] = __builtin_amdgcn_mfma_f32_16x16x32_bf16(sf[ks], mkfrag(r0, r1), ib[0], 0, 0, 0); ib[1] = __builtin_amdgcn_mfma_f32_16x16x32_bf16(sf[ks], mkfrag(r2, r3), ib[1], 0, 0, 0); \
              ib[2] = __builtin_amdgcn_mfma_f32_16x16x32_bf16(sf[ks], mkfrag(r4, r5), ib[2], 0, 0, 0); ib[3] = __builtin_amdgcn_mfma_f32_16x16x32_bf16(sf[ks], mkfrag(r6, r7), ib[3], 0, 0, 0); }
          SCAN_IB(0) SCAN_IB(1) SCAN_IB(2) SCAN_IB(3)
#undef SCAN_IB
#pragma unroll
          for (int j = 0; j < 4; ++j) { const int tl = fq * 4 + j, t = 16 * wid + tl; const float wi = f_wi[t];
              float inv = 1.f;
              if (ISM) { const float qn = __shfl(ia[NT - 1][j], lane & 48, 64); const float dn = __shfl(dsum, tl, 64); inv = __builtin_amdgcn_rcpf(fmaxf(fabsf(wi * qn + dn), f_em[t])); }
              u16* dst = obase + (size_t)od[j];
              float v[4];
#pragma unroll
              for (int n = 0; n < 4; ++n) { v[n] = (wi * ia[n][j] + ib[n][j]) * inv; if (!ISM && dir == 0) v[n] += Dh * bf2f(Vs[t * LDV + n * 16 + fr]); }
              const unsigned p01 = pk2(v[0], v[1]), p23 = pk2(v[2], v[3]);
              dst[0] = (u16)(p01 & 0xFFFFu); dst[16] = (u16)(p01 >> 16); dst[32] = (u16)(p23 & 0xFFFFu); dst[48] = (u16)(p23 >> 16); } }
        LDS_BAR();
        {
#pragma unroll
          for (int m = 0; m < NT; ++m) st[m] *= decay;
#define SCAN_ST(ks) { u32x2 k0, k1, a0, a1, a2, a3, a4, a5, a6, a7, a8, a9; \
              if (ISM) TR_ST12(k0, k1, a0, a1, a2, a3, a4, a5, a6, a7, a8, a9, trK, trVw, (ks) * 32 * LDK * 2, (ks) * 32 * LDK * 2 + 4 * LDK * 2, \
                     (ks) * 32 * LDV * 2, (ks) * 32 * LDV * 2 + 4 * LDV * 2, (ks) * 32 * LDV * 2 + 32, (ks) * 32 * LDV * 2 + 4 * LDV * 2 + 32, \
                     (ks) * 32 * LDV * 2 + 64, (ks) * 32 * LDV * 2 + 4 * LDV * 2 + 64, (ks) * 32 * LDV * 2 + 96, (ks) * 32 * LDV * 2 + 4 * LDV * 2 + 96, \
                     (ks) * 32 * LDV * 2 + 128, (ks) * 32 * LDV * 2 + 4 * LDV * 2 + 128); \
              else TR_ST10(k0, k1, a0, a1, a2, a3, a4, a5, a6, a7, trK, trVw, (ks) * 32 * LDK * 2, (ks) * 32 * LDK * 2 + 4 * LDK * 2, \
                     (ks) * 32 * LDV * 2, (ks) * 32 * LDV * 2 + 4 * LDV * 2, (ks) * 32 * LDV * 2 + 32, (ks) * 32 * LDV * 2 + 4 * LDV * 2 + 32, \
                     (ks) * 32 * LDV * 2 + 64, (ks) * 32 * LDV * 2 + 4 * LDV * 2 + 64, (ks) * 32 * LDV * 2 + 96, (ks) * 32 * LDV * 2 + 4 * LDV * 2 + 96); \
              const bf16x8 kfr = mkfrag(k0, k1); \
              st[0] = __builtin_amdgcn_mfma_f32_16x16x32_bf16(mkfrag(a0, a1), kfr, st[0], 0, 0, 0); st[1] = __builtin_amdgcn_mfma_f32_16x16x32_bf16(mkfrag(a2, a3), kfr, st[1], 0, 0, 0); \
              st[2] = __builtin_amdgcn_mfma_f32_16x16x32_bf16(mkfrag(a4, a5), kfr, st[2], 0, 0, 0); st[3] = __builtin_amdgcn_mfma_f32_16x16x32_bf16(mkfrag(a6, a7), kfr, st[3], 0, 0, 0); \
              if (ISM) st[NT - 1] = __builtin_amdgcn_mfma_f32_16x16x32_bf16(mkfrag(a8, a9), kfr, st[NT - 1], 0, 0, 0); }
          SCAN_ST(0) SCAN_ST(1) SCAN_ST(2) SCAN_ST(3)
#undef SCAN_ST
#pragma unroll
          for (int m = 0; m < NT; ++m) { const unsigned p01 = pk2(st[m][0], st[m][1]), p23 = pk2(st[m][2], st[m][3]);
              u16* cp = CT + (m * 16 + fq * 4) * LDK + 16 * wid + fr;
              cp[0] = (u16)(p01 & 0xFFFFu); cp[LDK] = (u16)(p01 >> 16); cp[2 * LDK] = (u16)(p23 & 0xFFFFu); cp[3 * LDK] = (u16)(p23 >> 16); } }
        LDS_BAR();
    }
#undef SCAN_LOAD
#undef SCAN_ADV
#undef SCAN_PTRS
}

__device__ void phase_scan(const Params& p, int l, unsigned char* lds) {
    for (int blk = BIDX; blk < 256; blk += GDIM) {
        const int xcd = blk & 7, j = blk >> 3;
        if (j < 16) scan_item<true>(p, l, (xcd + 8 * (j >> 2)) * 4 + (j & 3), lds);
        else { const int G = xcd + 8 * ((j - 16) >> 3), r = (j - 16) & 7; const int dir = G & 1, g = (G >> 1) & 3, b = G >> 3;
            scan_item<false>(p, l, dir + 2 * (g * 8 + r) + 64 * b, lds); }
    }
}

__device__ void phase_post(const Params& p, int l) {
    const int wid = TIDX >> 6, lane = TIDX & 63;
    const int nw = GDIM * 8;
    const int c0 = lane * 32;
    for (int row = BIDX * 8 + wid; row < MROWS; row += nw) {
        u16* pr = p.P + (size_t)row * PW;
        {
            float tv[32]; float ss = 0.f;
#pragma unroll
            for (int q = 0; q < 4; ++q) { const u32x4 yv = *(const u32x4*)(pr + 8192 + c0 + q * 8), zv = *(const u32x4*)(pr + 11264 + c0 + q * 8), yb = *(const u32x4*)(p.YB + (size_t)row * 2048 + c0 + q * 8);
#pragma unroll
                for (int e = 0; e < 4; ++e) { const float t0 = (bflo(yv[e]) + bflo(yb[e])) * siluf(bflo(zv[e])), t1 = (bfhi(yv[e]) + bfhi(yb[e])) * siluf(bfhi(zv[e]));
                    tv[q * 8 + 2 * e] = t0; tv[q * 8 + 2 * e + 1] = t1; ss += t0 * t0 + t1 * t1; } }
            const float rstd = rsqrtf(wsum(ss) * (1.f / 2048.f) + LN_EPS);
            const float* sw = p.ssm_w + (size_t)l * 2048 + c0;
#pragma unroll
            for (int q = 0; q < 4; ++q) { const f32x4 wa = *(const f32x4*)(sw + q * 8), wb = *(const f32x4*)(sw + q * 8 + 4);
                u32x4 o; o.x = pk2(tv[q * 8] * rstd * wa[0], tv[q * 8 + 1] * rstd * wa[1]); o.y = pk2(tv[q * 8 + 2] * rstd * wa[2], tv[q * 8 + 3] * rstd * wa[3]);
                o.z = pk2(tv[q * 8 + 4] * rstd * wb[0], tv[q * 8 + 5] * rstd * wb[1]); o.w = pk2(tv[q * 8 + 6] * rstd * wb[2], tv[q * 8 + 7] * rstd * wb[3]);
                *(u32x4*)(pr + 11264 + c0 + q * 8) = o; }
        }
        {
            float hv[32]; float s = 0.f;
#pragma unroll
            for (int q = 0; q < 4; ++q) { const u32x4 a = *(const u32x4*)(pr + c0 + q * 8), ab = *(const u32x4*)(p.HB + (size_t)row * 2048 + c0 + q * 8);
#pragma unroll
                for (int e = 0; e < 4; ++e) { const float h0 = bflo(a[e]) + bflo(ab[e]), h1 = bfhi(a[e]) + bfhi(ab[e]); hv[q * 8 + 2 * e] = h0; hv[q * 8 + 2 * e + 1] = h1; s += h0 + h1; } }
            s += __shfl_xor(s, 1, 64); s += __shfl_xor(s, 2, 64); s += __shfl_xor(s, 4, 64);
            const float mean = s * (1.f / 256.f);
            float q2 = 0.f;
#pragma unroll
            for (int e = 0; e < 32; ++e) { const float d = hv[e] - mean; q2 += d * d; }
            q2 += __shfl_xor(q2, 1, 64); q2 += __shfl_xor(q2, 2, 64); q2 += __shfl_xor(q2, 4, 64);
            const float rstd = rsqrtf(q2 * (1.f / 256.f) + LN_EPS);
            const float* mw = p.mh_w + (size_t)l * 2048 + c0;
#pragma unroll
            for (int q = 0; q < 4; ++q) { const u32x4 ov = *(const u32x4*)(pr + 4096 + c0 + q * 8), zv = *(const u32x4*)(pr + 6144 + c0 + q * 8);
                const f32x4 wa = *(const f32x4*)(mw + q * 8), wb = *(const f32x4*)(mw + q * 8 + 4);
                float r[8];
#pragma unroll
                for (int e = 0; e < 4; ++e) {
                    const float m0 = (e < 2 ? wa[2 * e] : wb[2 * e - 4]), m1 = (e < 2 ? wa[2 * e + 1] : wb[2 * e - 3]);
                    r[2 * e] = sigmf(bflo(ov[e])) * ((hv[q * 8 + 2 * e] - mean) * rstd * m0) * siluf(bflo(zv[e]));
                    r[2 * e + 1] = sigmf(bfhi(ov[e])) * ((hv[q * 8 + 2 * e + 1] - mean) * rstd * m1) * siluf(bfhi(zv[e])); }
                u32x4 o; o.x = pk2(r[0], r[1]); o.y = pk2(r[2], r[3]); o.z = pk2(r[4], r[5]); o.w = pk2(r[6], r[7]);
                *(u32x4*)(pr + 9216 + c0 + q * 8) = o; }
        }
    }
}

__device__ __forceinline__ void grid_barrier(unsigned* ctr, unsigned target) {
    __syncthreads();
    if (threadIdx.x == 0) {
        __builtin_amdgcn_fence(__ATOMIC_RELEASE, "agent");
        asm volatile("s_waitcnt vmcnt(0)" ::: "memory");
        __hip_atomic_fetch_add(ctr, 1u, __ATOMIC_RELAXED, __HIP_MEMORY_SCOPE_AGENT);
        while (__hip_atomic_load(ctr, __ATOMIC_RELAXED, __HIP_MEMORY_SCOPE_AGENT) < target) __builtin_amdgcn_s_sleep(2);
        __builtin_amdgcn_fence(__ATOMIC_ACQUIRE, "agent");
        asm volatile("s_waitcnt vmcnt(0)" ::: "memory");
    }
    __syncthreads();
}
__device__ __forceinline__ void acquire_workgroup() {
    if (threadIdx.x == 0) { __builtin_amdgcn_fence(__ATOMIC_ACQUIRE, "agent"); asm volatile("s_waitcnt vmcnt(0)" ::: "memory"); }
    __syncthreads();
}

constexpr int N_PHASES = 2 + 6 * DEPTH;
__global__ __launch_bounds__(512, 2) void mega(KArgs ka, int ph_lo, int ph_hi) {
    extern __shared__ __attribute__((aligned(16))) unsigned char shm[];
    cg::grid_group grid = cg::this_grid();
#pragma unroll 1
    for (int ph = ph_lo; ph < ph_hi; ++ph) {
        if (ph == 0) {
            Params q{}; unsigned char* ws = KWS();
            q.c = KIN(1); q.c_ctx = KIN(3); q.w_ada = KIN(4); q.b_ada = KIN(5); q.w_in = KIN(6); q.w_out = KIN(17);
            q.MOD = (float*)(ws + OFF_MOD); q.wt_in = (u16*)(ws + OFF_W); q.wt_out = (u16*)(ws + OFF_W + SZ_WTIN1);
            phase_a(q, shm);
        } else {
            const int l = (ph == N_PHASES - 1) ? DEPTH : (ph - 1) / 6, k = (ph == N_PHASES - 1) ? 0 : (ph - 1) % 6;
            if (k == 0) {
                Params q{}; unsigned char* ws = KWS();
                q.x = KIN(0); q.ctx = KIN(2); q.ln_g = KIN(18); q.ln_b = KIN(19); q.out = KOUT();
                q.RC = (float*)(ws + OFF_RC); q.MOD = (float*)(ws + OFF_MOD); q.U = (u16*)(ws + OFF_U);
                phase_ln(q, l);
                if (l >= 1 && l < DEPTH) {
                    q.w_in = KIN(6); q.w_out = KIN(17); q.wt_in = (u16*)(ws + OFF_W); q.wt_out = (u16*)(ws + OFF_W + SZ_WTIN1);
                    weight_tiles(q, (float*)shm, l);
                }
            } else if (k == 1) {
                unsigned char* ws = KWS();
                pg8::Gemm g{(const u16*)(ws + OFF_U), (const u16*)(ws + OFF_W + (size_t)l * SZ_WL), MROWS, NPAD, 2048, 2048};
                pg8::StaticOrder S; S.init(MROWS, NPAD, GDIM, BIDX);
                EpiG1 E{(u16*)(ws + OFF_P), (float*)(ws + OFF_GD)};
                pg8::gemm_phase<EpiG1>((LAS unsigned char*)shm, g, S, E);
            } else if (k == 2) {
                Params q{}; unsigned char* ws = KWS();
                q.conv_qk_w = KIN(7); q.conv_qk_b = KIN(8); q.conv_xbc_w = KIN(11); q.conv_xbc_b = KIN(12); q.gate_b = KIN(9); q.dt_bias = KIN(13); q.a_log = KIN(14);
                q.P = (u16*)(ws + OFF_P); q.QKX = (u16*)(ws + OFF_QKX); q.GD = (float*)(ws + OFF_GD); q.G2 = (float*)(ws + OFF_G2);
                phase_conv(q, l);
            } else if (k == 3) {
                Params q{}; unsigned char* ws = KWS();
                q.gate_b = KIN(9); q.dt_bias = KIN(13); q.a_log = KIN(14); q.d_skip = KIN(15);
                q.P = (u16*)(ws + OFF_P); q.QKX = (u16*)(ws + OFF_QKX); q.G2 = (float*)(ws + OFF_G2);
                q.HB = (u16*)(ws + OFF_U); q.YB = (u16*)(ws + OFF_W + (size_t)((l + 1) & 1) * SZ_WL);
                phase_scan(q, l, shm);
            } else if (k == 4) {
                Params q{}; unsigned char* ws = KWS();
                q.mh_w = KIN(10); q.ssm_w = KIN(16); q.P = (u16*)(ws + OFF_P);
                q.HB = (u16*)(ws + OFF_U); q.YB = (u16*)(ws + OFF_W + (size_t)((l + 1) & 1) * SZ_WL);
                phase_post(q, l);
            } else {
                unsigned char* ws = KWS(); float* outp = KOUT();
                const float* xin = KIN(0); const float* cin = KIN(2);
                float* rc = (float*)(ws + OFF_RC);
                const int roff = (l == DEPTH - 1) ? CTXROWS : 0;
                pg8::Gemm g{(const u16*)(ws + OFF_P) + (size_t)roff * PW + 9216, (const u16*)(ws + OFF_W + (size_t)l * SZ_WL + SZ_WTIN1), MROWS - roff, 2048, 4096, PW};
                pg8::StaticOrder S; S.init(MROWS - roff, 2048, GDIM, BIDX);
                EpiG2 E{l == 0 ? xin : outp, l == 0 ? cin : rc, outp, rc, (const float*)(ws + OFF_MOD) + (size_t)l * 3 * 6144, roff};
                pg8::gemm_phase<EpiG2>((LAS unsigned char*)shm, g, S, E);
            }
        }
        if (ph + 1 < ph_hi) {
            if (ph_hi > N_PHASES) { grid.sync(); acquire_workgroup(); }
            grid_barrier((unsigned*)(KWS() + OFF_BAR), (unsigned)(ph - ph_lo + 1) * (unsigned)GDIM);
        }
    }
}

extern "C" void kernel_launch(void* const* d_in, const int* in_sizes, int n_in, void* d_out, int out_size, void* d_ws, size_t ws_size, hipStream_t stream) {
    static int grid = 0;
    if (grid == 0) {
        if (n_in != 20 || ws_size < WS_END) { fprintf(stderr, "kernel_launch: unexpected n_in %d or ws_size %zu (< %zu)\n", n_in, ws_size, (size_t)WS_END); grid = -1; return; }
        int dev = 0, cus = 0, per_cu = 0;
        hipGetDevice(&dev);
        hipDeviceGetAttribute(&cus, hipDeviceAttributeMultiprocessorCount, dev);
        if (hipFuncSetAttribute((const void*)mega, hipFuncAttributeMaxDynamicSharedMemorySize, LDS_BYTES) != hipSuccess) { fprintf(stderr, "kernel_launch: hipFuncSetAttribute failed\n"); grid = -1; return; }
        if (hipOccupancyMaxActiveBlocksPerMultiprocessor(&per_cu, (const void*)mega, 512, LDS_BYTES) != hipSuccess || per_cu < 1) { fprintf(stderr, "kernel_launch: occupancy query says %d\n", per_cu); per_cu = 1; }
        (void)hipGetLastError();
        grid = cus;
    }
    if (grid < 0) return;
    if (hipMemsetAsync((unsigned char*)d_ws + OFF_BAR, 0, 256, stream) != hipSuccess) { fprintf(stderr, "kernel_launch: memset failed\n"); return; }
    KArgs ka{};
    for (int i = 0; i < 20; ++i) ka.in[i] = (const float*)d_in[i];
    ka.out = (float*)d_out; ka.ws = (unsigned char*)d_ws;
    int lo = 0, hi = N_PHASES;
    void* args[] = {&ka, &lo, &hi};
    hipError_t e = hipLaunchCooperativeKernel((const void*)mega, dim3(grid), dim3(512), args, LDS_BYTES, stream);
    if (e != hipSuccess) fprintf(stderr, "kernel_launch: cooperative launch failed: %s (grid %d)\n", hipGetErrorString(e), grid);
}
```
